# Optimizing an MI355X kernel written in HIP

```python
import math
import jax, jax.numpy as jnp
from jax import lax
import numpy as np

D_MODEL = 1024
BATCH = 4
SEQ = 4096
DEPTH = 2

CTX_LEN = 256
GRID_W = 64
HEAD_DIM = 64
EPS = 1e-6
ROPE_BASE = 10000.0
A_HEADS = 8
A_KV_HEADS = 2
A_WINDOW = 128
A_BLOCK = 128
B_HEADS = 4
B_DK = 64
B_DV = 128
B_GATE_RANK = 16
B_GATE_NORM = 16.0
B_CHUNK = 16
C_HEADS = 8
C_WIN_ROWS = 8
C_WIN_COLS = 16
C_QBLOCK_COLS = 16
C_KBLOCK_COLS = 32
FFN_HIDDEN = -(-8 * D_MODEL // (3 * 256)) * 256
IN_SIZES = (A_HEADS * HEAD_DIM, A_KV_HEADS * HEAD_DIM, A_KV_HEADS * HEAD_DIM,
            B_HEADS * B_DK, B_HEADS * B_DK, B_HEADS * B_DV, B_HEADS * B_DV, 2 * B_GATE_RANK,
            C_HEADS * HEAD_DIM, C_HEADS * HEAD_DIM, C_HEADS * HEAD_DIM)
IN_TOTAL = sum(IN_SIZES)

kernel_name = "hybrid_gated_parallel_mixer_dit"


def rmsnorm(x, g):
    xf = x.astype(jnp.float32)
    y = xf * lax.rsqrt(jnp.mean(xf * xf, axis=-1, keepdims=True) + EPS)
    return (y * g.astype(jnp.float32)).astype(x.dtype)


def split_projection(t):
    idx = []
    acc = 0
    for s in IN_SIZES[:-1]:
        acc += s
        idx.append(acc)
    return jnp.split(t, idx, axis=-1)


def split_heads(t, n_heads):
    return t.reshape(t.shape[0], t.shape[1], n_heads, -1)


def axial_rope_tables(L):
    t = jnp.arange(L)
    row = (t // GRID_W).astype(jnp.float32)
    col = (t % GRID_W).astype(jnp.float32)
    n_freq = HEAD_DIM // 4
    inv = ROPE_BASE ** (-jnp.arange(n_freq, dtype=jnp.float32) / n_freq)
    ang = jnp.concatenate([row[:, None] * inv[None], col[:, None] * inv[None]], axis=-1)
    return jnp.cos(ang), jnp.sin(ang)


def apply_rope(x, cos, sin):
    half = HEAD_DIM // 2
    x1, x2 = x[..., :half], x[..., half:]
    c = cos[None, :, None, :]
    s = sin[None, :, None, :]
    return jnp.concatenate([x1 * c - x2 * s, x1 * s + x2 * c], axis=-1).astype(x.dtype)


def window_attention(q, k, v, k_ctx, v_ctx, sink):
    B, L, Hq, dh = q.shape
    n_kv = k.shape[2]
    G = Hq // n_kv
    Lc = k_ctx.shape[1]
    blk = A_BLOCK
    nb = L // blk
    qb = q.reshape(B, nb, blk, n_kv, G, dh)
    pad = ((0, 0), (blk, blk), (0, 0), (0, 0))
    kp = jnp.pad(k, pad).reshape(B, nb + 2, blk, n_kv, dh)
    vp = jnp.pad(v, pad).reshape(B, nb + 2, blk, n_kv, dh)
    k_band = jnp.concatenate([kp[:, :-2], kp[:, 1:-1], kp[:, 2:]], axis=2)
    v_band = jnp.concatenate([vp[:, :-2], vp[:, 1:-1], vp[:, 2:]], axis=2)
    scale = dh ** -0.5
    s_loc = jnp.einsum('bnqhgd,bnkhd->bnhgqk', qb, k_band).astype(jnp.float32) * scale
    s_ctx = jnp.einsum('bnqhgd,bchd->bnhgqc', qb, k_ctx).astype(jnp.float32) * scale
    qi = jnp.arange(blk)[:, None]
    kj = jnp.arange(3 * blk)[None, :] - blk
    j_abs = jnp.arange(nb)[:, None, None] * blk + kj[None]
    valid = (jnp.abs(kj - qi)[None] <= A_WINDOW) & (j_abs >= 0) & (j_abs < L)
    s_loc = jnp.where(valid[None, :, None, None], s_loc, -jnp.inf)
    sink_col = jnp.broadcast_to(sink.astype(jnp.float32).reshape(n_kv, G)[None, None, :, :, None, None],
                                s_loc.shape[:-1] + (1,))
    p = jax.nn.softmax(jnp.concatenate([s_loc, s_ctx, sink_col], axis=-1), axis=-1)
    nk = 3 * blk
    p_loc = p[..., :nk].astype(v.dtype)
    p_ctx = p[..., nk:nk + Lc].astype(v.dtype)
    o = (jnp.einsum('bnhgqk,bnkhd->bnqhgd', p_loc, v_band)
         + jnp.einsum('bnhgqc,bchd->bnqhgd', p_ctx, v_ctx))
    return o.reshape(B, L, Hq * dh)


def dense_ctx_attention(q, k, v, n_kv, sink):
    B, Lc, Hq, dh = q.shape
    G = Hq // n_kv
    qg = q.reshape(B, Lc, n_kv, G, dh)
    s = jnp.einsum('bqhgd,bkhd->bhgqk', qg, k).astype(jnp.float32) * dh ** -0.5
    if sink is not None:
        sink_col = jnp.broadcast_to(sink.astype(jnp.float32).reshape(n_kv, G)[None, :, :, None, None],
                                    (B, n_kv, G, Lc, 1))
        s = jnp.concatenate([s, sink_col], axis=-1)
    p = jax.nn.softmax(s, axis=-1)[..., :Lc].astype(v.dtype)
    o = jnp.einsum('bhgqk,bkhd->bqhgd', p, v)
    return o.reshape(B, Lc, Hq * dh)


def neighbourhood_attention(q, k, v, k_ctx, v_ctx, rpb):
    B, L, H, dh = q.shape
    Lc = k_ctx.shape[1]
    rows = L // GRID_W
    kh = min(C_WIN_ROWS, rows)
    qbw = C_QBLOCK_COLS
    kbw = C_KBLOCK_COLS
    nm = GRID_W // qbw
    qg = q.reshape(B, rows, nm, qbw, H, dh)
    kg = k.reshape(B, rows, GRID_W, H, dh)
    vg = v.reshape(B, rows, GRID_W, H, dh)
    r = jnp.arange(rows)
    row_idx = jnp.clip(r - kh // 2, 0, rows - kh)[:, None] + jnp.arange(kh)[None]
    m = jnp.arange(nm)
    col_start = jnp.clip(m * qbw - C_WIN_COLS // 2, 0, GRID_W - kbw)
    col_idx = col_start[:, None] + jnp.arange(kbw)[None]
    ri = row_idx[:, None, :, None]
    ci = col_idx[None, :, None, :]
    k_nb = kg[:, ri, ci]
    v_nb = vg[:, ri, ci]
    scale = dh ** -0.5
    s_loc = jnp.einsum('brmqhd,brmijhd->brmhqij', qg, k_nb).astype(jnp.float32) * scale
    qcol = m[:, None] * qbw + jnp.arange(qbw)[None]
    wstart = jnp.clip(qcol - C_WIN_COLS // 2, 0, GRID_W - C_WIN_COLS)
    kcol = col_idx[:, None, :]
    col_ok = (kcol >= wstart[..., None]) & (kcol < wstart[..., None] + C_WIN_COLS)
    d_row = row_idx - r[:, None] + (C_WIN_ROWS - 1)
    d_col = jnp.clip(kcol - qcol[..., None], -(C_WIN_COLS - 1), C_WIN_COLS - 1) + (C_WIN_COLS - 1)
    bias = rpb[:, d_row[:, None, None, :, None], d_col[None, :, :, None, :]]
    bias = jnp.moveaxis(bias, 0, 2).astype(jnp.float32)
    s_loc = jnp.where(col_ok[None, None, :, None, :, None, :], s_loc + bias[None], -jnp.inf)
    s_loc = s_loc.reshape(B, rows, nm, H, qbw, kh * kbw)
    s_ctx = jnp.einsum('brmqhd,bchd->brmhqc', qg, k_ctx).astype(jnp.float32) * scale
    p = jax.nn.softmax(jnp.concatenate([s_loc, s_ctx], axis=-1), axis=-1)
    nk = kh * kbw
    p_loc = p[..., :nk].reshape(B, rows, nm, H, qbw, kh, kbw).astype(v.dtype)
    p_ctx = p[..., nk:].astype(v.dtype)
    o = (jnp.einsum('brmhqij,brmijhd->brmqhd', p_loc, v_nb)
         + jnp.einsum('brmhqc,bchd->brmqhd', p_ctx, v_ctx))
    return o.reshape(B, L, H * dh)


def gla_chunked(q, k, v, g, s0):
    B, H, L, dk = q.shape
    dv = v.shape[-1]
    C = B_CHUNK
    n = L // C
    qc = q.reshape(B, H, n, C, dk)
    kc = k.reshape(B, H, n, C, dk)
    vc = v.reshape(B, H, n, C, dv)
    b = jnp.cumsum(g.astype(jnp.float32).reshape(B, H, n, C, dk), axis=3)
    b_last = b[:, :, :, -1:]
    causal = jnp.tril(jnp.ones((C, C), dtype=bool))
    diff = b[:, :, :, :, None, :] - b[:, :, :, None, :, :]
    decay = jnp.exp(jnp.where(causal[:, :, None], diff, -jnp.inf))
    A = jnp.einsum('bhnid,bhnjd,bhnijd->bhnij', qc, kc, decay)
    o_intra = jnp.einsum('bhnij,bhnjd->bhnid', A, vc)
    k_tail = kc * jnp.exp(b_last - b)
    upd = jnp.einsum('bhncd,bhnce->bhnde', k_tail, vc)
    chunk_decay = jnp.exp(b_last[:, :, :, 0])

    def step(S, inp):
        dec, u = inp
        return dec[..., None] * S + u, S

    s_final, s_before = lax.scan(step, s0, (jnp.moveaxis(chunk_decay, 2, 0), jnp.moveaxis(upd, 2, 0)))
    s_before = jnp.moveaxis(s_before, 0, 2)
    o_inter = jnp.einsum('bhncd,bhnde->bhnce', qc * jnp.exp(b), s_before)
    o = (o_intra + o_inter).reshape(B, H, L, dv).astype(v.dtype)
    return o, s_final


def gla_bidirectional(q, k, v, g_fwd, g_bwd, s0_fwd, s0_bwd):
    o_f, s_f = gla_chunked(q, k, v, g_fwd, s0_fwd)
    flip = lambda t: jnp.flip(t, axis=2)
    o_b, s_b = gla_chunked(flip(q), flip(k), flip(v), flip(g_bwd), s0_bwd)
    return o_f + flip(o_b), s_f, s_b


def to_gla_heads(t, n_heads):
    return split_heads(t, n_heads).transpose(0, 2, 1, 3)


def gla_log_gates(z_low, w, bias):
    z = (z_low @ w + bias).astype(jnp.float32)
    return to_gla_heads(jax.nn.log_sigmoid(z) / B_GATE_NORM, B_HEADS)


def gla_output(o, r, norm_g):
    B, H, L, dv = o.shape
    o = rmsnorm(o.transpose(0, 2, 1, 3), norm_g).reshape(B, L, H * dv)
    return (o * jax.nn.silu(r)).astype(r.dtype)


def merge_branches(h, y_a, y_b, y_c, w_ba, w_bb, w_bc, w_merge, b_merge, w_out):
    gates = jax.nn.sigmoid(h @ w_merge + b_merge)
    g_a, g_b, g_c = jnp.split(gates, 3, axis=-1)
    mixed = g_a * (y_a @ w_ba) + g_b * (y_b @ w_bb) + g_c * (y_c @ w_bc)
    return mixed @ w_out


def swiglu(h, w_in, w_out):
    gate, up = jnp.split(h @ w_in, 2, axis=-1)
    return (jax.nn.silu(gate) * up) @ w_out


def setup_inputs(seed: int = 0) -> dict:
    key = jax.random.key(seed)
    ks = iter(jax.random.split(key, 32))

    def nrm(shape, scale):
        return jax.random.normal(next(ks), shape, jnp.float32) * scale

    D = D_MODEL
    return {
        'x': nrm((BATCH, SEQ, D), 1.0),
        'c': nrm((BATCH, D), 1.0),
        'ctx': nrm((BATCH, CTX_LEN, D), 1.0),
        'c_ctx': nrm((D,), 1.0),
        'w_ada': nrm((DEPTH, D, 6 * D), 0.5 * D ** -0.5),
        'b_ada': nrm((DEPTH, 6 * D), 0.02),
        'norm_mix': 1.0 + nrm((DEPTH, D), 0.02),
        'w_in': nrm((DEPTH, D, IN_TOTAL), D ** -0.5),
        'attn_sink': nrm((DEPTH, A_HEADS), 0.5),
        'gla_gate_w_fwd': nrm((DEPTH, B_GATE_RANK, B_HEADS * B_DK), B_GATE_RANK ** -0.5),
        'gla_gate_b_fwd': nrm((DEPTH, B_HEADS * B_DK), 0.1),
        'gla_gate_w_bwd': nrm((DEPTH, B_GATE_RANK, B_HEADS * B_DK), B_GATE_RANK ** -0.5),
        'gla_gate_b_bwd': nrm((DEPTH, B_HEADS * B_DK), 0.1),
        'gla_norm': 1.0 + nrm((DEPTH, B_DV), 0.02),
        'na_rpb': nrm((DEPTH, C_HEADS, 2 * C_WIN_ROWS - 1, 2 * C_WIN_COLS - 1), 0.02),
        'w_branch_a': nrm((DEPTH, A_HEADS * HEAD_DIM, D), (A_HEADS * HEAD_DIM) ** -0.5),
        'w_branch_b': nrm((DEPTH, B_HEADS * B_DV, D), (B_HEADS * B_DV) ** -0.5),
        'w_branch_c': nrm((DEPTH, C_HEADS * HEAD_DIM, D), (C_HEADS * HEAD_DIM) ** -0.5),
        'w_merge': nrm((DEPTH, D, 3 * D), D ** -0.5),
        'b_merge': nrm((DEPTH, 3 * D), 0.02),
        'w_out': nrm((DEPTH, D, D), D ** -0.5),
        'norm_ffn': 1.0 + nrm((DEPTH, D), 0.02),
        'w_ffn_in': nrm((DEPTH, D, 2 * FFN_HIDDEN), D ** -0.5),
        'w_ffn_out': nrm((DEPTH, FFN_HIDDEN, D), FFN_HIDDEN ** -0.5),
        'final_norm': 1.0 + nrm((D,), 0.02),
    }


def reference(x, c, ctx, c_ctx, w_ada, b_ada, norm_mix, w_in, attn_sink, gla_gate_w_fwd, gla_gate_b_fwd,
              gla_gate_w_bwd, gla_gate_b_bwd, gla_norm, na_rpb, w_branch_a, w_branch_b, w_branch_c,
              w_merge, b_merge, w_out, norm_ffn, w_ffn_in, w_ffn_out, final_norm):
    B, L, D = x.shape
    cos, sin = axial_rope_tables(L)
    xc = ctx
    for l in range(DEPTH):
        last = l == DEPTH - 1
        mod = (jax.nn.silu(c) @ w_ada[l] + b_ada[l])[:, None, :]
        mod_c = (jax.nn.silu(c_ctx) @ w_ada[l] + b_ada[l])[None, None, :]
        sh_m, sc_m, gt_m, sh_f, sc_f, gt_f = jnp.split(mod, 6, axis=-1)
        shc_m, scc_m, gtc_m, shc_f, scc_f, gtc_f = jnp.split(mod_c, 6, axis=-1)

        h = rmsnorm(x, norm_mix[l]) * (1.0 + sc_m) + sh_m
        hc = rmsnorm(xc, norm_mix[l]) * (1.0 + scc_m) + shc_m
        a_q, a_k, a_v, g_q, g_k, g_v, g_r, g_a, n_q, n_k, n_v = split_projection(h @ w_in[l])
        ac_q, ac_k, ac_v, gc_q, gc_k, gc_v, gc_r, gc_a, nc_q, nc_k, nc_v = split_projection(hc @ w_in[l])

        qa = apply_rope(split_heads(a_q, A_HEADS), cos, sin)
        ka = apply_rope(split_heads(a_k, A_KV_HEADS), cos, sin)
        va = split_heads(a_v, A_KV_HEADS)
        qa_c = split_heads(ac_q, A_HEADS)
        ka_c = split_heads(ac_k, A_KV_HEADS)
        va_c = split_heads(ac_v, A_KV_HEADS)
        y_a = window_attention(qa, ka, va, ka_c, va_c, attn_sink[l])

        R = B_GATE_RANK
        gf_c = gla_log_gates(gc_a[..., :R], gla_gate_w_fwd[l], gla_gate_b_fwd[l])
        gb_c = gla_log_gates(gc_a[..., R:], gla_gate_w_bwd[l], gla_gate_b_bwd[l])
        zeros = jnp.zeros((B, B_HEADS, B_DK, B_DV), jnp.float32)
        o_c, s_ctx_f, s_ctx_b = gla_bidirectional(
            to_gla_heads(gc_q * B_DK ** -0.5, B_HEADS), to_gla_heads(gc_k, B_HEADS), to_gla_heads(gc_v, B_HEADS),
            gf_c, gb_c, zeros, zeros)
        gf = gla_log_gates(g_a[..., :R], gla_gate_w_fwd[l], gla_gate_b_fwd[l])
        gb = gla_log_gates(g_a[..., R:], gla_gate_w_bwd[l], gla_gate_b_bwd[l])
        o_l, _, _ = gla_bidirectional(
            to_gla_heads(g_q * B_DK ** -0.5, B_HEADS), to_gla_heads(g_k, B_HEADS), to_gla_heads(g_v, B_HEADS),
            gf, gb, s_ctx_f, s_ctx_b)
        y_b = gla_output(o_l, g_r, gla_norm[l])

        nk_c = split_heads(nc_k, C_HEADS)
        nv_c = split_heads(nc_v, C_HEADS)
        y_c = neighbourhood_attention(split_heads(n_q, C_HEADS), split_heads(n_k, C_HEADS),
                                      split_heads(n_v, C_HEADS), nk_c, nv_c, na_rpb[l])

        x = x + gt_m * merge_branches(h, y_a, y_b, y_c, w_branch_a[l], w_branch_b[l], w_branch_c[l],
                                      w_merge[l], b_merge[l], w_out[l])
        if not last:
            yc_a = dense_ctx_attention(qa_c, ka_c, va_c, A_KV_HEADS, attn_sink[l])
            yc_b = gla_output(o_c, gc_r, gla_norm[l])
            yc_c = dense_ctx_attention(split_heads(nc_q, C_HEADS), nk_c, nv_c, C_HEADS, None)
            xc = xc + gtc_m * merge_branches(hc, yc_a, yc_b, yc_c, w_branch_a[l], w_branch_b[l],
                                             w_branch_c[l], w_merge[l], b_merge[l], w_out[l])

        hf = rmsnorm(x, norm_ffn[l]) * (1.0 + sc_f) + sh_f
        x = x + gt_f * swiglu(hf, w_ffn_in[l], w_ffn_out[l])
        if not last:
            hfc = rmsnorm(xc, norm_ffn[l]) * (1.0 + scc_f) + shc_f
            xc = xc + gtc_f * swiglu(hfc, w_ffn_in[l], w_ffn_out[l])
    return rmsnorm(x, final_norm)
```

```cpp
#include <hip/hip_runtime.h>
#include <hip/hip_cooperative_groups.h>
#include <cstdio>
namespace cg = cooperative_groups;

#ifndef MULTI_LAUNCH
#define MULTI_LAUNCH 0
#endif

typedef unsigned short u16;
using bf16x8 = __attribute__((ext_vector_type(8))) short;
using s16x4  = __attribute__((ext_vector_type(4))) short;
using f32x4  = __attribute__((ext_vector_type(4))) float;
#define DI __device__ __forceinline__
#define MFMA16(a, b, c) __builtin_amdgcn_mfma_f32_16x16x32_bf16((a), (b), (c), 0, 0, 0)

constexpr int D = 1024, NB = 4, SEQ = 4096, LC = 256, NLAT = NB * SEQ, NCTX = NB * LC, NTOK = NLAT + NCTX;
constexpr int INT = 3872, INTP = 3968, FH = 2816, PNLD = 2720, VTR = 1152;
constexpr float LOG2E = 1.4426950408889634f;

constexpr size_t OFF_WIN  = 0;
constexpr size_t OFF_WMG  = OFF_WIN + (size_t)INTP * D * 2;
constexpr size_t OFF_WBR  = OFF_WMG + (size_t)3072 * D * 2;
constexpr size_t OFF_WOUT = OFF_WBR + (size_t)3 * 1024 * 512 * 2;
constexpr size_t OFF_WF1  = OFF_WOUT + (size_t)D * D * 2;
constexpr size_t OFF_WF2  = OFF_WF1 + (size_t)2 * FH * D * 2;
constexpr size_t OFF_PAD  = OFF_WF2 + (size_t)D * FH * 2;
constexpr size_t OFF_MOD  = OFF_PAD + (1u << 20);
constexpr size_t OFF_ROPE = OFF_MOD + (size_t)2 * 5 * 6144 * 4;
constexpr size_t OFF_XC   = OFF_ROPE + (size_t)SEQ * 32 * 2 * 4;
constexpr size_t OFF_HB   = OFF_XC + (size_t)NCTX * D * 4;
constexpr size_t OFF_PN   = OFF_HB + (size_t)NTOK * D * 2;
constexpr size_t OFF_VT   = OFF_PN + (size_t)NTOK * PNLD * 2;
constexpr size_t OFF_VTC  = OFF_VT + (size_t)NB * VTR * SEQ * 2;
constexpr size_t OFF_Y    = OFF_VTC + (size_t)NB * VTR * LC * 2;
constexpr size_t WS_END   = OFF_Y + (size_t)3 * NTOK * 512 * 2;
static_assert(WS_END <= ((size_t)256 << 20), "workspace too large");
constexpr size_t OFF_OB    = OFF_WF1;
static_assert(OFF_OB + (size_t)NTOK * 512 * 2 <= OFF_MOD, "o_b alias");
constexpr size_t OFF_BAR   = OFF_PAD + (768u << 10);
constexpr size_t OFF_MIXED = OFF_PN;
constexpr size_t OFF_ACT   = OFF_PN + (size_t)NTOK * D * 2;
static_assert(OFF_ACT + (size_t)NTOK * FH * 2 <= OFF_Y, "act alias");

struct Params {
  const float *x, *c, *ctx, *c_ctx, *w_ada, *b_ada, *norm_mix, *w_in, *sink, *gw_f, *gb_f, *gw_b, *gb_b, *gla_norm, *rpb,
      *w_ba, *w_bb, *w_bc, *w_merge, *b_merge, *w_out, *norm_ffn, *w_ffn_in, *w_ffn_out, *final_norm;
  float* out;
  char* ws;
};

typedef __bf16 bf2_t __attribute__((ext_vector_type(2)));
DI u16 f2bf(float x) { __bf16 v = (__bf16)x; return __builtin_bit_cast(u16, v); }
DI float bf2f(u16 h) { return __uint_as_float(((unsigned)h) << 16); }
DI unsigned pack2(float a, float b) { bf2_t v = {(__bf16)a, (__bf16)b}; return __builtin_bit_cast(unsigned, v); }
DI float wave_sum(float v) { for (int o = 32; o; o >>= 1) v += __shfl_xor(v, o, 64); return v; }
DI float sigmoidf_(float x) { return __builtin_amdgcn_rcpf(1.0f + __expf(-x)); }
DI float siluf_(float x) { return x * __builtin_amdgcn_rcpf(1.0f + __expf(-x)); }

DI const float* xsrc(const Params& p, int l, int row) {
  if (row < NLAT) return (l == 0 ? p.x : p.out) + (size_t)row * D;
  return (l == 0 ? p.ctx : (const float*)(p.ws + OFF_XC)) + (size_t)(row - NLAT) * D;
}
DI float* xdst(const Params& p, int row) {
  if (row < NLAT) return p.out + (size_t)row * D;
  return (float*)(p.ws + OFF_XC) + (size_t)(row - NLAT) * D;
}
DI const float* modp(const Params& p, int l, int row) {
  int s = row < NLAT ? (row >> 12) : 4;
  return (const float*)(p.ws + OFF_MOD) + (size_t)(l * 5 + s) * 6144;
}

constexpr int LROW = 144;
constexpr int LDS_A = 0, LDS_B = 128 * LROW;

constexpr int GROW = 128;
constexpr int G_A = 0, G_B = 128 * GROW;
constexpr int GBUF = 2 * 128 * GROW;
template <int NI, int CH>
DI void gemm_tile(const u16* __restrict__ A, int lda, const u16* __restrict__ Bt, int ldb, int K,
                  f32x4 (&acc)[4][NI], char* lds) {
  const int tid = threadIdx.x, lane = tid & 63, wave = tid >> 6;
  const int wm = wave >> 1, wn = wave & 1, g = lane >> 4, n = lane & 15;
  const int lrow = tid >> 3, lkc = tid & 7;
  const u16* ap = CH ? A + (size_t)lrow * 32 + (size_t)(lkc >> 2) * lda * 32 + (lkc & 3) * 8 : A + (size_t)lrow * lda + lkc * 8;
  const u16* bp = CH ? Bt + (size_t)lrow * 32 + (size_t)(lkc >> 2) * ldb * 32 + (lkc & 3) * 8 : Bt + (size_t)lrow * ldb + lkc * 8;
  const size_t sa = CH ? (size_t)32 * 32 : (size_t)32 * lda, sb = CH ? (size_t)32 * 32 : (size_t)32 * ldb;
  const size_t ka = CH ? (size_t)lda : 1, kb = CH ? (size_t)ldb : 1;
  const int wsw = (lkc ^ ((lrow >> 1) & 7)) * 16;
  const int rsw0 = (g ^ ((n >> 1) & 7)) * 16, rsw1 = ((4 + g) ^ ((n >> 1) & 7)) * 16;
  uint4 ra0, ra1, ra2, ra3, rb0, rb1, rb2, rb3;
#define GLOADS(kk)                                                                                                   \
  {                                                                                                                  \
    ra0 = *(const uint4*)(ap + (kk) * ka); ra1 = *(const uint4*)(ap + sa + (kk) * ka);                               \
    ra2 = *(const uint4*)(ap + 2 * sa + (kk) * ka); ra3 = *(const uint4*)(ap + 3 * sa + (kk) * ka);                  \
    rb0 = *(const uint4*)(bp + (kk) * kb); rb1 = *(const uint4*)(bp + sb + (kk) * kb);                               \
    if (NI == 4) { rb2 = *(const uint4*)(bp + 2 * sb + (kk) * kb); rb3 = *(const uint4*)(bp + 3 * sb + (kk) * kb); } \
  }
#define LSTORES(buf)                                                                                                 \
  {                                                                                                                  \
    char* wa_ = lds + (buf) * GBUF + G_A + lrow * GROW + wsw;                                                        \
    char* wb_ = lds + (buf) * GBUF + G_B + lrow * GROW + wsw;                                                        \
    *(uint4*)(wa_) = ra0; *(uint4*)(wa_ + 32 * GROW) = ra1; *(uint4*)(wa_ + 64 * GROW) = ra2; *(uint4*)(wa_ + 96 * GROW) = ra3; \
    *(uint4*)(wb_) = rb0; *(uint4*)(wb_ + 32 * GROW) = rb1;                                                          \
    if (NI == 4) { *(uint4*)(wb_ + 64 * GROW) = rb2; *(uint4*)(wb_ + 96 * GROW) = rb3; }                             \
  }
  GLOADS(0);
  __syncthreads();
  LSTORES(0);
  GLOADS(64);
  __syncthreads();
  const int nk = K >> 6;
#pragma unroll 1
  for (int it = 0; it < nk; it++) {
    const int cur = it & 1;
    if (it + 1 < nk) LSTORES(cur ^ 1);
    if (it + 2 < nk) GLOADS((it + 2) * 64);
    const char* fa = lds + cur * GBUF + G_A + (wm * 64 + n) * GROW;
    const char* fb = lds + cur * GBUF + G_B + (wn * 16 * NI + n) * GROW;
#pragma unroll
    for (int ks = 0; ks < 2; ks++) {
      const int rsw = ks ? rsw1 : rsw0;
      bf16x8 af[4], bfr[NI];
#pragma unroll
      for (int i = 0; i < 4; i++) af[i] = *(const bf16x8*)(fa + i * 16 * GROW + rsw);
#pragma unroll
      for (int i = 0; i < NI; i++) bfr[i] = *(const bf16x8*)(fb + i * 16 * GROW + rsw);
#pragma unroll
      for (int mi = 0; mi < 4; mi++)
#pragma unroll
        for (int ni = 0; ni < NI; ni++) acc[mi][ni] = MFMA16(af[mi], bfr[ni], acc[mi][ni]);
    }
    __syncthreads();
  }
#undef GLOADS
#undef LSTORES
}

template <int NI>
DI void zero_acc(f32x4 (&acc)[4][NI]) {
#pragma unroll
  for (int i = 0; i < 4; i++)
#pragma unroll
    for (int j = 0; j < NI; j++) acc[i][j] = f32x4{0.f, 0.f, 0.f, 0.f};
}

constexpr int LROW2 = 64;
constexpr int W_A = 0, W_B = 128 * LROW2, WBUF = 384 * LROW2;
DI void gemm_wide(const u16* __restrict__ A, int lda, const u16* __restrict__ Bt, int ldb, int K, f32x4 (&acc)[4][8], char* lds) {
  const int tid = threadIdx.x, lane = tid & 63, wave = tid >> 6;
  const int wm = wave >> 1, wn = wave & 1, g = lane >> 4, n = lane & 15;
  const int lrow = tid >> 2, lkc = tid & 3;
  const u16* ap = A + (size_t)lrow * 32 + lkc * 8;
  const u16* bp = Bt + (size_t)lrow * 32 + lkc * 8;
  const size_t sa = (size_t)64 * 32, sb = (size_t)64 * 32;
  const size_t ka = (size_t)lda, kb = (size_t)ldb;
  uint4 ra0, ra1, rb0, rb1, rb2, rb3;
  const int wsw = (lkc ^ ((0 - (lrow >> 2)) & 3)) * 16;
  const int rsw = (g ^ ((0 - (n >> 2)) & 3)) * 16;
#define GLOADS(kk)                                                                           \
  {                                                                                          \
    ra0 = *(const uint4*)(ap + (kk) * ka); ra1 = *(const uint4*)(ap + sa + (kk) * ka);       \
    rb0 = *(const uint4*)(bp + (kk) * kb); rb1 = *(const uint4*)(bp + sb + (kk) * kb);       \
    rb2 = *(const uint4*)(bp + 2 * sb + (kk) * kb); rb3 = *(const uint4*)(bp + 3 * sb + (kk) * kb); \
  }
#define LSTORES(buf)                                                                         \
  {                                                                                          \
    char* wa_ = lds + (buf) * WBUF + W_A + lrow * LROW2 + wsw;                               \
    char* wb_ = lds + (buf) * WBUF + W_B + lrow * LROW2 + wsw;                               \
    *(uint4*)(wa_) = ra0; *(uint4*)(wa_ + 64 * LROW2) = ra1;                                 \
    *(uint4*)(wb_) = rb0; *(uint4*)(wb_ + 64 * LROW2) = rb1;                                 \
    *(uint4*)(wb_ + 128 * LROW2) = rb2; *(uint4*)(wb_ + 192 * LROW2) = rb3;                  \
  }
#define HALF(h)                                                                              \
  {                                                                                          \
    bf16x8 bfr[4];                                                                           \
    _Pragma("unroll") for (int i = 0; i < 4; i++) bfr[i] = *(const bf16x8*)(fb + ((h) * 4 + i) * 16 * LROW2); \
    _Pragma("unroll") for (int mi = 0; mi < 4; mi++)                                         \
      _Pragma("unroll") for (int ni = 0; ni < 4; ni++) acc[mi][(h) * 4 + ni] = MFMA16(af[mi], bfr[ni], acc[mi][(h) * 4 + ni]); \
  }
  GLOADS(0);
  __syncthreads();
  LSTORES(0);
  GLOADS(32);
  __syncthreads();
  const int nk = K >> 5;
#pragma unroll 1
  for (int it = 0; it < nk; it++) {
    const int cur = it & 1;
    const char* fa = lds + cur * WBUF + W_A + (wm * 64 + n) * LROW2 + rsw;
    const char* fb = lds + cur * WBUF + W_B + (wn * 128 + n) * LROW2 + rsw;
    bf16x8 af[4];
#pragma unroll
    for (int i = 0; i < 4; i++) af[i] = *(const bf16x8*)(fa + i * 16 * LROW2);
    HALF(0);
    if (it + 1 < nk) LSTORES(cur ^ 1);
    if (it + 2 < nk) GLOADS((it + 2) * 32);
    HALF(1);
    __syncthreads();
  }
#undef GLOADS
#undef LSTORES
#undef HALF
}

DI void task_mod(const Params& p, int task, char* lds) {
  const int tid = threadIdx.x, lane = tid & 63, wave = tid >> 6;
  const int l = task / 96, cb = task % 96;
  float* sc = (float*)lds;
  float* red = sc + 5 * 1024;
  __syncthreads();
  for (int i = tid; i < 5 * 1024; i += 256) {
    int s = i >> 10, k = i & 1023;
    float v = s < 4 ? p.c[s * 1024 + k] : p.c_ctx[k];
    sc[i] = siluf_(v);
  }
  __syncthreads();
  const int ncol = cb * 64 + lane;
  const float* w = p.w_ada + (size_t)l * 1024 * 6144 + ncol;
  float a0 = 0, a1 = 0, a2 = 0, a3 = 0, a4 = 0;
#pragma unroll 16
  for (int k = wave * 256; k < wave * 256 + 256; k++) {
    float wv = w[(size_t)k * 6144];
    a0 += sc[k] * wv; a1 += sc[1024 + k] * wv; a2 += sc[2048 + k] * wv; a3 += sc[3072 + k] * wv; a4 += sc[4096 + k] * wv;
  }
  red[(wave * 5 + 0) * 64 + lane] = a0; red[(wave * 5 + 1) * 64 + lane] = a1; red[(wave * 5 + 2) * 64 + lane] = a2;
  red[(wave * 5 + 3) * 64 + lane] = a3; red[(wave * 5 + 4) * 64 + lane] = a4;
  __syncthreads();
  float* mod = (float*)(p.ws + OFF_MOD);
  for (int i = tid; i < 320; i += 256) {
    int s = i >> 6, ln = i & 63;
    float v = red[(0 * 5 + s) * 64 + ln] + red[(1 * 5 + s) * 64 + ln] + red[(2 * 5 + s) * 64 + ln] + red[(3 * 5 + s) * 64 + ln];
    int nc = cb * 64 + ln;
    mod[(size_t)(l * 5 + s) * 6144 + nc] = v + p.b_ada[l * 6144 + nc];
  }
}

DI void task_rope(const Params& p, int task) {
  int e = task * 256 + threadIdx.x;
  int t = e >> 5, i = e & 31;
  float pos = (i < 16) ? (float)(t >> 6) : (float)(t & 63);
  float inv = exp2f(-(float)(i & 15) * (13.287712379549449f / 16.0f));
  float ang = pos * inv;
  float kq = rintf(ang * 0.15915494309189535f);
  float rr = fmaf(-kq, 6.28125f, ang);
  rr = fmaf(-kq, 0.0019353071795864769f, rr);
  float s = sinf(rr), c = cosf(rr);
  float* rc = (float*)(p.ws + OFF_ROPE);
  rc[e] = c; rc[SEQ * 32 + e] = s;
}

DI void conv_tile(const float* __restrict__ src, int K, int N, int kt, int nt, u16* __restrict__ dst, int mode, int R, char* lds) {
  float* tile = (float*)lds;
  const int tid = threadIdx.x;
  const int k0 = kt * 64, n0 = nt * 64;
  __syncthreads();
  {
    float4 v[4];
#pragma unroll
    for (int i = 0; i < 4; i++) {
      int idx = tid + 256 * i, kk = idx >> 4, n4 = (idx & 15) * 4;
      v[i] = float4{0.f, 0.f, 0.f, 0.f};
      if (n0 + n4 < N) v[i] = *(const float4*)(src + (size_t)(k0 + kk) * N + n0 + n4);
    }
#pragma unroll
    for (int i = 0; i < 4; i++) {
      int idx = tid + 256 * i, kk = idx >> 4, n4 = (idx & 15) * 4;
      float* t = tile + kk * 65 + n4;
      t[0] = v[i].x; t[1] = v[i].y; t[2] = v[i].z; t[3] = v[i].w;
    }
  }
  __syncthreads();
#pragma unroll
  for (int i = 0; i < 2; i++) {
    int cidx = tid + 256 * i, nn = cidx >> 3, kc = cidx & 7;
    int ncol = n0 + nn;
    if (ncol < N) {
      int drow = ncol;
      if (mode == 1) {
        int up = ncol >= FH, j = up ? ncol - FH : ncol;
        drow = (j >> 7) * 256 + ((j >> 6) & 1) * 128 + up * 64 + (j & 63);
      }
      uint4 o;
      o.x = pack2(tile[(kc * 8 + 0) * 65 + nn], tile[(kc * 8 + 1) * 65 + nn]);
      o.y = pack2(tile[(kc * 8 + 2) * 65 + nn], tile[(kc * 8 + 3) * 65 + nn]);
      o.z = pack2(tile[(kc * 8 + 4) * 65 + nn], tile[(kc * 8 + 5) * 65 + nn]);
      o.w = pack2(tile[(kc * 8 + 6) * 65 + nn], tile[(kc * 8 + 7) * 65 + nn]);
      const int kd = k0 + kc * 8;
      if (R > 0) *(uint4*)(dst + ((size_t)(kd >> 5) * R + drow) * 32 + (kd & 31)) = o;
      else *(uint4*)(dst + (size_t)drow * K + kd) = o;
    }
  }
}

constexpr int CONV1_TASKS = 976 + 768 + 384 + 256 + 1;
constexpr int CONV2_TASKS = 1408 + 704;
DI void task_conv1(const Params& p, int l, int t, char* lds) {
  if (t < 976) { conv_tile(p.w_in + (size_t)l * D * INT, D, INT, t / 61, t % 61, (u16*)(p.ws + OFF_WIN), 0, INTP, lds); return; }
  t -= 976;
  if (t < 768) { conv_tile(p.w_merge + (size_t)l * D * 3072, D, 3072, t / 48, t % 48, (u16*)(p.ws + OFF_WMG), 0, 3072, lds); return; }
  t -= 768;
  if (t < 384) {
    int br = t / 128, tt = t % 128;
    const float* src = (br == 0 ? p.w_ba : br == 1 ? p.w_bb : p.w_bc) + (size_t)l * 512 * D;
    conv_tile(src, 512, D, tt / 16, tt % 16, (u16*)(p.ws + OFF_WBR) + (size_t)br * 1024 * 512, 0, 0, lds);
    return;
  }
  t -= 384;
  if (t < 256) { conv_tile(p.w_out + (size_t)l * D * D, D, D, t / 16, t % 16, (u16*)(p.ws + OFF_WOUT), 0, D, lds); return; }
  uint4 z = {0, 0, 0, 0};
  for (int i = threadIdx.x; i < 32 * (INTP - INT) * 4; i += 256) {
    const int ch = i / ((INTP - INT) * 4), off = i % ((INTP - INT) * 4);
    *(uint4*)((u16*)(p.ws + OFF_WIN) + ((size_t)ch * INTP + INT) * 32 + off * 8) = z;
  }
}
DI void task_conv2(const Params& p, int l, int t, char* lds) {
  if (t < 1408) { conv_tile(p.w_ffn_in + (size_t)l * D * 2 * FH, D, 2 * FH, t / 88, t % 88, (u16*)(p.ws + OFF_WF1), 1, 2 * FH, lds); return; }
  t -= 1408;
  conv_tile(p.w_ffn_out + (size_t)l * FH * D, FH, D, t / 16, t % 16, (u16*)(p.ws + OFF_WF2), 0, D, lds);
}

DI void task_norm(const Params& p, int l, int task, int which) {
  const int lane = threadIdx.x & 63, wave = threadIdx.x >> 6;
  const int row = task * 4 + wave;
  const float* xr = which == 0 ? xsrc(p, l, row) : (const float*)xdst(p, row);
  const float* g = (which == 0 ? p.norm_mix : p.norm_ffn) + l * D;
  const float* md = modp(p, l, row) + (which ? 3 * D : 0);
  float4 v[4];
  float ss = 0.f;
#pragma unroll
  for (int i = 0; i < 4; i++) {
    v[i] = *(const float4*)(xr + i * 256 + lane * 4);
    ss += v[i].x * v[i].x + v[i].y * v[i].y + v[i].z * v[i].z + v[i].w * v[i].w;
  }
  ss = wave_sum(ss);
  const float rstd = rsqrtf(ss * (1.0f / 1024.0f) + 1e-6f);
  u16* hb = (u16*)(p.ws + OFF_HB) + (size_t)row * 32;
#pragma unroll
  for (int i = 0; i < 4; i++) {
    int cidx = i * 256 + lane * 4;
    float4 gg = *(const float4*)(g + cidx), sh = *(const float4*)(md + cidx), sc = *(const float4*)(md + D + cidx);
    float o0 = v[i].x * rstd * gg.x * (1.f + sc.x) + sh.x;
    float o1 = v[i].y * rstd * gg.y * (1.f + sc.y) + sh.y;
    float o2 = v[i].z * rstd * gg.z * (1.f + sc.z) + sh.z;
    float o3 = v[i].w * rstd * gg.w * (1.f + sc.w) + sh.w;
    uint2 o; o.x = pack2(o0, o1); o.y = pack2(o2, o3);
    *(uint2*)(hb + (size_t)(cidx >> 5) * NTOK * 32 + (cidx & 31)) = o;
  }
}
DI void task_final_norm(const Params& p, int task) {
  const int lane = threadIdx.x & 63, wave = threadIdx.x >> 6;
  const int row = task * 4 + wave;
  float* xr = p.out + (size_t)row * D;
  float4 v[4];
  float ss = 0.f;
#pragma unroll
  for (int i = 0; i < 4; i++) {
    v[i] = *(const float4*)(xr + i * 256 + lane * 4);
    ss += v[i].x * v[i].x + v[i].y * v[i].y + v[i].z * v[i].z + v[i].w * v[i].w;
  }
  ss = wave_sum(ss);
  const float rstd = rsqrtf(ss * (1.0f / 1024.0f) + 1e-6f);
#pragma unroll
  for (int i = 0; i < 4; i++) {
    int cidx = i * 256 + lane * 4;
    float4 gg = *(const float4*)(p.final_norm + cidx);
    float4 o = {v[i].x * rstd * gg.x, v[i].y * rstd * gg.y, v[i].z * rstd * gg.z, v[i].w * rstd * gg.w};
    *(float4*)(xr + cidx) = o;
  }
}

DI void task_g1(const Params& p, int l, int tile, char* lds) {
  const int mt = tile / 15, nt = tile % 15;
  const int tid = threadIdx.x, lane = tid & 63, wave = tid >> 6;
  const int wm = wave >> 1, wn = wave & 1, g = lane >> 4, n = lane & 15;
  f32x4 acc[4][8];
#pragma unroll
  for (int i = 0; i < 4; i++)
#pragma unroll
    for (int j = 0; j < 8; j++) acc[i][j] = f32x4{0.f, 0.f, 0.f, 0.f};
  gemm_wide((const u16*)(p.ws + OFF_HB) + (size_t)mt * 128 * 32, NTOK, (const u16*)(p.ws + OFF_WIN) + (size_t)nt * 256 * 32, INTP, D, acc, lds);
  const int cw = nt * 256 + wn * 128;
  const int rw = mt * 128 + wm * 64;
  if (mt < 128) {
    const float* rc = (const float*)(p.ws + OFF_ROPE);
    const float* rs = rc + SEQ * 32;
#pragma unroll
    for (int hh = 0; hh < 2; hh++) {
      if (cw + hh * 64 >= 640) continue;
#pragma unroll
      for (int mi = 0; mi < 4; mi++)
#pragma unroll
        for (int ni = 0; ni < 2; ni++)
#pragma unroll
          for (int r = 0; r < 4; r++) {
            int t = (rw + mi * 16 + 4 * g + r) & 4095;
            float c = rc[t * 32 + ni * 16 + n], sn = rs[t * 32 + ni * 16 + n];
            float x1 = acc[mi][hh * 4 + ni][r], x2 = acc[mi][hh * 4 + ni + 2][r];
            acc[mi][hh * 4 + ni][r] = x1 * c - x2 * sn;
            acc[mi][hh * 4 + ni + 2][r] = x1 * sn + x2 * c;
          }
    }
  }
  u16* PN = (u16*)(p.ws + OFF_PN);
  u16* VT = (u16*)(p.ws + OFF_VT);
  u16* VTc = (u16*)(p.ws + OFF_VTC);
#pragma unroll
  for (int ni = 0; ni < 8; ni++) {
    const int c16 = cw + ni * 16;
    if (c16 >= INT) continue;
    int tr = -1, nat = 0;
    if (c16 < 640) nat = c16;
    else if (c16 < 768) tr = c16 - 640;
    else if (c16 < 1280) nat = c16 - 128;
    else if (c16 < 1792) tr = 128 + c16 - 1280;
    else if (c16 < 3360) nat = c16 - 640;
    else tr = 640 + c16 - 3360;
#pragma unroll
    for (int mi = 0; mi < 4; mi++) {
      const int row0 = rw + mi * 16 + 4 * g;
      if (tr < 0) {
#pragma unroll
        for (int r = 0; r < 4; r++) PN[(size_t)(row0 + r) * PNLD + nat + n] = f2bf(acc[mi][ni][r]);
      } else {
        uint2 o; o.x = pack2(acc[mi][ni][0], acc[mi][ni][1]); o.y = pack2(acc[mi][ni][2], acc[mi][ni][3]);
        if (mt < 128) {
          int b = row0 >> 12, tok = row0 & 4095;
          *(uint2*)(VT + ((size_t)(b * VTR + tr + n)) * SEQ + tok) = o;
        } else {
          int rr = row0 - NLAT, b = rr >> 8, tok = rr & 255;
          *(uint2*)(VTc + ((size_t)(b * VTR + tr + n)) * LC + tok) = o;
        }
      }
    }
  }
}

DI void task_g1_tail(const Params& p, int l, int mt, char* lds) {
  const int tid = threadIdx.x, lane = tid & 63, wave = tid >> 6;
  const int wm = wave >> 1, wn = wave & 1, g = lane >> 4, n = lane & 15;
  f32x4 acc[4][2];
  zero_acc<2>(acc);
  gemm_tile<2, 1>((const u16*)(p.ws + OFF_HB) + (size_t)mt * 128 * 32, NTOK, (const u16*)(p.ws + OFF_WIN) + (size_t)3840 * 32, INTP, D, acc, lds);
  if (wn != 0) return;
  u16* VT = (u16*)(p.ws + OFF_VT);
  u16* VTc = (u16*)(p.ws + OFF_VTC);
#pragma unroll
  for (int ni = 0; ni < 2; ni++) {
    const int tr = 640 + (3840 - 3360) + ni * 16;
#pragma unroll
    for (int mi = 0; mi < 4; mi++) {
      const int row0 = mt * 128 + wm * 64 + mi * 16 + 4 * g;
      uint2 o; o.x = pack2(acc[mi][ni][0], acc[mi][ni][1]); o.y = pack2(acc[mi][ni][2], acc[mi][ni][3]);
      if (mt < 128) {
        int b = row0 >> 12, tok = row0 & 4095;
        *(uint2*)(VT + ((size_t)(b * VTR + tr + n)) * SEQ + tok) = o;
      } else {
        int rr = row0 - NLAT, b = rr >> 8, tok = rr & 255;
        *(uint2*)(VTc + ((size_t)(b * VTR + tr + n)) * LC + tok) = o;
      }
    }
  }
}

constexpr float QSC = 0.125f * LOG2E;

template <class QF, class OF, class M0F, class TileFn, class ScoreFn, class SkipFn>
DI void attn_core4(QF qptr, OF optr, M0F m0f, float l0, int ntiles, TileFn tilefn, ScoreFn scorefn, SkipFn skipfn) {
  const int lane = threadIdx.x & 63, g = lane >> 4, n = lane & 15;
  bf16x8 qf[4][2];
  f32x4 o[4][4];
  float m[4], ls[4];
#pragma unroll
  for (int gi = 0; gi < 4; gi++) {
    const u16* q = qptr(gi);
    qf[gi][0] = *(const bf16x8*)(q + (size_t)n * PNLD + g * 8);
    qf[gi][1] = *(const bf16x8*)(q + (size_t)n * PNLD + 32 + g * 8);
#pragma unroll
    for (int i = 0; i < 4; i++) o[gi][i] = f32x4{0.f, 0.f, 0.f, 0.f};
    m[gi] = m0f(gi);
    ls[gi] = (g == 0) ? l0 : 0.f;
  }
  const u16* kp; const u16* vp; int vld, aux;
  tilefn(0, kp, vp, vld, aux);
  bf16x8 kn0, kn1, kn2, kn3;
  s16x4 vn0, vn1, vn2, vn3, vn4, vn5, vn6, vn7;
#define LOADK()                                                                     \
  {                                                                                 \
    const u16* kr = kp + (size_t)n * PNLD + g * 8;                                  \
    kn0 = *(const bf16x8*)(kr); kn1 = *(const bf16x8*)(kr + (size_t)16 * PNLD);     \
    kn2 = *(const bf16x8*)(kr + 32); kn3 = *(const bf16x8*)(kr + (size_t)16 * PNLD + 32); \
  }
#define LOADV()                                                                     \
  {                                                                                 \
    const u16* vr = vp + (size_t)n * vld + 4 * g;                                   \
    vn0 = *(const s16x4*)(vr); vn1 = *(const s16x4*)(vr + 16);                      \
    vn2 = *(const s16x4*)(vr + (size_t)16 * vld); vn3 = *(const s16x4*)(vr + (size_t)16 * vld + 16); \
    vn4 = *(const s16x4*)(vr + (size_t)32 * vld); vn5 = *(const s16x4*)(vr + (size_t)32 * vld + 16); \
    vn6 = *(const s16x4*)(vr + (size_t)48 * vld); vn7 = *(const s16x4*)(vr + (size_t)48 * vld + 16); \
  }
  LOADK();
  LOADV();
#pragma unroll 1
  for (int t = 0; t < ntiles; t++) {
    const int auxc = aux;
    const bool more = t + 1 < ntiles;
    bf16x8 vf[4];
    vf[0] = __builtin_shufflevector(vn0, vn1, 0, 1, 2, 3, 4, 5, 6, 7);
    vf[1] = __builtin_shufflevector(vn2, vn3, 0, 1, 2, 3, 4, 5, 6, 7);
    vf[2] = __builtin_shufflevector(vn4, vn5, 0, 1, 2, 3, 4, 5, 6, 7);
    vf[3] = __builtin_shufflevector(vn6, vn7, 0, 1, 2, 3, 4, 5, 6, 7);
#pragma unroll
    for (int hf = 0; hf < 2; hf++) {
      f32x4 s0[2], s1[2];
#pragma unroll
      for (int gg = 0; gg < 2; gg++) {
        const int gi = hf * 2 + gg;
        s0[gg] = f32x4{0.f, 0.f, 0.f, 0.f}; s1[gg] = f32x4{0.f, 0.f, 0.f, 0.f};
        if (skipfn(gi, auxc)) continue;
        s0[gg] = MFMA16(kn0, qf[gi][0], s0[gg]); s1[gg] = MFMA16(kn1, qf[gi][0], s1[gg]);
        s0[gg] = MFMA16(kn2, qf[gi][1], s0[gg]); s1[gg] = MFMA16(kn3, qf[gi][1], s1[gg]);
      }
      if (hf == 1 && more) { tilefn(t + 1, kp, vp, vld, aux); LOADK(); }
#pragma unroll
      for (int gg = 0; gg < 2; gg++) {
        const int gi = hf * 2 + gg;
        if (skipfn(gi, auxc)) continue;
        float sc[8];
#pragma unroll
        for (int r = 0; r < 4; r++) {
          sc[r] = scorefn(gi, auxc, 4 * g + r, n, s0[gg][r]);
          sc[4 + r] = scorefn(gi, auxc, 16 + 4 * g + r, n, s1[gg][r]);
        }
        float mx = fmaxf(fmaxf(fmaxf(sc[0], sc[1]), fmaxf(sc[2], sc[3])), fmaxf(fmaxf(sc[4], sc[5]), fmaxf(sc[6], sc[7])));
        mx = fmaxf(mx, __shfl_xor(mx, 16, 64));
        mx = fmaxf(mx, __shfl_xor(mx, 32, 64));
        const float mn = fmaxf(m[gi], mx);
        const float alpha = __builtin_amdgcn_exp2f(m[gi] - mn);
        float pv[8], ps = 0.f;
#pragma unroll
        for (int r = 0; r < 8; r++) { pv[r] = __builtin_amdgcn_exp2f(sc[r] - mn); ps += pv[r]; }
        ls[gi] = ls[gi] * alpha + ps;
        m[gi] = mn;
        union { bf16x8 v; unsigned u[4]; } pf;
        pf.u[0] = pack2(pv[0], pv[1]); pf.u[1] = pack2(pv[2], pv[3]); pf.u[2] = pack2(pv[4], pv[5]); pf.u[3] = pack2(pv[6], pv[7]);
#pragma unroll
        for (int d4 = 0; d4 < 4; d4++) {
          o[gi][d4] *= alpha;
          o[gi][d4] = MFMA16(vf[d4], pf.v, o[gi][d4]);
        }
      }
    }
    if (more) LOADV();
  }
#undef LOADK
#undef LOADV
#pragma unroll
  for (int gi = 0; gi < 4; gi++) {
    float lsum = ls[gi];
    lsum += __shfl_xor(lsum, 16, 64);
    lsum += __shfl_xor(lsum, 32, 64);
    const float inv = 1.0f / lsum;
    u16* ob = optr(gi);
#pragma unroll
    for (int d4 = 0; d4 < 4; d4++) {
      uint2 w; w.x = pack2(o[gi][d4][0] * inv, o[gi][d4][1] * inv); w.y = pack2(o[gi][d4][2] * inv, o[gi][d4][3] * inv);
      *(uint2*)(ob + (size_t)n * 512 + d4 * 16 + 4 * g) = w;
    }
  }
}

DI void attn_a_latent(const Params& p, int l, int wt) {
  wt = __builtin_amdgcn_readfirstlane(wt);
  const int kvh = wt & 1, qt = (wt >> 1) & 255, b = wt >> 9, q0 = qt * 16;
  const u16* PN = (const u16*)(p.ws + OFF_PN);
  const u16* VT = (const u16*)(p.ws + OFF_VT);
  const u16* VTc = (const u16*)(p.ws + OFF_VTC);
  int jlo = (q0 - 128) & ~31; if (jlo < 0) jlo = 0;
  int jhi = (q0 + 144 + 31) & ~31; if (jhi > SEQ) jhi = SEQ;
  const int ntiles = 8 + (jhi - jlo) / 32;
  const u16* kc = PN + (size_t)(NLAT + b * LC) * PNLD + 512 + kvh * 64;
  const u16* kl = PN + (size_t)(b * SEQ) * PNLD + 512 + kvh * 64;
  const u16* vc = VTc + (size_t)(b * VTR + kvh * 64) * LC;
  const u16* vl = VT + (size_t)(b * VTR + kvh * 64) * SEQ;
  const u16* qb = PN + (size_t)(b * SEQ + q0) * PNLD + kvh * 256;
  u16* ob = (u16*)(p.ws + OFF_Y) + (size_t)(b * SEQ + q0) * 512 + kvh * 256;
  const float* sk = p.sink + l * 8 + kvh * 4;
  auto tilefn = [&](int t, const u16*& kp, const u16*& vp, int& vld, int& aux) {
    if (t < 8) { kp = kc + (size_t)(t * 32) * PNLD; vp = vc + t * 32; vld = LC; aux = -1; }
    else { int j0 = jlo + (t - 8) * 32; kp = kl + (size_t)j0 * PNLD; vp = vl + j0; vld = SEQ; aux = j0; }
  };
  auto scorefn = [&](int gi, int aux, int kidx, int n, float dot) -> float {
    float s = dot * QSC;
    if (aux >= 0) { int dj = aux + kidx - (q0 + n); if (dj > 128 || dj < -128) s = -INFINITY; }
    return s;
  };
  attn_core4([&](int gi) { return qb + gi * 64; }, [&](int gi) { return ob + gi * 64; }, [&](int gi) { return sk[gi] * LOG2E; }, 1.0f,
             ntiles, tilefn, scorefn, [&](int gi, int aux) { return false; });
}

DI void attn_c_latent(const Params& p, int l, int wt, char* lds) {
  wt = __builtin_amdgcn_readfirstlane(wt);
  const int head = wt & 7, r = (wt >> 3) & 63, b = wt >> 9;
  const u16* PN = (const u16*)(p.ws + OFF_PN);
  const u16* VT = (const u16*)(p.ws + OFF_VT);
  const u16* VTc = (const u16*)(p.ws + OFF_VTC);
  int rs = r - 4; rs = rs < 0 ? 0 : (rs > 56 ? 56 : rs);
  const int tok0 = b * SEQ + r * 64;
  const u16* kc = PN + (size_t)(NLAT + b * LC) * PNLD + 2208 + head * 64;
  const u16* kl = PN + (size_t)(b * SEQ) * PNLD + 2208 + head * 64;
  const u16* vc = VTc + (size_t)(b * VTR + 640 + head * 64) * LC;
  const u16* vl = VT + (size_t)(b * VTR + 640 + head * 64) * SEQ;
  float* rpb = (float*)(lds + (threadIdx.x >> 6) * 2048);
  {
    const float* src = p.rpb + (size_t)(l * 8 + head) * 15 * 31;
    const int lane_ = threadIdx.x & 63;
    for (int i = lane_; i < 465; i += 64) rpb[i] = src[i] * LOG2E;
  }
  const u16* qb = PN + (size_t)tok0 * PNLD + 1696 + head * 64;
  u16* ob = (u16*)(p.ws + OFF_Y) + (size_t)2 * NTOK * 512 + (size_t)tok0 * 512 + head * 64;
  auto tilefn = [&](int t, const u16*& kp, const u16*& vp, int& vld, int& aux) {
    if (t < 8) { kp = kc + (size_t)(t * 32) * PNLD; vp = vc + t * 32; vld = LC; aux = -1; }
    else { int a = t - 8; int tk = (rs + (a >> 1)) * 64 + (a & 1) * 32; kp = kl + (size_t)tk * PNLD; vp = vl + tk; vld = SEQ; aux = a; }
  };
  auto scorefn = [&](int gi, int aux, int kidx, int n, float dot) -> float {
    float s = dot * QSC;
    if (aux >= 0) {
      int kcol = (aux & 1) * 32 + kidx, qcol = gi * 16 + n;
      int wsx = qcol - 8; wsx = wsx < 0 ? 0 : (wsx > 48 ? 48 : wsx);
      int drow = rs + (aux >> 1) - r + 7;
      int dc = kcol - qcol; dc = dc < -15 ? -15 : (dc > 15 ? 15 : dc);
      float bias = rpb[drow * 31 + dc + 15];
      s = (kcol >= wsx && kcol < wsx + 16) ? s + bias : -INFINITY;
    }
    return s;
  };
  attn_core4([&](int gi) { return qb + (size_t)gi * 16 * PNLD; }, [&](int gi) { return ob + (size_t)gi * 16 * 512; },
             [&](int gi) { return -INFINITY; }, 0.0f, 24, tilefn, scorefn,
             [&](int gi, int aux) { return aux >= 0 && ((gi == 0 && (aux & 1)) || (gi == 3 && !(aux & 1))); });
}

DI void attn_ctx(const Params& p, int l, int wt, int which) {
  wt = __builtin_amdgcn_readfirstlane(wt);
  const u16* PN = (const u16*)(p.ws + OFF_PN);
  const u16* VTc = (const u16*)(p.ws + OFF_VTC);
  if (which == 0) {
    const int kvh = wt & 1, qt = (wt >> 1) & 15, b = wt >> 5;
    const int row0 = NLAT + b * LC + qt * 16;
    const u16* kc = PN + (size_t)(NLAT + b * LC) * PNLD + 512 + kvh * 64;
    const u16* vc = VTc + (size_t)(b * VTR + kvh * 64) * LC;
    const u16* qb = PN + (size_t)row0 * PNLD + kvh * 256;
    u16* ob = (u16*)(p.ws + OFF_Y) + (size_t)row0 * 512 + kvh * 256;
    const float* sk = p.sink + l * 8 + kvh * 4;
    attn_core4([&](int gi) { return qb + gi * 64; }, [&](int gi) { return ob + gi * 64; }, [&](int gi) { return sk[gi] * LOG2E; }, 1.0f, 8,
               [&](int t, const u16*& kp, const u16*& vp, int& vld, int& aux) { kp = kc + (size_t)(t * 32) * PNLD; vp = vc + t * 32; vld = LC; aux = -1; },
               [&](int gi, int aux, int kidx, int n, float dot) -> float { return dot * QSC; }, [&](int gi, int aux) { return false; });
  } else {
    const int head = wt & 7, q4 = (wt >> 3) & 3, b = wt >> 5;
    const int row0 = NLAT + b * LC + q4 * 64;
    const u16* kc = PN + (size_t)(NLAT + b * LC) * PNLD + 2208 + head * 64;
    const u16* vc = VTc + (size_t)(b * VTR + 640 + head * 64) * LC;
    const u16* qb = PN + (size_t)row0 * PNLD + 1696 + head * 64;
    u16* ob = (u16*)(p.ws + OFF_Y) + (size_t)2 * NTOK * 512 + (size_t)row0 * 512 + head * 64;
    attn_core4([&](int gi) { return qb + (size_t)gi * 16 * PNLD; }, [&](int gi) { return ob + (size_t)gi * 16 * 512; },
               [&](int gi) { return -INFINITY; }, 0.0f, 8,
               [&](int t, const u16*& kp, const u16*& vp, int& vld, int& aux) { kp = kc + (size_t)(t * 32) * PNLD; vp = vc + t * 32; vld = LC; aux = -1; },
               [&](int gi, int aux, int kidx, int n, float dot) -> float { return dot * QSC; }, [&](int gi, int aux) { return false; });
  }
}

constexpr int G_QS = 0, G_KS = 9216, G_KT = 18432, G_VT = 27648, G_ZL = 36864, G_TOT = 40960, G_DEC = 41984, G_END = 42240;
constexpr int NE = 4;
constexpr size_t OFF_SL = OFF_Y + (size_t)2 * NTOK * 512 * 2;
constexpr size_t OFF_DS = OFF_PAD + (524288u);

template <int PASS>
DI void task_gla(const Params& p, int l, int id, char* lds) {
  int seg, rest;
  if (PASS == 1) { seg = id & 15; rest = id >> 4; } else { seg = 16 - (id % 17); rest = id / 17; }
  const int sl = rest & 1, dir = (rest >> 1) & 1, h = (rest >> 2) & 3, b = rest >> 4, combo = rest >> 1;
  const int tid = threadIdx.x, lane = tid & 63, wave = tid >> 6, g = lane >> 4, n = lane & 15;
  const u16* PN = (const u16*)(p.ws + OFF_PN);
  u16* odst = dir ? (u16*)(p.ws + OFF_OB) : (u16*)(p.ws + OFF_Y) + (size_t)NTOK * 512;
  float* SL = (float*)(p.ws + OFF_SL);
  float* DS = (float*)(p.ws + OFF_DS);
  const float* gwp = (dir ? p.gw_b : p.gw_f) + (size_t)l * 16 * 256 + h * 64 + lane;
  const float* gbp = (dir ? p.gb_b : p.gb_f) + l * 256 + h * 64 + lane;
  f32x4 S[4][NE];
#pragma unroll
  for (int i = 0; i < 4; i++)
#pragma unroll
    for (int j = 0; j < NE; j++) S[i][j] = f32x4{0.f, 0.f, 0.f, 0.f};
  if (PASS == 2) {
    const float* sl_src = SL + ((size_t)(rest * 17 + seg)) * (1024 * NE) + lane * 4;
#pragma unroll
    for (int dt = 0; dt < 4; dt++)
#pragma unroll
      for (int et = 0; et < NE; et++) S[dt][et] = *(const f32x4*)(sl_src + (dt * NE + et) * 256);
  }
  float* ZL = (float*)(lds + G_ZL);
  float* TOT = (float*)(lds + G_TOT);
  float* DEC = (float*)(lds + G_DEC);
  float totsum = 0.f;

  int tb = 0, rowbase = 0;
  uint4 rq0, rq1, rk0, rk1, rz, rv, rv2;
  rq0 = rq1 = rz = uint4{0, 0, 0, 0};
  auto gload = [&](int ch) {
    int vld; const u16* vsrc;
    if (ch < 4) {
      tb = dir ? 192 - 64 * ch : 64 * ch; rowbase = NLAT + b * LC; vld = LC;
      vsrc = (const u16*)(p.ws + OFF_VTC) + (size_t)(b * VTR + 128 + h * 128 + sl * 64) * LC;
    } else {
      tb = dir ? SEQ - 64 * (ch - 3) : 64 * (ch - 4); rowbase = b * SEQ; vld = SEQ;
      vsrc = (const u16*)(p.ws + OFF_VT) + (size_t)(b * VTR + 128 + h * 128 + sl * 64) * SEQ;
    }
    {
      int row = tid >> 3, kc = tid & 7;
      int tok0 = dir ? tb + 63 - row : tb + row, tok1 = dir ? tb + 31 - row : tb + 32 + row;
      const u16* s0 = PN + (size_t)(rowbase + tok0) * PNLD + h * 64 + kc * 8;
      const u16* s1 = PN + (size_t)(rowbase + tok1) * PNLD + h * 64 + kc * 8;
      if (PASS == 2) { rq0 = *(const uint4*)(s0 + 640); rq1 = *(const uint4*)(s1 + 640); }
      rk0 = *(const uint4*)(s0 + 896); rk1 = *(const uint4*)(s1 + 896);
    }
    if (tid < 128) {
      int row = tid >> 1, hc = tid & 1;
      int tok = dir ? tb + 63 - row : tb + row;
      rz = *(const uint4*)(PN + (size_t)(rowbase + tok) * PNLD + 1664 + dir * 16 + hc * 8);
    }
    rv = *(const uint4*)(vsrc + (size_t)(tid >> 3) * vld + tb + (tid & 7) * 8);
    rv2 = *(const uint4*)(vsrc + (size_t)(32 + (tid >> 3)) * vld + tb + (tid & 7) * 8);
  };
  gload(seg * 4);

  for (int ci = 0; ci < 4; ci++) {
    const int ctb = tb, crowbase = rowbase;
    float gw[16];
#pragma unroll
    for (int r = 0; r < 16; r++) gw[r] = gwp[r * 256];
    const float gbias = gbp[0];
    __syncthreads();
    {
      int row = tid >> 3, kc = tid & 7;
      if (PASS == 2) {
        *(uint4*)(lds + G_QS + row * LROW + kc * 16) = rq0;
        *(uint4*)(lds + G_QS + (row + 32) * LROW + kc * 16) = rq1;
      }
      *(uint4*)(lds + G_KS + row * LROW + kc * 16) = rk0;
      *(uint4*)(lds + G_KS + (row + 32) * LROW + kc * 16) = rk1;
    }
    if (tid < 128) {
      int row = tid >> 1, hc = tid & 1;
      float* zd = ZL + row * 16 + hc * 8;
      zd[0] = __uint_as_float(rz.x << 16); zd[1] = __uint_as_float(rz.x & 0xffff0000u);
      zd[2] = __uint_as_float(rz.y << 16); zd[3] = __uint_as_float(rz.y & 0xffff0000u);
      zd[4] = __uint_as_float(rz.z << 16); zd[5] = __uint_as_float(rz.z & 0xffff0000u);
      zd[6] = __uint_as_float(rz.w << 16); zd[7] = __uint_as_float(rz.w & 0xffff0000u);
    }
    {
      int e = tid >> 3, kc = tid & 7;
      if (dir) {
        uint4 rr;
        rr.x = (rv.w >> 16) | (rv.w << 16); rr.y = (rv.z >> 16) | (rv.z << 16);
        rr.z = (rv.y >> 16) | (rv.y << 16); rr.w = (rv.x >> 16) | (rv.x << 16);
        *(uint4*)(lds + G_VT + e * LROW + (7 - kc) * 16) = rr;
        rr.x = (rv2.w >> 16) | (rv2.w << 16); rr.y = (rv2.z >> 16) | (rv2.z << 16);
        rr.z = (rv2.y >> 16) | (rv2.y << 16); rr.w = (rv2.x >> 16) | (rv2.x << 16);
        *(uint4*)(lds + G_VT + (32 + e) * LROW + (7 - kc) * 16) = rr;
      } else {
        *(uint4*)(lds + G_VT + e * LROW + kc * 16) = rv;
        *(uint4*)(lds + G_VT + (32 + e) * LROW + kc * 16) = rv2;
      }
    }
    __syncthreads();
    float bv[16];
    {
      float run = 0.f;
#pragma unroll
      for (int tt = 0; tt < 16; tt++) {
        const float4* zr = (const float4*)(ZL + (wave * 16 + tt) * 16);
        float z = gbias;
#pragma unroll
        for (int q = 0; q < 4; q++) {
          float4 zz = zr[q];
          z += zz.x * gw[q * 4 + 0] + zz.y * gw[q * 4 + 1] + zz.z * gw[q * 4 + 2] + zz.w * gw[q * 4 + 3];
        }
        float lsg = fminf(z, 0.f) - __logf(1.0f + __expf(-fabsf(z)));
        run += lsg * (1.0f / 16.0f);
        bv[tt] = run;
      }
      TOT[wave * 64 + lane] = run;
    }
    __syncthreads();
    {
      float off = 0.f, tot = 0.f;
#pragma unroll
      for (int s = 0; s < 4; s++) { float tv = TOT[s * 64 + lane]; if (s < wave) off += tv; tot += tv; }
      totsum += tot;
      const float dtot = __expf(tot);
      if (wave == 0) DEC[lane] = dtot;
      unsigned ktp[8];
#pragma unroll
      for (int tt = 0; tt < 16; tt++) {
        const int t = wave * 16 + tt;
        const float bq = bv[tt] + off;
        u16* ka = (u16*)(lds + G_KS + t * LROW) + lane;
        const float kv = bf2f(*ka);
        const float e1 = __expf(bq), e2 = __builtin_amdgcn_rcpf(e1);
        if (PASS == 2) {
          u16* qa = (u16*)(lds + G_QS + t * LROW) + lane;
          const float qv = bf2f(*qa);
          *qa = f2bf(qv * 0.125f * e1);
          *ka = f2bf(kv * e2);
        }
        const unsigned kt = f2bf(kv * (dtot * e2));
        if (tt & 1) ktp[tt >> 1] |= kt << 16; else ktp[tt >> 1] = kt;
      }
      uint4* kd = (uint4*)(lds + G_KT + lane * LROW + wave * 32);
      kd[0] = uint4{ktp[0], ktp[1], ktp[2], ktp[3]};
      kd[1] = uint4{ktp[4], ktp[5], ktp[6], ktp[7]};
    }
    __syncthreads();
    if (ci < 3) gload(seg * 4 + ci + 1);
    if (PASS == 2) {
      bf16x8 qf[2];
      qf[0] = *(const bf16x8*)(lds + G_QS + (wave * 16 + n) * LROW + g * 16);
      qf[1] = *(const bf16x8*)(lds + G_QS + (wave * 16 + n) * LROW + 64 + g * 16);
      f32x4 X[4];
#pragma unroll
      for (int jt = 0; jt < 4; jt++) {
        X[jt] = f32x4{0.f, 0.f, 0.f, 0.f};
#pragma unroll
        for (int s = 0; s < 2; s++) {
          bf16x8 kf = *(const bf16x8*)(lds + G_KS + (jt * 16 + n) * LROW + s * 64 + g * 16);
          X[jt] = MFMA16(kf, qf[s], X[jt]);
        }
#pragma unroll
        for (int r = 0; r < 4; r++) if (jt * 16 + 4 * g + r > wave * 16 + n) X[jt][r] = 0.f;
      }
      f32x4 o[NE];
#pragma unroll
      for (int et = 0; et < NE; et++) o[et] = f32x4{0.f, 0.f, 0.f, 0.f};
#pragma unroll
      for (int kk = 0; kk < 2; kk++) {
        union { bf16x8 v; unsigned u[4]; } pa;
        pa.u[0] = pack2(X[2 * kk][0], X[2 * kk][1]); pa.u[1] = pack2(X[2 * kk][2], X[2 * kk][3]);
        pa.u[2] = pack2(X[2 * kk + 1][0], X[2 * kk + 1][1]); pa.u[3] = pack2(X[2 * kk + 1][2], X[2 * kk + 1][3]);
        const char* qr = lds + G_QS + (wave * 16 + n) * LROW + kk * 64 + g * 8;
        s16x4 qa = *(const s16x4*)(qr), qb = *(const s16x4*)(qr + 32);
        bf16x8 qp = __builtin_shufflevector(qa, qb, 0, 1, 2, 3, 4, 5, 6, 7);
#pragma unroll
        for (int et = 0; et < NE; et++) {
          const char* vr = lds + G_VT + (et * 16 + n) * LROW + kk * 64 + g * 8;
          s16x4 va = *(const s16x4*)(vr), vb = *(const s16x4*)(vr + 32);
          bf16x8 vf = __builtin_shufflevector(va, vb, 0, 1, 2, 3, 4, 5, 6, 7);
          o[et] = MFMA16(pa.v, vf, o[et]);
          union { bf16x8 v; unsigned u[4]; } sb;
          sb.u[0] = pack2(S[2 * kk][et][0], S[2 * kk][et][1]); sb.u[1] = pack2(S[2 * kk][et][2], S[2 * kk][et][3]);
          sb.u[2] = pack2(S[2 * kk + 1][et][0], S[2 * kk + 1][et][1]); sb.u[3] = pack2(S[2 * kk + 1][et][2], S[2 * kk + 1][et][3]);
          o[et] = MFMA16(qp, sb.v, o[et]);
        }
      }
#pragma unroll
      for (int r = 0; r < 4; r++) {
        int i = wave * 16 + 4 * g + r;
        int tok = dir ? ctb + 63 - i : ctb + i;
        u16* orow = odst + (size_t)(crowbase + tok) * 512 + h * 128 + sl * 64 + n;
#pragma unroll
        for (int et = 0; et < NE; et++) orow[et * 16] = f2bf(o[et][r]);
      }
    }
    if (PASS == 1 || ci < 3) {
      bf16x8 vfr[NE][2];
#pragma unroll
      for (int et = 0; et < NE; et++)
#pragma unroll
        for (int s = 0; s < 2; s++) vfr[et][s] = *(const bf16x8*)(lds + G_VT + (et * 16 + n) * LROW + s * 64 + g * 16);
#pragma unroll
      for (int dt = 0; dt < 4; dt++) {
        bf16x8 kf0 = *(const bf16x8*)(lds + G_KT + (dt * 16 + n) * LROW + g * 16);
        bf16x8 kf1 = *(const bf16x8*)(lds + G_KT + (dt * 16 + n) * LROW + 64 + g * 16);
        const f32x4 dc = *(const f32x4*)(DEC + dt * 16 + 4 * g);
#pragma unroll
        for (int et = 0; et < NE; et++) {
          f32x4 u = {0.f, 0.f, 0.f, 0.f};
          u = MFMA16(kf0, vfr[et][0], u);
          u = MFMA16(kf1, vfr[et][1], u);
          S[dt][et] = S[dt][et] * dc + u;
        }
      }
    }
  }
  if (PASS == 1 && wave == 0) {
    float* dst = SL + ((size_t)(rest * 17 + seg)) * (1024 * NE) + lane * 4;
#pragma unroll
    for (int dt = 0; dt < 4; dt++)
#pragma unroll
      for (int et = 0; et < NE; et++) *(f32x4*)(dst + (dt * NE + et) * 256) = S[dt][et];
    if (sl == 0) DS[(size_t)(combo * 17 + seg) * 64 + lane] = totsum;
  }
}

DI void task_gla_prefix(const Params& p, int rest) {
  const int tid = threadIdx.x, combo = rest >> 1;
  constexpr int SSZ = 1024 * NE;
  float* SL = (float*)(p.ws + OFF_SL) + (size_t)rest * 17 * SSZ + tid * 16;
  const int tile = tid >> 4, g4 = (tid & 15) >> 2;
  const float* DS = (const float*)(p.ws + OFF_DS) + (size_t)combo * 17 * 64 + (tile / NE) * 16 + 4 * g4;
  f32x4 s0 = {0.f, 0.f, 0.f, 0.f}, s1 = s0, s2 = s0, s3 = s0;
#pragma unroll 2
  for (int seg = 0; seg < 16; seg++) {
    float* q = SL + (size_t)seg * SSZ;
    const f32x4 c0 = *(const f32x4*)(q), c1 = *(const f32x4*)(q + 4), c2 = *(const f32x4*)(q + 8), c3 = *(const f32x4*)(q + 12);
    const f32x4 dl = *(const f32x4*)(DS + seg * 64);
    *(f32x4*)(q) = s0; *(f32x4*)(q + 4) = s1; *(f32x4*)(q + 8) = s2; *(f32x4*)(q + 12) = s3;
    const f32x4 dc = {__expf(dl[0]), __expf(dl[1]), __expf(dl[2]), __expf(dl[3])};
    s0 = s0 * dc + c0; s1 = s1 * dc + c1; s2 = s2 * dc + c2; s3 = s3 * dc + c3;
  }
  float* q = SL + (size_t)16 * SSZ;
  *(f32x4*)(q) = s0; *(f32x4*)(q + 4) = s1; *(f32x4*)(q + 8) = s2; *(f32x4*)(q + 12) = s3;
}

DI void task_gla_out(const Params& p, int l, int task) {
  const int lane = threadIdx.x & 63, wave = threadIdx.x >> 6;
  const int row = task * 4 + wave;
  u16* of = (u16*)(p.ws + OFF_Y) + (size_t)NTOK * 512 + (size_t)row * 512 + lane * 8;
  const u16* ob = (const u16*)(p.ws + OFF_OB) + (size_t)row * 512 + lane * 8;
  const u16* gr = (const u16*)(p.ws + OFF_PN) + (size_t)row * PNLD + 1152 + lane * 8;
  uint4 a = *(const uint4*)of, bb = *(const uint4*)ob, rr = *(const uint4*)gr;
  const unsigned au[4] = {a.x, a.y, a.z, a.w}, bu[4] = {bb.x, bb.y, bb.z, bb.w}, ru[4] = {rr.x, rr.y, rr.z, rr.w};
  float v[8], rv[8], ss = 0.f;
#pragma unroll
  for (int i = 0; i < 4; i++) {
    v[2 * i] = __uint_as_float(au[i] << 16) + __uint_as_float(bu[i] << 16);
    v[2 * i + 1] = __uint_as_float(au[i] & 0xffff0000u) + __uint_as_float(bu[i] & 0xffff0000u);
    rv[2 * i] = __uint_as_float(ru[i] << 16);
    rv[2 * i + 1] = __uint_as_float(ru[i] & 0xffff0000u);
    ss += v[2 * i] * v[2 * i] + v[2 * i + 1] * v[2 * i + 1];
  }
  ss += __shfl_xor(ss, 1, 64); ss += __shfl_xor(ss, 2, 64); ss += __shfl_xor(ss, 4, 64); ss += __shfl_xor(ss, 8, 64);
  const float rstd = rsqrtf(ss * (1.0f / 128.0f) + 1e-6f);
  const float* gn = p.gla_norm + l * 128 + (lane & 15) * 8;
  float o[8];
#pragma unroll
  for (int i = 0; i < 8; i++) o[i] = v[i] * rstd * gn[i] * siluf_(rv[i]);
  uint4 w; w.x = pack2(o[0], o[1]); w.y = pack2(o[2], o[3]); w.z = pack2(o[4], o[5]); w.w = pack2(o[6], o[7]);
  *(uint4*)of = w;
}

constexpr size_t OFF_GQ = OFF_ACT;
static_assert(OFF_GQ + (size_t)3072 * NTOK <= OFF_Y, "gate alias");

DI void task_gates(const Params& p, int l, int tile, char* lds) {
  const int mt = tile / 12, nt = tile % 12;
  const int tid = threadIdx.x, lane = tid & 63, wave = tid >> 6;
  const int wm = wave >> 1, wn = wave & 1, g = lane >> 4, n = lane & 15;
  f32x4 acc[4][8];
#pragma unroll
  for (int i = 0; i < 4; i++)
#pragma unroll
    for (int j = 0; j < 8; j++) acc[i][j] = f32x4{0.f, 0.f, 0.f, 0.f};
  gemm_wide((const u16*)(p.ws + OFF_HB) + (size_t)mt * 128 * 32, NTOK, (const u16*)(p.ws + OFF_WMG) + (size_t)nt * 256 * 32, 3072, D, acc, lds);
  unsigned char* GQ = (unsigned char*)(p.ws + OFF_GQ);
  const float* bm = p.b_merge + l * 3072 + nt * 256 + wn * 128 + n;
#pragma unroll
  for (int ni = 0; ni < 8; ni++) {
    const float bias = bm[ni * 16];
    const size_t col = (size_t)(nt * 256 + wn * 128 + ni * 16 + n);
#pragma unroll
    for (int mi = 0; mi < 4; mi++) {
      const int row0 = mt * 128 + wm * 64 + mi * 16 + 4 * g;
      unsigned q0 = (unsigned)(sigmoidf_(acc[mi][ni][0] + bias) * 255.0f + 0.5f);
      unsigned q1 = (unsigned)(sigmoidf_(acc[mi][ni][1] + bias) * 255.0f + 0.5f);
      unsigned q2 = (unsigned)(sigmoidf_(acc[mi][ni][2] + bias) * 255.0f + 0.5f);
      unsigned q3 = (unsigned)(sigmoidf_(acc[mi][ni][3] + bias) * 255.0f + 0.5f);
      *(unsigned*)(GQ + col * NTOK + row0) = q0 | (q1 << 8) | (q2 << 16) | (q3 << 24);
    }
  }
}

DI void task_mg(const Params& p, int l, int tile, char* lds) {
  const int mt = tile >> 3, nt = tile & 7;
  const int tid = threadIdx.x, lane = tid & 63, wave = tid >> 6;
  const int wm = wave >> 1, wn = wave & 1, g = lane >> 4, n = lane & 15;
  f32x4 mix[4][4];
  zero_acc<4>(mix);
  const unsigned char* GQ = (const unsigned char*)(p.ws + OFF_GQ);
#pragma unroll 1
  for (int br = 0; br < 3; br++) {
    f32x4 acc[4][4];
    zero_acc<4>(acc);
    gemm_tile<4, 0>((const u16*)(p.ws + OFF_Y) + (size_t)br * NTOK * 512 + (size_t)mt * 128 * 512, 512,
                 (const u16*)(p.ws + OFF_WBR) + (size_t)br * 1024 * 512 + (size_t)nt * 128 * 512, 512, 512, acc, lds);
#pragma unroll
    for (int ni = 0; ni < 4; ni++) {
      const size_t col = (size_t)(br * 1024 + nt * 128 + wn * 64 + ni * 16 + n);
#pragma unroll
      for (int mi = 0; mi < 4; mi++) {
        const int row0 = mt * 128 + wm * 64 + mi * 16 + 4 * g;
        const unsigned q = *(const unsigned*)(GQ + col * NTOK + row0);
        mix[mi][ni][0] += (float)(q & 255u) * (1.0f / 255.0f) * acc[mi][ni][0];
        mix[mi][ni][1] += (float)((q >> 8) & 255u) * (1.0f / 255.0f) * acc[mi][ni][1];
        mix[mi][ni][2] += (float)((q >> 16) & 255u) * (1.0f / 255.0f) * acc[mi][ni][2];
        mix[mi][ni][3] += (float)(q >> 24) * (1.0f / 255.0f) * acc[mi][ni][3];
      }
    }
  }
  u16* mx = (u16*)(p.ws + OFF_MIXED);
#pragma unroll
  for (int mi = 0; mi < 4; mi++)
#pragma unroll
    for (int ni = 0; ni < 4; ni++)
#pragma unroll
      for (int r = 0; r < 4; r++)
      {
        const int row = mt * 128 + wm * 64 + mi * 16 + 4 * g + r, col = nt * 128 + wn * 64 + ni * 16 + n;
        mx[((size_t)(col >> 5) * NTOK + row) * 32 + (col & 31)] = f2bf(mix[mi][ni][r]);
      }
}

DI void task_res_wide(const Params& p, int l, int tile, const u16* A, int lda, const u16* Wt, int K, int gate_idx, bool first, char* lds) {
  const int mt = tile >> 2, nt = tile & 3;
  const int tid = threadIdx.x, lane = tid & 63, wave = tid >> 6;
  const int wm = wave >> 1, wn = wave & 1, g = lane >> 4, n = lane & 15;
  f32x4 acc[4][8];
#pragma unroll
  for (int i = 0; i < 4; i++)
#pragma unroll
    for (int j = 0; j < 8; j++) acc[i][j] = f32x4{0.f, 0.f, 0.f, 0.f};
  gemm_wide(A + (size_t)mt * 128 * 32, NTOK, Wt + (size_t)nt * 256 * 32, D, K, acc, lds);
  const float* gt = modp(p, l, mt * 128) + gate_idx * D + nt * 256 + wn * 128 + n;
#pragma unroll
  for (int ni = 0; ni < 8; ni++) {
    const float gv = gt[ni * 16];
#pragma unroll
    for (int mi = 0; mi < 4; mi++)
#pragma unroll
      for (int r = 0; r < 4; r++) {
        int row = mt * 128 + wm * 64 + mi * 16 + 4 * g + r, col = nt * 256 + wn * 128 + ni * 16 + n;
        const float* xs = first ? xsrc(p, l, row) : (const float*)xdst(p, row);
        xdst(p, row)[col] = xs[col] + gv * acc[mi][ni][r];
      }
  }
}

DI void task_res_ctx(const Params& p, int l, int tile, const u16* A, int lda, const u16* Wt, int K, int gate_idx, bool first, char* lds) {
  const int mt = 128 + (tile >> 4), nt = tile & 15;
  const int tid = threadIdx.x, lane = tid & 63, wave = tid >> 6;
  const int wm = wave >> 1, wn = wave & 1, g = lane >> 4, n = lane & 15;
  f32x4 acc[4][2];
  zero_acc<2>(acc);
  gemm_tile<2, 1>(A + (size_t)mt * 128 * 32, NTOK, Wt + (size_t)nt * 64 * 32, D, K, acc, lds);
  const float* gt = modp(p, l, mt * 128) + gate_idx * D + nt * 64 + wn * 32 + n;
#pragma unroll
  for (int ni = 0; ni < 2; ni++) {
    const float gv = gt[ni * 16];
#pragma unroll
    for (int mi = 0; mi < 4; mi++)
#pragma unroll
      for (int r = 0; r < 4; r++) {
        int row = mt * 128 + wm * 64 + mi * 16 + 4 * g + r, col = nt * 64 + wn * 32 + ni * 16 + n;
        const float* xs = first ? xsrc(p, l, row) : (const float*)xdst(p, row);
        xdst(p, row)[col] = xs[col] + gv * acc[mi][ni][r];
      }
  }
}

DI void task_f1(const Params& p, int tile, char* lds) {
  const int mt = tile / 22, nt = tile % 22;
  const int tid = threadIdx.x, lane = tid & 63, wave = tid >> 6;
  const int wm = wave >> 1, wn = wave & 1, g = lane >> 4, n = lane & 15;
  f32x4 acc[4][8];
#pragma unroll
  for (int i = 0; i < 4; i++)
#pragma unroll
    for (int j = 0; j < 8; j++) acc[i][j] = f32x4{0.f, 0.f, 0.f, 0.f};
  gemm_wide((const u16*)(p.ws + OFF_HB) + (size_t)mt * 128 * 32, NTOK, (const u16*)(p.ws + OFF_WF1) + (size_t)nt * 256 * 32, 2 * FH, D, acc, lds);
  u16* act = (u16*)(p.ws + OFF_ACT);
#pragma unroll
  for (int mi = 0; mi < 4; mi++)
#pragma unroll
    for (int ni = 0; ni < 4; ni++)
#pragma unroll
      for (int r = 0; r < 4; r++) {
        int row = mt * 128 + wm * 64 + mi * 16 + 4 * g + r, col = nt * 128 + wn * 64 + ni * 16 + n;
        act[((size_t)(col >> 5) * NTOK + row) * 32 + (col & 31)] = f2bf(siluf_(acc[mi][ni][r]) * acc[mi][ni + 4][r]);
      }
}

#define XB_TMO      128
#define XB_XCNT(j)  (256  + 64 * (j))
#define XB_XSUB(j)  (1280 + 64 * (j))
#define XB_XGEN(j)  (2304 + 64 * (j))
#define XB_TOP      3328
#define XB_TOPGEN   3392
#define XCD_BAR_WORDS 3456
#define XB_SPIN_CAP (1u << 18)
#define LAS __attribute__((address_space(3)))

__device__ __forceinline__ unsigned xb_ld(unsigned* p)              { return __hip_atomic_load(p, __ATOMIC_RELAXED, __HIP_MEMORY_SCOPE_AGENT); }
__device__ __forceinline__ unsigned xb_add(unsigned* p, unsigned v) { return __hip_atomic_fetch_add(p, v, __ATOMIC_RELAXED, __HIP_MEMORY_SCOPE_AGENT); }
__device__ __forceinline__ unsigned xb_xcc_id() { return (unsigned)__builtin_amdgcn_s_getreg((3 << 11) | 20) & 0xFu; }
#define XB_SPIN(cond, bar) do { unsigned _sp = 0; while (cond) { __builtin_amdgcn_s_sleep(1); \
    if ((++_sp & 255u) == 0u) { if (xb_ld(&(bar)[XB_TMO])) break; if (_sp > XB_SPIN_CAP) { atomicAdd(&(bar)[XB_TMO], 1u); break; } } } } while (0)

struct XcdBarrier {
    unsigned* bar; unsigned x;
    volatile LAS unsigned* st;
};

__device__ __forceinline__ XcdBarrier xcd_barrier_post(unsigned* bar, volatile LAS unsigned* st) {
    XcdBarrier b; b.bar = bar; b.x = xb_xcc_id(); b.st = st;
    if (threadIdx.x == 0) (void)xb_add(&bar[XB_XCNT(b.x)], 1u);
    return b;
}
__device__ __forceinline__ void xcd_barrier_complete(unsigned* bar, unsigned x, unsigned& nloc, unsigned& nx) {
    const unsigned G = gridDim.x * gridDim.y * gridDim.z;
    unsigned sum, cnt, mine, sp = 0u;
    for (;;) {
        sum = 0u; cnt = 0u; mine = 0u;
#pragma unroll
        for (unsigned j = 0; j < 16; ++j) { const unsigned c = xb_ld(&bar[XB_XCNT(j)]); sum += c; cnt += (c > 0u) ? 1u : 0u; mine = (j == x) ? c : mine; }
        if (sum == G) break;
        __builtin_amdgcn_s_sleep(1);
        if ((++sp & 255u) == 0u) { if (xb_ld(&bar[XB_TMO])) break; if (sp > XB_SPIN_CAP) { atomicAdd(&bar[XB_TMO], 1u); break; } }
    }
    nloc = mine > 0u ? mine : 1u; nx = cnt > 0u ? cnt : 1u;
}

__device__ __forceinline__ void xcd_barrier(const XcdBarrier& b) {
    asm volatile("s_waitcnt vmcnt(0)" ::: "memory");
    __syncthreads();
    if (threadIdx.x == 0) {
        unsigned* bar = b.bar;
        __builtin_amdgcn_s_waitcnt(0);
        unsigned nloc = b.st[0], nx = b.st[1];
        if (nloc == 0u) { xcd_barrier_complete(bar, b.x, nloc, nx); b.st[0] = nloc; b.st[1] = nx; }
        const unsigned old = xb_add(&bar[XB_XSUB(b.x)], 1u);
        const unsigned gen = old / nloc;
        if (old + 1u == (gen + 1u) * nloc) {
            __builtin_amdgcn_fence(__ATOMIC_RELEASE, "agent");
            asm volatile("s_waitcnt vmcnt(0)" ::: "memory");
            const unsigned og = xb_add(&bar[XB_TOP], 1u);
            const unsigned tg = og / nx;
            if (og + 1u == (tg + 1u) * nx) xb_add(&bar[XB_TOPGEN], 1u);
            else XB_SPIN(xb_ld(&bar[XB_TOPGEN]) == tg, bar);
            __builtin_amdgcn_fence(__ATOMIC_ACQUIRE, "agent");
            xb_add(&bar[XB_XGEN(b.x)], 1u);
            asm volatile("s_waitcnt vmcnt(0)" ::: "memory");
        } else {
            XB_SPIN(xb_ld(&bar[XB_XGEN(b.x)]) == gen, bar);
            __builtin_amdgcn_fence(__ATOMIC_ACQUIRE, "agent");
            asm volatile("s_waitcnt vmcnt(0)" ::: "memory");
        }
    }
    __syncthreads();
}


DI int xcd_swizzle(int t, int nb, int ntiles) {
  const int r = t / nb;
  if ((nb & 7) || (r + 1) * nb > ntiles) return t;
  const int b = t - r * nb, per = nb >> 3;
  return r * nb + (b & 7) * per + (b >> 3);
}

constexpr int NPHASE = 26;
constexpr int SMEM_BYTES = 2 * GBUF;

DI void run_phase(const Params& p, int ph, char* lds) {
  const int bid = blockIdx.x, nb = gridDim.x, wave = threadIdx.x >> 6;
  if (ph == 0) {
    for (int t = bid; t < 192 + 512 + CONV1_TASKS; t += nb) {
      if (t < 192) task_mod(p, t, lds); else if (t < 704) task_rope(p, t - 192); else task_conv1(p, 0, t - 704, lds);
    }
    return;
  }
  if (ph == 25) { for (int t = bid; t < NLAT / 4; t += nb) task_final_norm(p, t); return; }
  const int l = (ph - 1) / 12; int sp = (ph - 1) % 12;
  const bool last = l == 1;
  const int mtiles = last ? 128 : 136;
  if (sp >= 7) sp = (sp == 7) ? 11 : sp - 1;
  switch (sp) {
    case 0: for (int t = bid; t < NTOK / 4; t += nb) task_norm(p, l, t, 0); break;
    case 1: {
      for (int t = bid; t < 136 * 15; t += nb) task_g1(p, l, xcd_swizzle(t, nb, 136 * 15), lds);
      for (int t = (bid + nb - ((136 * 15) % nb)) % nb; t < 136; t += nb) task_g1_tail(p, l, t, lds);
    } break;
    case 2: for (int t = bid; t < 1024; t += nb) task_gla<1>(p, l, xcd_swizzle(t, nb, 1024), lds); break;
    case 3: {
      for (int t = bid; t < 64; t += nb) task_gla_prefix(p, t);
      for (int t = bid; t < 512; t += nb) attn_a_latent(p, l, xcd_swizzle(t, nb, 512) * 4 + wave);
      if (!last) for (int t = bid; t < 32; t += nb) attn_ctx(p, l, (31 - t) * 4 + wave, 0);
    } break;
    case 4: for (int t = bid; t < 1088; t += nb) task_gla<2>(p, l, xcd_swizzle(t, nb, 1088), lds); break;
    case 5: {
      __syncthreads();
      for (int t = bid; t < 512; t += nb) attn_c_latent(p, l, xcd_swizzle(t, nb, 512) * 4 + wave, lds);
      if (!last) for (int t = bid; t < 32; t += nb) attn_ctx(p, l, t * 4 + wave, 1);
      for (int t = bid; t < (last ? NLAT : NTOK) / 4; t += nb) task_gla_out(p, l, t);
    } break;
    case 6: for (int t = bid; t < mtiles * 12; t += nb) task_gates(p, l, xcd_swizzle(t, nb, mtiles * 12), lds); break;
    case 11: for (int t = bid; t < mtiles * 8; t += nb) task_mg(p, l, xcd_swizzle(t, nb, mtiles * 8), lds); break;
    case 7: {
      for (int t = bid; t < 512; t += nb) task_res_wide(p, l, xcd_swizzle(t, nb, 512), (const u16*)(p.ws + OFF_MIXED), D, (const u16*)(p.ws + OFF_WOUT), D, 2, true, lds);
      if (!last) for (int t = bid; t < 128; t += nb) task_res_ctx(p, l, t, (const u16*)(p.ws + OFF_MIXED), D, (const u16*)(p.ws + OFF_WOUT), D, 2, true, lds);
      for (int t = (bid + nb - (last ? 0 : 128)) % nb; t < CONV2_TASKS; t += nb) task_conv2(p, l, t, lds);
    } break;
    case 8: for (int t = bid; t < (last ? NLAT : NTOK) / 4; t += nb) task_norm(p, l, t, 1); break;
    case 9: for (int t = bid; t < mtiles * 22; t += nb) task_f1(p, xcd_swizzle(t, nb, mtiles * 22), lds); break;
    case 10: {
      for (int t = bid; t < 512; t += nb) task_res_wide(p, l, xcd_swizzle(t, nb, 512), (const u16*)(p.ws + OFF_ACT), FH, (const u16*)(p.ws + OFF_WF2), FH, 5, false, lds);
      if (!last) {
        for (int t = bid; t < 128; t += nb) task_res_ctx(p, l, t, (const u16*)(p.ws + OFF_ACT), FH, (const u16*)(p.ws + OFF_WF2), FH, 5, false, lds);
        for (int t = (bid + nb - 128) % nb; t < CONV1_TASKS; t += nb) task_conv1(p, 1, t, lds);
      }
    } break;
  }
}

#if MULTI_LAUNCH
__global__ void __launch_bounds__(256, 2) k_phase(Params p, int ph) {
  __shared__ __attribute__((aligned(16))) char smem[SMEM_BYTES];
  run_phase(p, ph, smem);
}
#endif

#if !MULTI_LAUNCH
__global__ void __launch_bounds__(256, 2) k_mega(Params p) {
  extern __shared__ __attribute__((aligned(16))) char smem[];
  __shared__ uint4 xb_words;
  if (threadIdx.x == 0) xb_words = make_uint4(0u, 0u, 0u, 0u);
  __syncthreads();
  XcdBarrier xb = xcd_barrier_post((unsigned*)(p.ws + OFF_BAR), (volatile LAS unsigned*)&xb_words);
  if (p.ws == nullptr) cg::this_grid().sync();
#define PH(k) run_phase(p, k, smem); xcd_barrier(xb);
  PH(0) PH(1) PH(2) PH(3) PH(4) PH(5) PH(6) PH(7) PH(8) PH(9) PH(10) PH(11) PH(12) PH(13) PH(14) PH(15) PH(16) PH(17) PH(18) PH(19) PH(20) PH(21) PH(22) PH(23) PH(24)
  run_phase(p, 25, smem);
}
#endif

extern "C" void kernel_launch(void* const* d_in, const int* in_sizes, int n_in, void* d_out, int out_size, void* d_ws, size_t ws_size,
                              hipStream_t stream) {
  Params p{};
  const float** f = (const float**)&p;
  for (int i = 0; i < 25; i++) f[i] = (const float*)d_in[i];
  p.out = (float*)d_out;
  p.ws = (char*)d_ws;
#if MULTI_LAUNCH
  for (int ph = 0; ph < NPHASE; ph++) hipLaunchKernelGGL(k_phase, dim3(512), dim3(256), 0, stream, p, ph);
#else
  static int grid_blocks = 0;
  if (!grid_blocks) {
    int dev = 0, cus = 0, per_cu = 0;
    hipGetDevice(&dev);
    hipDeviceGetAttribute(&cus, hipDeviceAttributeMultiprocessorCount, dev);
    (void)hipFuncSetAttribute((const void*)k_mega, hipFuncAttributeMaxDynamicSharedMemorySize, SMEM_BYTES);
    (void)hipOccupancyMaxActiveBlocksPerMultiprocessor(&per_cu, k_mega, 256, SMEM_BYTES);
    if (per_cu > 2) per_cu = 2;
    if (per_cu < 1) per_cu = 1;
    grid_blocks = cus * per_cu;
  }
  hipMemsetAsync((char*)d_ws + OFF_BAR, 0, XCD_BAR_WORDS * 4, stream);
  void* args[] = {&p};
  hipError_t e = hipLaunchCooperativeKernel((void*)k_mega, dim3(grid_blocks), dim3(256), args, SMEM_BYTES, stream);
  if (e != hipSuccess) fprintf(stderr, "cooperative launch failed: %s (grid %d)\n", hipGetErrorString(e), grid_blocks);
#endif
}
```

```cpp
#include <hip/hip_runtime.h>
#include <hip/hip_cooperative_groups.h>
#include <cstdio>
namespace cg = cooperative_groups;

#ifndef MULTI_LAUNCH
#define MULTI_LAUNCH 0
#endif

typedef unsigned short u16;
using bf16x8 = __attribute__((ext_vector_type(8))) short;
using s16x4  = __attribute__((ext_vector_type(4))) short;
using f32x4  = __attribute__((ext_vector_type(4))) float;
#define DI __device__ __forceinline__
#define MFMA16(a, b, c) __builtin_amdgcn_mfma_f32_16x16x32_bf16((a), (b), (c), 0, 0, 0)

constexpr int D = 1024, NB = 4, SEQ = 4096, LC = 256, NLAT = NB * SEQ, NCTX = NB * LC, NTOK = NLAT + NCTX;
constexpr int INT = 3872, INTP = 3968, FH = 2816, PNLD = 2720, VTR = 1152;
constexpr float LOG2E = 1.4426950408889634f;

constexpr size_t OFF_WIN  = 0;
constexpr size_t OFF_WMG  = OFF_WIN + (size_t)INTP * D * 2;
constexpr size_t OFF_WBR  = OFF_WMG + (size_t)3072 * D * 2;
constexpr size_t OFF_WOUT = OFF_WBR + (size_t)3 * 1024 * 512 * 2;
constexpr size_t OFF_WF1  = OFF_WOUT + (size_t)D * D * 2;
constexpr size_t OFF_WF2  = OFF_WF1 + (size_t)2 * FH * D * 2;
constexpr size_t OFF_PAD  = OFF_WF2 + (size_t)D * FH * 2;
constexpr size_t OFF_MOD  = OFF_PAD + (1u << 20);
constexpr size_t OFF_ROPE = OFF_MOD + (size_t)2 * 5 * 6144 * 4;
constexpr size_t OFF_XC   = OFF_ROPE + (size_t)SEQ * 32 * 2 * 4;
constexpr size_t OFF_HB   = OFF_XC + (size_t)NCTX * D * 4;
constexpr size_t OFF_PN   = OFF_HB + (size_t)NTOK * D * 2;
constexpr size_t OFF_VT   = OFF_PN + (size_t)NTOK * PNLD * 2;
constexpr size_t OFF_VTC  = OFF_VT + (size_t)NB * VTR * SEQ * 2;
constexpr size_t OFF_Y    = OFF_VTC + (size_t)NB * VTR * LC * 2;
constexpr size_t WS_END   = OFF_Y + (size_t)3 * NTOK * 512 * 2;
static_assert(WS_END <= ((size_t)256 << 20), "workspace too large");
constexpr size_t OFF_OB    = OFF_WF1;
static_assert(OFF_OB + (size_t)NTOK * 512 * 2 <= OFF_MOD, "o_b alias");
constexpr size_t OFF_BAR   = OFF_PAD + (768u << 10);
constexpr size_t OFF_MIXED = OFF_PN;
constexpr size_t OFF_ACT   = OFF_PN + (size_t)NTOK * D * 2;
static_assert(OFF_ACT + (size_t)NTOK * FH * 2 <= OFF_Y, "act alias");

struct Params {
  const float *x, *c, *ctx, *c_ctx, *w_ada, *b_ada, *norm_mix, *w_in, *sink, *gw_f, *gb_f, *gw_b, *gb_b, *gla_norm, *rpb,
      *w_ba, *w_bb, *w_bc, *w_merge, *b_merge, *w_out, *norm_ffn, *w_ffn_in, *w_ffn_out, *final_norm;
  float* out;
  char* ws;
};

typedef __bf16 bf2_t __attribute__((ext_vector_type(2)));
DI u16 f2bf(float x) { __bf16 v = (__bf16)x; return __builtin_bit_cast(u16, v); }
DI float bf2f(u16 h) { return __uint_as_float(((unsigned)h) << 16); }
DI unsigned pack2(float a, float b) { bf2_t v = {(__bf16)a, (__bf16)b}; return __builtin_bit_cast(unsigned, v); }
DI float wave_sum(float v) { for (int o = 32; o; o >>= 1) v += __shfl_xor(v, o, 64); return v; }
DI float sigmoidf_(float x) { return __builtin_amdgcn_rcpf(1.0f + __expf(-x)); }
DI float siluf_(float x) { return x * __builtin_amdgcn_rcpf(1.0f + __expf(-x)); }

DI const float* xsrc(const Params& p, int l, int row) {
  if (row < NLAT) return (l == 0 ? p.x : p.out) + (size_t)row * D;
  return (l == 0 ? p.ctx : (const float*)(p.ws + OFF_XC)) + (size_t)(row - NLAT) * D;
}
DI float* xdst(const Params& p, int row) {
  if (row < NLAT) return p.out + (size_t)row * D;
  return (float*)(p.ws + OFF_XC) + (size_t)(row - NLAT) * D;
}
DI const float* modp(const Params& p, int l, int row) {
  int s = row < NLAT ? (row >> 12) : 4;
  return (const float*)(p.ws + OFF_MOD) + (size_t)(l * 5 + s) * 6144;
}

constexpr int LROW = 144;
constexpr int LDS_A = 0, LDS_B = 128 * LROW;

constexpr int GROW = 128;
constexpr int G_A = 0, G_B = 128 * GROW;
constexpr int GBUF = 2 * 128 * GROW;
template <int NI, int CH>
DI void gemm_tile(const u16* __restrict__ A, int lda, const u16* __restrict__ Bt, int ldb, int K,
                  f32x4 (&acc)[4][NI], char* lds) {
  const int tid = threadIdx.x, lane = tid & 63, wave = tid >> 6;
  const int wm = wave >> 1, wn = wave & 1, g = lane >> 4, n = lane & 15;
  const int lrow = tid >> 3, lkc = tid & 7;
  const u16* ap = CH ? A + (size_t)lrow * 32 + (size_t)(lkc >> 2) * lda * 32 + (lkc & 3) * 8 : A + (size_t)lrow * lda + lkc * 8;
  const u16* bp = CH ? Bt + (size_t)lrow * 32 + (size_t)(lkc >> 2) * ldb * 32 + (lkc & 3) * 8 : Bt + (size_t)lrow * ldb + lkc * 8;
  const size_t sa = CH ? (size_t)32 * 32 : (size_t)32 * lda, sb = CH ? (size_t)32 * 32 : (size_t)32 * ldb;
  const size_t ka = CH ? (size_t)lda : 1, kb = CH ? (size_t)ldb : 1;
  const int wsw = (lkc ^ ((lrow >> 1) & 7)) * 16;
  const int rsw0 = (g ^ ((n >> 1) & 7)) * 16, rsw1 = ((4 + g) ^ ((n >> 1) & 7)) * 16;
  uint4 ra0, ra1, ra2, ra3, rb0, rb1, rb2, rb3;
#define GLOADS(kk)                                                                                                   \
  {                                                                                                                  \
    ra0 = *(const uint4*)(ap + (kk) * ka); ra1 = *(const uint4*)(ap + sa + (kk) * ka);                               \
    ra2 = *(const uint4*)(ap + 2 * sa + (kk) * ka); ra3 = *(const uint4*)(ap + 3 * sa + (kk) * ka);                  \
    rb0 = *(const uint4*)(bp + (kk) * kb); rb1 = *(const uint4*)(bp + sb + (kk) * kb);                               \
    if (NI == 4) { rb2 = *(const uint4*)(bp + 2 * sb + (kk) * kb); rb3 = *(const uint4*)(bp + 3 * sb + (kk) * kb); } \
  }
#define LSTORES(buf)                                                                                                 \
  {                                                                                                                  \
    char* wa_ = lds + (buf) * GBUF + G_A + lrow * GROW + wsw;                                                        \
    char* wb_ = lds + (buf) * GBUF + G_B + lrow * GROW + wsw;                                                        \
    *(uint4*)(wa_) = ra0; *(uint4*)(wa_ + 32 * GROW) = ra1; *(uint4*)(wa_ + 64 * GROW) = ra2; *(uint4*)(wa_ + 96 * GROW) = ra3; \
    *(uint4*)(wb_) = rb0; *(uint4*)(wb_ + 32 * GROW) = rb1;                                                          \
    if (NI == 4) { *(uint4*)(wb_ + 64 * GROW) = rb2; *(uint4*)(wb_ + 96 * GROW) = rb3; }                             \
  }
  GLOADS(0);
  __syncthreads();
  LSTORES(0);
  GLOADS(64);
  __syncthreads();
  const int nk = K >> 6;
#pragma unroll 1
  for (int it = 0; it < nk; it++) {
    const int cur = it & 1;
    if (it + 1 < nk) LSTORES(cur ^ 1);
    if (it + 2 < nk) GLOADS((it + 2) * 64);
    const char* fa = lds + cur * GBUF + G_A + (wm * 64 + n) * GROW;
    const char* fb = lds + cur * GBUF + G_B + (wn * 16 * NI + n) * GROW;
#pragma unroll
    for (int ks = 0; ks < 2; ks++) {
      const int rsw = ks ? rsw1 : rsw0;
      bf16x8 af[4], bfr[NI];
#pragma unroll
      for (int i = 0; i < 4; i++) af[i] = *(const bf16x8*)(fa + i * 16 * GROW + rsw);
#pragma unroll
      for (int i = 0; i < NI; i++) bfr[i] = *(const bf16x8*)(fb + i * 16 * GROW + rsw);
#pragma unroll
      for (int mi = 0; mi < 4; mi++)
#pragma unroll
        for (int ni = 0; ni < NI; ni++) acc[mi][ni] = MFMA16(af[mi], bfr[ni], acc[mi][ni]);
    }
    __syncthreads();
  }
#undef GLOADS
#undef LSTORES
}

template <int NI>
DI void zero_acc(f32x4 (&acc)[4][NI]) {
#pragma unroll
  for (int i = 0; i < 4; i++)
#pragma unroll
    for (int j = 0; j < NI; j++) acc[i][j] = f32x4{0.f, 0.f, 0.f, 0.f};
}

constexpr int LROW2 = 64;
constexpr int W_A = 0, W_B = 128 * LROW2, WBUF = 384 * LROW2;
DI void gemm_wide(const u16* __restrict__ A, int lda, const u16* __restrict__ Bt, int ldb, int K, f32x4 (&acc)[4][8], char* lds) {
  const int tid = threadIdx.x, lane = tid & 63, wave = tid >> 6;
  const int wm = wave >> 1, wn = wave & 1, g = lane >> 4, n = lane & 15;
  const int lrow = tid >> 2, lkc = tid & 3;
  const u16* ap = A + (size_t)lrow * 32 + lkc * 8;
  const u16* bp = Bt + (size_t)lrow * 32 + lkc * 8;
  const size_t sa = (size_t)64 * 32, sb = (size_t)64 * 32;
  const size_t ka = (size_t)lda, kb = (size_t)ldb;
  uint4 ra0, ra1, rb0, rb1, rb2, rb3;
  const int wsw = (lkc ^ ((0 - (lrow >> 2)) & 3)) * 16;
  const int rsw = (g ^ ((0 - (n >> 2)) & 3)) * 16;
#define GLOADS(kk)                                                                           \
  {                                                                                          \
    ra0 = *(const uint4*)(ap + (kk) * ka); ra1 = *(const uint4*)(ap + sa + (kk) * ka);       \
    rb0 = *(const uint4*)(bp + (kk) * kb); rb1 = *(const uint4*)(bp + sb + (kk) * kb);       \
    rb2 = *(const uint4*)(bp + 2 * sb + (kk) * kb); rb3 = *(const uint4*)(bp + 3 * sb + (kk) * kb); \
  }
#define LSTORES(buf)                                                                         \
  {                                                                                          \
    char* wa_ = lds + (buf) * WBUF + W_A + lrow * LROW2 + wsw;                               \
    char* wb_ = lds + (buf) * WBUF + W_B + lrow * LROW2 + wsw;                               \
    *(uint4*)(wa_) = ra0; *(uint4*)(wa_ + 64 * LROW2) = ra1;                                 \
    *(uint4*)(wb_) = rb0; *(uint4*)(wb_ + 64 * LROW2) = rb1;                                 \
    *(uint4*)(wb_ + 128 * LROW2) = rb2; *(uint4*)(wb_ + 192 * LROW2) = rb3;                  \
  }
#define HALF(h)                                                                              \
  {                                                                                          \
    bf16x8 bfr[4];                                                                           \
    _Pragma("unroll") for (int i = 0; i < 4; i++) bfr[i] = *(const bf16x8*)(fb + ((h) * 4 + i) * 16 * LROW2); \
    _Pragma("unroll") for (int mi = 0; mi < 4; mi++)                                         \
      _Pragma("unroll") for (int ni = 0; ni < 4; ni++) acc[mi][(h) * 4 + ni] = MFMA16(af[mi], bfr[ni], acc[mi][(h) * 4 + ni]); \
  }
  GLOADS(0);
  __syncthreads();
  LSTORES(0);
  GLOADS(32);
  __syncthreads();
  const int nk = K >> 5;
#pragma unroll 1
  for (int it = 0; it < nk; it++) {
    const int cur = it & 1;
    const char* fa = lds + cur * WBUF + W_A + (wm * 64 + n) * LROW2 + rsw;
    const char* fb = lds + cur * WBUF + W_B + (wn * 128 + n) * LROW2 + rsw;
    bf16x8 af[4];
#pragma unroll
    for (int i = 0; i < 4; i++) af[i] = *(const bf16x8*)(fa + i * 16 * LROW2);
    HALF(0);
    if (it + 1 < nk) LSTORES(cur ^ 1);
    if (it + 2 < nk) GLOADS((it + 2) * 32);
    HALF(1);
    __syncthreads();
  }
#undef GLOADS
#undef LSTORES
#undef HALF
}

DI void task_mod(const Params& p, int task, char* lds) {
  const int tid = threadIdx.x, lane = tid & 63, wave = tid >> 6;
  const int l = task / 96, cb = task % 96;
  float* sc = (float*)lds;
  float* red = sc + 5 * 1024;
  __syncthreads();
  for (int i = tid; i < 5 * 1024; i += 256) {
    int s = i >> 10, k = i & 1023;
    float v = s < 4 ? p.c[s * 1024 + k] : p.c_ctx[k];
    sc[i] = siluf_(v);
  }
  __syncthreads();
  const int ncol = cb * 64 + lane;
  const float* w = p.w_ada + (size_t)l * 1024 * 6144 + ncol;
  float a0 = 0, a1 = 0, a2 = 0, a3 = 0, a4 = 0;
#pragma unroll 16
  for (int k = wave * 256; k < wave * 256 + 256; k++) {
    float wv = w[(size_t)k * 6144];
    a0 += sc[k] * wv; a1 += sc[1024 + k] * wv; a2 += sc[2048 + k] * wv; a3 += sc[3072 + k] * wv; a4 += sc[4096 + k] * wv;
  }
  red[(wave * 5 + 0) * 64 + lane] = a0; red[(wave * 5 + 1) * 64 + lane] = a1; red[(wave * 5 + 2) * 64 + lane] = a2;
  red[(wave * 5 + 3) * 64 + lane] = a3; red[(wave * 5 + 4) * 64 + lane] = a4;
  __syncthreads();
  float* mod = (float*)(p.ws + OFF_MOD);
  for (int i = tid; i < 320; i += 256) {
    int s = i >> 6, ln = i & 63;
    float v = red[(0 * 5 + s) * 64 + ln] + red[(1 * 5 + s) * 64 + ln] + red[(2 * 5 + s) * 64 + ln] + red[(3 * 5 + s) * 64 + ln];
    int nc = cb * 64 + ln;
    mod[(size_t)(l * 5 + s) * 6144 + nc] = v + p.b_ada[l * 6144 + nc];
  }
}

DI void task_rope(const Params& p, int task) {
  int e = task * 256 + threadIdx.x;
  int t = e >> 5, i = e & 31;
  float pos = (i < 16) ? (float)(t >> 6) : (float)(t & 63);
  float inv = exp2f(-(float)(i & 15) * (13.287712379549449f / 16.0f));
  float ang = pos * inv;
  float kq = rintf(ang * 0.15915494309189535f);
  float rr = fmaf(-kq, 6.28125f, ang);
  rr = fmaf(-kq, 0.0019353071795864769f, rr);
  float s = sinf(rr), c = cosf(rr);
  float* rc = (float*)(p.ws + OFF_ROPE);
  rc[e] = c; rc[SEQ * 32 + e] = s;
}

DI void conv_tile(const float* __restrict__ src, int K, int N, int kt, int nt, u16* __restrict__ dst, int mode, int R, char* lds) {
  float* tile = (float*)lds;
  const int tid = threadIdx.x;
  const int k0 = kt * 64, n0 = nt * 64;
  __syncthreads();
  {
    float4 v[4];
#pragma unroll
    for (int i = 0; i < 4; i++) {
      int idx = tid + 256 * i, kk = idx >> 4, n4 = (idx & 15) * 4;
      v[i] = float4{0.f, 0.f, 0.f, 0.f};
      if (n0 + n4 < N) v[i] = *(const float4*)(src + (size_t)(k0 + kk) * N + n0 + n4);
    }
#pragma unroll
    for (int i = 0; i < 4; i++) {
      int idx = tid + 256 * i, kk = idx >> 4, n4 = (idx & 15) * 4;
      float* t = tile + kk * 65 + n4;
      t[0] = v[i].x; t[1] = v[i].y; t[2] = v[i].z; t[3] = v[i].w;
    }
  }
  __syncthreads();
#pragma unroll
  for (int i = 0; i < 2; i++) {
    int cidx = tid + 256 * i, nn = cidx >> 3, kc = cidx & 7;
    int ncol = n0 + nn;
    if (ncol < N) {
      int drow = ncol;
      if (mode == 1) {
        int up = ncol >= FH, j = up ? ncol - FH : ncol;
        drow = (j >> 7) * 256 + ((j >> 6) & 1) * 128 + up * 64 + (j & 63);
      }
      uint4 o;
      o.x = pack2(tile[(kc * 8 + 0) * 65 + nn], tile[(kc * 8 + 1) * 65 + nn]);
      o.y = pack2(tile[(kc * 8 + 2) * 65 + nn], tile[(kc * 8 + 3) * 65 + nn]);
      o.z = pack2(tile[(kc * 8 + 4) * 65 + nn], tile[(kc * 8 + 5) * 65 + nn]);
      o.w = pack2(tile[(kc * 8 + 6) * 65 + nn], tile[(kc * 8 + 7) * 65 + nn]);
      const int kd = k0 + kc * 8;
      if (R > 0) *(uint4*)(dst + ((size_t)(kd >> 5) * R + drow) * 32 + (kd & 31)) = o;
      else *(uint4*)(dst + (size_t)drow * K + kd) = o;
    }
  }
}

constexpr int CONV1_TASKS = 976 + 768 + 384 + 256 + 1;
constexpr int CONV2_TASKS = 1408 + 704;
DI void task_conv1(const Params& p, int l, int t, char* lds) {
  if (t < 976) { conv_tile(p.w_in + (size_t)l * D * INT, D, INT, t / 61, t % 61, (u16*)(p.ws + OFF_WIN), 0, INTP, lds); return; }
  t -= 976;
  if (t < 768) { conv_tile(p.w_merge + (size_t)l * D * 3072, D, 3072, t / 48, t % 48, (u16*)(p.ws + OFF_WMG), 0, 3072, lds); return; }
  t -= 768;
  if (t < 384) {
    int br = t / 128, tt = t % 128;
    const float* src = (br == 0 ? p.w_ba : br == 1 ? p.w_bb : p.w_bc) + (size_t)l * 512 * D;
    conv_tile(src, 512, D, tt / 16, tt % 16, (u16*)(p.ws + OFF_WBR) + (size_t)br * 1024 * 512, 0, 0, lds);
    return;
  }
  t -= 384;
  if (t < 256) { conv_tile(p.w_out + (size_t)l * D * D, D, D, t / 16, t % 16, (u16*)(p.ws + OFF_WOUT), 0, D, lds); return; }
  uint4 z = {0, 0, 0, 0};
  for (int i = threadIdx.x; i < 32 * (INTP - INT) * 4; i += 256) {
    const int ch = i / ((INTP - INT) * 4), off = i % ((INTP - INT) * 4);
    *(uint4*)((u16*)(p.ws + OFF_WIN) + ((size_t)ch * INTP + INT) * 32 + off * 8) = z;
  }
}
DI void task_conv2(const Params& p, int l, int t, char* lds) {
  if (t < 1408) { conv_tile(p.w_ffn_in + (size_t)l * D * 2 * FH, D, 2 * FH, t / 88, t % 88, (u16*)(p.ws + OFF_WF1), 1, 2 * FH, lds); return; }
  t -= 1408;
  conv_tile(p.w_ffn_out + (size_t)l * FH * D, FH, D, t / 16, t % 16, (u16*)(p.ws + OFF_WF2), 0, D, lds);
}

DI void task_norm(const Params& p, int l, int task, int which) {
  const int lane = threadIdx.x & 63, wave = threadIdx.x >> 6;
  const int row0 = task * 16 + wave * 4;
  const float* g = (which == 0 ? p.norm_mix : p.norm_ffn) + l * D;
  const float* md = modp(p, l, row0) + (which ? 3 * D : 0);
  float4 v[4][4];
#pragma unroll
  for (int r = 0; r < 4; r++) {
    const float* xr = which == 0 ? xsrc(p, l, row0 + r) : (const float*)xdst(p, row0 + r);
#pragma unroll
    for (int i = 0; i < 4; i++) v[r][i] = *(const float4*)(xr + i * 256 + lane * 4);
  }
  float rstd[4];
#pragma unroll
  for (int r = 0; r < 4; r++) {
    float ss = 0.f;
#pragma unroll
    for (int i = 0; i < 4; i++) ss += v[r][i].x * v[r][i].x + v[r][i].y * v[r][i].y + v[r][i].z * v[r][i].z + v[r][i].w * v[r][i].w;
    ss = wave_sum(ss);
    rstd[r] = rsqrtf(ss * (1.0f / 1024.0f) + 1e-6f);
  }
  u16* hb = (u16*)(p.ws + OFF_HB) + (size_t)row0 * 32;
#pragma unroll
  for (int i = 0; i < 4; i++) {
    const int cidx = i * 256 + lane * 4;
    const float4 gg = *(const float4*)(g + cidx), sh = *(const float4*)(md + cidx), sc = *(const float4*)(md + D + cidx);
    const float a0 = gg.x * (1.f + sc.x), a1 = gg.y * (1.f + sc.y), a2 = gg.z * (1.f + sc.z), a3 = gg.w * (1.f + sc.w);
#pragma unroll
    for (int r = 0; r < 4; r++) {
      uint2 o;
      o.x = pack2(v[r][i].x * rstd[r] * a0 + sh.x, v[r][i].y * rstd[r] * a1 + sh.y);
      o.y = pack2(v[r][i].z * rstd[r] * a2 + sh.z, v[r][i].w * rstd[r] * a3 + sh.w);
      *(uint2*)(hb + (size_t)(cidx >> 5) * NTOK * 32 + r * 32 + (cidx & 31)) = o;
    }
  }
}
DI void task_final_norm(const Params& p, int task) {
  const int lane = threadIdx.x & 63, wave = threadIdx.x >> 6;
  float* xr = p.out + (size_t)(task * 16 + wave * 4) * D;
  float4 v[4][4];
#pragma unroll
  for (int r = 0; r < 4; r++)
#pragma unroll
    for (int i = 0; i < 4; i++) v[r][i] = *(const float4*)(xr + (size_t)r * D + i * 256 + lane * 4);
  float rstd[4];
#pragma unroll
  for (int r = 0; r < 4; r++) {
    float ss = 0.f;
#pragma unroll
    for (int i = 0; i < 4; i++) ss += v[r][i].x * v[r][i].x + v[r][i].y * v[r][i].y + v[r][i].z * v[r][i].z + v[r][i].w * v[r][i].w;
    ss = wave_sum(ss);
    rstd[r] = rsqrtf(ss * (1.0f / 1024.0f) + 1e-6f);
  }
#pragma unroll
  for (int i = 0; i < 4; i++) {
    const int cidx = i * 256 + lane * 4;
    const float4 gg = *(const float4*)(p.final_norm + cidx);
#pragma unroll
    for (int r = 0; r < 4; r++) {
      float4 o = {v[r][i].x * rstd[r] * gg.x, v[r][i].y * rstd[r] * gg.y, v[r][i].z * rstd[r] * gg.z, v[r][i].w * rstd[r] * gg.w};
      *(float4*)(xr + (size_t)r * D + cidx) = o;
    }
  }
}

DI void task_g1(const Params& p, int l, int tile, char* lds) {
  const int mt = tile / 15, nt = tile % 15;
  const int tid = threadIdx.x, lane = tid & 63, wave = tid >> 6;
  const int wm = wave >> 1, wn = wave & 1, g = lane >> 4, n = lane & 15;
  f32x4 acc[4][8];
#pragma unroll
  for (int i = 0; i < 4; i++)
#pragma unroll
    for (int j = 0; j < 8; j++) acc[i][j] = f32x4{0.f, 0.f, 0.f, 0.f};
  gemm_wide((const u16*)(p.ws + OFF_HB) + (size_t)mt * 128 * 32, NTOK, (const u16*)(p.ws + OFF_WIN) + (size_t)nt * 256 * 32, INTP, D, acc, lds);
  const int cw = nt * 256 + wn * 128;
  const int rw = mt * 128 + wm * 64;
  if (mt < 128) {
    const float* rc = (const float*)(p.ws + OFF_ROPE);
    const float* rs = rc + SEQ * 32;
#pragma unroll
    for (int hh = 0; hh < 2; hh++) {
      if (cw + hh * 64 >= 640) continue;
#pragma unroll
      for (int mi = 0; mi < 4; mi++)
#pragma unroll
        for (int ni = 0; ni < 2; ni++)
#pragma unroll
          for (int r = 0; r < 4; r++) {
            int t = (rw + mi * 16 + 4 * g + r) & 4095;
            float c = rc[t * 32 + ni * 16 + n], sn = rs[t * 32 + ni * 16 + n];
            float x1 = acc[mi][hh * 4 + ni][r], x2 = acc[mi][hh * 4 + ni + 2][r];
            acc[mi][hh * 4 + ni][r] = x1 * c - x2 * sn;
            acc[mi][hh * 4 + ni + 2][r] = x1 * sn + x2 * c;
          }
    }
  }
  u16* PN = (u16*)(p.ws + OFF_PN);
  u16* VT = (u16*)(p.ws + OFF_VT);
  u16* VTc = (u16*)(p.ws + OFF_VTC);
#pragma unroll
  for (int ni = 0; ni < 8; ni++) {
    const int c16 = cw + ni * 16;
    if (c16 >= INT) continue;
    int tr = -1, nat = 0;
    if (c16 < 640) nat = c16;
    else if (c16 < 768) tr = c16 - 640;
    else if (c16 < 1280) nat = c16 - 128;
    else if (c16 < 1792) tr = 128 + c16 - 1280;
    else if (c16 < 3360) nat = c16 - 640;
    else tr = 640 + c16 - 3360;
#pragma unroll
    for (int mi = 0; mi < 4; mi++) {
      const int row0 = rw + mi * 16 + 4 * g;
      if (tr < 0) {
#pragma unroll
        for (int r = 0; r < 4; r++) PN[(size_t)(row0 + r) * PNLD + nat + n] = f2bf(acc[mi][ni][r]);
      } else {
        uint2 o; o.x = pack2(acc[mi][ni][0], acc[mi][ni][1]); o.y = pack2(acc[mi][ni][2], acc[mi][ni][3]);
        if (mt < 128) {
          int b = row0 >> 12, tok = row0 & 4095;
          *(uint2*)(VT + ((size_t)(b * VTR + tr + n)) * SEQ + tok) = o;
        } else {
          int rr = row0 - NLAT, b = rr >> 8, tok = rr & 255;
          *(uint2*)(VTc + ((size_t)(b * VTR + tr + n)) * LC + tok) = o;
        }
      }
    }
  }
}

DI void task_g1_tail(const Params& p, int l, int mt, char* lds) {
  const int tid = threadIdx.x, lane = tid & 63, wave = tid >> 6;
  const int wm = wave >> 1, wn = wave & 1, g = lane >> 4, n = lane & 15;
  f32x4 acc[4][2];
  zero_acc<2>(acc);
  gemm_tile<2, 1>((const u16*)(p.ws + OFF_HB) + (size_t)mt * 128 * 32, NTOK, (const u16*)(p.ws + OFF_WIN) + (size_t)3840 * 32, INTP, D, acc, lds);
  if (wn != 0) return;
  u16* VT = (u16*)(p.ws + OFF_VT);
  u16* VTc = (u16*)(p.ws + OFF_VTC);
#pragma unroll
  for (int ni = 0; ni < 2; ni++) {
    const int tr = 640 + (3840 - 3360) + ni * 16;
#pragma unroll
    for (int mi = 0; mi < 4; mi++) {
      const int row0 = mt * 128 + wm * 64 + mi * 16 + 4 * g;
      uint2 o; o.x = pack2(acc[mi][ni][0], acc[mi][ni][1]); o.y = pack2(acc[mi][ni][2], acc[mi][ni][3]);
      if (mt < 128) {
        int b = row0 >> 12, tok = row0 & 4095;
        *(uint2*)(VT + ((size_t)(b * VTR + tr + n)) * SEQ + tok) = o;
      } else {
        int rr = row0 - NLAT, b = rr >> 8, tok = rr & 255;
        *(uint2*)(VTc + ((size_t)(b * VTR + tr + n)) * LC + tok) = o;
      }
    }
  }
}

constexpr float QSC = 0.125f * LOG2E;

template <class QF, class OF, class M0F, class TileFn, class ScoreFn, class SkipFn>
DI void attn_core4(QF qptr, OF optr, M0F m0f, float l0, int ntiles, TileFn tilefn, ScoreFn scorefn, SkipFn skipfn) {
  const int lane = threadIdx.x & 63, g = lane >> 4, n = lane & 15;
  bf16x8 qf[4][2];
  f32x4 o[4][4];
  float m[4], ls[4];
#pragma unroll
  for (int gi = 0; gi < 4; gi++) {
    const u16* q = qptr(gi);
    qf[gi][0] = *(const bf16x8*)(q + (size_t)n * PNLD + g * 8);
    qf[gi][1] = *(const bf16x8*)(q + (size_t)n * PNLD + 32 + g * 8);
#pragma unroll
    for (int i = 0; i < 4; i++) o[gi][i] = f32x4{0.f, 0.f, 0.f, 0.f};
    m[gi] = m0f(gi);
    ls[gi] = (g == 0) ? l0 : 0.f;
  }
  const u16* kp; const u16* vp; int vld, aux;
  tilefn(0, kp, vp, vld, aux);
  bf16x8 kn0, kn1, kn2, kn3;
  s16x4 vn0, vn1, vn2, vn3, vn4, vn5, vn6, vn7;
#define LOADK()                                                                     \
  {                                                                                 \
    const u16* kr = kp + (size_t)n * PNLD + g * 8;                                  \
    kn0 = *(const bf16x8*)(kr); kn1 = *(const bf16x8*)(kr + (size_t)16 * PNLD);     \
    kn2 = *(const bf16x8*)(kr + 32); kn3 = *(const bf16x8*)(kr + (size_t)16 * PNLD + 32); \
  }
#define LOADV()                                                                     \
  {                                                                                 \
    const u16* vr = vp + (size_t)n * vld + 4 * g;                                   \
    vn0 = *(const s16x4*)(vr); vn1 = *(const s16x4*)(vr + 16);                      \
    vn2 = *(const s16x4*)(vr + (size_t)16 * vld); vn3 = *(const s16x4*)(vr + (size_t)16 * vld + 16); \
    vn4 = *(const s16x4*)(vr + (size_t)32 * vld); vn5 = *(const s16x4*)(vr + (size_t)32 * vld + 16); \
    vn6 = *(const s16x4*)(vr + (size_t)48 * vld); vn7 = *(const s16x4*)(vr + (size_t)48 * vld + 16); \
  }
  LOADK();
  LOADV();
#pragma unroll 1
  for (int t = 0; t < ntiles; t++) {
    const int auxc = aux;
    const bool more = t + 1 < ntiles;
    bf16x8 vf[4];
    vf[0] = __builtin_shufflevector(vn0, vn1, 0, 1, 2, 3, 4, 5, 6, 7);
    vf[1] = __builtin_shufflevector(vn2, vn3, 0, 1, 2, 3, 4, 5, 6, 7);
    vf[2] = __builtin_shufflevector(vn4, vn5, 0, 1, 2, 3, 4, 5, 6, 7);
    vf[3] = __builtin_shufflevector(vn6, vn7, 0, 1, 2, 3, 4, 5, 6, 7);
#pragma unroll
    for (int hf = 0; hf < 2; hf++) {
      f32x4 s0[2], s1[2];
#pragma unroll
      for (int gg = 0; gg < 2; gg++) {
        const int gi = hf * 2 + gg;
        s0[gg] = f32x4{0.f, 0.f, 0.f, 0.f}; s1[gg] = f32x4{0.f, 0.f, 0.f, 0.f};
        if (skipfn(gi, auxc)) continue;
        s0[gg] = MFMA16(kn0, qf[gi][0], s0[gg]); s1[gg] = MFMA16(kn1, qf[gi][0], s1[gg]);
        s0[gg] = MFMA16(kn2, qf[gi][1], s0[gg]); s1[gg] = MFMA16(kn3, qf[gi][1], s1[gg]);
      }
      if (hf == 1 && more) { tilefn(t + 1, kp, vp, vld, aux); LOADK(); }
#pragma unroll
      for (int gg = 0; gg < 2; gg++) {
        const int gi = hf * 2 + gg;
        if (skipfn(gi, auxc)) continue;
        float sc[8];
#pragma unroll
        for (int r = 0; r < 4; r++) {
          sc[r] = scorefn(gi, auxc, 4 * g + r, n, s0[gg][r]);
          sc[4 + r] = scorefn(gi, auxc, 16 + 4 * g + r, n, s1[gg][r]);
        }
        float mx = fmaxf(fmaxf(fmaxf(sc[0], sc[1]), fmaxf(sc[2], sc[3])), fmaxf(fmaxf(sc[4], sc[5]), fmaxf(sc[6], sc[7])));
        mx = fmaxf(mx, __shfl_xor(mx, 16, 64));
        mx = fmaxf(mx, __shfl_xor(mx, 32, 64));
        const float mn = fmaxf(m[gi], mx);
        const float alpha = __builtin_amdgcn_exp2f(m[gi] - mn);
        float pv[8], ps = 0.f;
#pragma unroll
        for (int r = 0; r < 8; r++) { pv[r] = __builtin_amdgcn_exp2f(sc[r] - mn); ps += pv[r]; }
        ls[gi] = ls[gi] * alpha + ps;
        m[gi] = mn;
        union { bf16x8 v; unsigned u[4]; } pf;
        pf.u[0] = pack2(pv[0], pv[1]); pf.u[1] = pack2(pv[2], pv[3]); pf.u[2] = pack2(pv[4], pv[5]); pf.u[3] = pack2(pv[6], pv[7]);
#pragma unroll
        for (int d4 = 0; d4 < 4; d4++) {
          o[gi][d4] *= alpha;
          o[gi][d4] = MFMA16(vf[d4], pf.v, o[gi][d4]);
        }
      }
    }
    if (more) LOADV();
  }
#undef LOADK
#undef LOADV
#pragma unroll
  for (int gi = 0; gi < 4; gi++) {
    float lsum = ls[gi];
    lsum += __shfl_xor(lsum, 16, 64);
    lsum += __shfl_xor(lsum, 32, 64);
    const float inv = 1.0f / lsum;
    u16* ob = optr(gi);
#pragma unroll
    for (int d4 = 0; d4 < 4; d4++) {
      uint2 w; w.x = pack2(o[gi][d4][0] * inv, o[gi][d4][1] * inv); w.y = pack2(o[gi][d4][2] * inv, o[gi][d4][3] * inv);
      *(uint2*)(ob + (size_t)n * 512 + d4 * 16 + 4 * g) = w;
    }
  }
}

DI void attn_a_latent(const Params& p, int l, int wt) {
  wt = __builtin_amdgcn_readfirstlane(wt);
  const int kvh = wt & 1, qt = (wt >> 1) & 255, b = wt >> 9, q0 = qt * 16;
  const u16* PN = (const u16*)(p.ws + OFF_PN);
  const u16* VT = (const u16*)(p.ws + OFF_VT);
  const u16* VTc = (const u16*)(p.ws + OFF_VTC);
  int jlo = (q0 - 128) & ~31; if (jlo < 0) jlo = 0;
  int jhi = (q0 + 144 + 31) & ~31; if (jhi > SEQ) jhi = SEQ;
  const int ntiles = 8 + (jhi - jlo) / 32;
  const u16* kc = PN + (size_t)(NLAT + b * LC) * PNLD + 512 + kvh * 64;
  const u16* kl = PN + (size_t)(b * SEQ) * PNLD + 512 + kvh * 64;
  const u16* vc = VTc + (size_t)(b * VTR + kvh * 64) * LC;
  const u16* vl = VT + (size_t)(b * VTR + kvh * 64) * SEQ;
  const u16* qb = PN + (size_t)(b * SEQ + q0) * PNLD + kvh * 256;
  u16* ob = (u16*)(p.ws + OFF_Y) + (size_t)(b * SEQ + q0) * 512 + kvh * 256;
  const float* sk = p.sink + l * 8 + kvh * 4;
  auto tilefn = [&](int t, const u16*& kp, const u16*& vp, int& vld, int& aux) {
    if (t < 8) { kp = kc + (size_t)(t * 32) * PNLD; vp = vc + t * 32; vld = LC; aux = -1; }
    else { int j0 = jlo + (t - 8) * 32; kp = kl + (size_t)j0 * PNLD; vp = vl + j0; vld = SEQ; aux = j0; }
  };
  auto scorefn = [&](int gi, int aux, int kidx, int n, float dot) -> float {
    float s = dot * QSC;
    if (aux >= 0) { int dj = aux + kidx - (q0 + n); if (dj > 128 || dj < -128) s = -INFINITY; }
    return s;
  };
  attn_core4([&](int gi) { return qb + gi * 64; }, [&](int gi) { return ob + gi * 64; }, [&](int gi) { return sk[gi] * LOG2E; }, 1.0f,
             ntiles, tilefn, scorefn, [&](int gi, int aux) { return false; });
}

DI void attn_c_latent(const Params& p, int l, int wt, char* lds) {
  wt = __builtin_amdgcn_readfirstlane(wt);
  const int head = wt & 7, r = (wt >> 3) & 63, b = wt >> 9;
  const u16* PN = (const u16*)(p.ws + OFF_PN);
  const u16* VT = (const u16*)(p.ws + OFF_VT);
  const u16* VTc = (const u16*)(p.ws + OFF_VTC);
  int rs = r - 4; rs = rs < 0 ? 0 : (rs > 56 ? 56 : rs);
  const int tok0 = b * SEQ + r * 64;
  const u16* kc = PN + (size_t)(NLAT + b * LC) * PNLD + 2208 + head * 64;
  const u16* kl = PN + (size_t)(b * SEQ) * PNLD + 2208 + head * 64;
  const u16* vc = VTc + (size_t)(b * VTR + 640 + head * 64) * LC;
  const u16* vl = VT + (size_t)(b * VTR + 640 + head * 64) * SEQ;
  float* rpb = (float*)(lds + (threadIdx.x >> 6) * 2048);
  {
    const float* src = p.rpb + (size_t)(l * 8 + head) * 15 * 31;
    const int lane_ = threadIdx.x & 63;
    for (int i = lane_; i < 465; i += 64) rpb[i] = src[i] * LOG2E;
  }
  const u16* qb = PN + (size_t)tok0 * PNLD + 1696 + head * 64;
  u16* ob = (u16*)(p.ws + OFF_Y) + (size_t)2 * NTOK * 512 + (size_t)tok0 * 512 + head * 64;
  auto tilefn = [&](int t, const u16*& kp, const u16*& vp, int& vld, int& aux) {
    if (t < 8) { kp = kc + (size_t)(t * 32) * PNLD; vp = vc + t * 32; vld = LC; aux = -1; }
    else { int a = t - 8; int tk = (rs + (a >> 1)) * 64 + (a & 1) * 32; kp = kl + (size_t)tk * PNLD; vp = vl + tk; vld = SEQ; aux = a; }
  };
  auto scorefn = [&](int gi, int aux, int kidx, int n, float dot) -> float {
    float s = dot * QSC;
    if (aux >= 0) {
      int kcol = (aux & 1) * 32 + kidx, qcol = gi * 16 + n;
      int wsx = qcol - 8; wsx = wsx < 0 ? 0 : (wsx > 48 ? 48 : wsx);
      int drow = rs + (aux >> 1) - r + 7;
      int dc = kcol - qcol; dc = dc < -15 ? -15 : (dc > 15 ? 15 : dc);
      float bias = rpb[drow * 31 + dc + 15];
      s = (kcol >= wsx && kcol < wsx + 16) ? s + bias : -INFINITY;
    }
    return s;
  };
  attn_core4([&](int gi) { return qb + (size_t)gi * 16 * PNLD; }, [&](int gi) { return ob + (size_t)gi * 16 * 512; },
             [&](int gi) { return -INFINITY; }, 0.0f, 24, tilefn, scorefn,
             [&](int gi, int aux) { return aux >= 0 && ((gi == 0 && (aux & 1)) || (gi == 3 && !(aux & 1))); });
}

DI void attn_ctx(const Params& p, int l, int wt, int which) {
  wt = __builtin_amdgcn_readfirstlane(wt);
  const u16* PN = (const u16*)(p.ws + OFF_PN);
  const u16* VTc = (const u16*)(p.ws + OFF_VTC);
  if (which == 0) {
    const int kvh = wt & 1, qt = (wt >> 1) & 15, b = wt >> 5;
    const int row0 = NLAT + b * LC + qt * 16;
    const u16* kc = PN + (size_t)(NLAT + b * LC) * PNLD + 512 + kvh * 64;
    const u16* vc = VTc + (size_t)(b * VTR + kvh * 64) * LC;
    const u16* qb = PN + (size_t)row0 * PNLD + kvh * 256;
    u16* ob = (u16*)(p.ws + OFF_Y) + (size_t)row0 * 512 + kvh * 256;
    const float* sk = p.sink + l * 8 + kvh * 4;
    attn_core4([&](int gi) { return qb + gi * 64; }, [&](int gi) { return ob + gi * 64; }, [&](int gi) { return sk[gi] * LOG2E; }, 1.0f, 8,
               [&](int t, const u16*& kp, const u16*& vp, int& vld, int& aux) { kp = kc + (size_t)(t * 32) * PNLD; vp = vc + t * 32; vld = LC; aux = -1; },
               [&](int gi, int aux, int kidx, int n, float dot) -> float { return dot * QSC; }, [&](int gi, int aux) { return false; });
  } else {
    const int head = wt & 7, q4 = (wt >> 3) & 3, b = wt >> 5;
    const int row0 = NLAT + b * LC + q4 * 64;
    const u16* kc = PN + (size_t)(NLAT + b * LC) * PNLD + 2208 + head * 64;
    const u16* vc = VTc + (size_t)(b * VTR + 640 + head * 64) * LC;
    const u16* qb = PN + (size_t)row0 * PNLD + 1696 + head * 64;
    u16* ob = (u16*)(p.ws + OFF_Y) + (size_t)2 * NTOK * 512 + (size_t)row0 * 512 + head * 64;
    attn_core4([&](int gi) { return qb + (size_t)gi * 16 * PNLD; }, [&](int gi) { return ob + (size_t)gi * 16 * 512; },
               [&](int gi) { return -INFINITY; }, 0.0f, 8,
               [&](int t, const u16*& kp, const u16*& vp, int& vld, int& aux) { kp = kc + (size_t)(t * 32) * PNLD; vp = vc + t * 32; vld = LC; aux = -1; },
               [&](int gi, int aux, int kidx, int n, float dot) -> float { return dot * QSC; }, [&](int gi, int aux) { return false; });
  }
}

constexpr int G_QS = 0, G_KS = 9216, G_KT = 18432, G_VT = 27648, G_ZL = 36864, G_TOT = 40960, G_DEC = 41984, G_END = 42240;
constexpr int NE = 4;
constexpr size_t OFF_SL = OFF_Y + (size_t)2 * NTOK * 512 * 2;
constexpr size_t OFF_DS = OFF_PAD + (524288u);

template <int PASS>
DI void task_gla(const Params& p, int l, int id, char* lds) {
  int seg, rest;
  if (PASS == 1) { seg = id & 15; rest = id >> 4; } else { seg = 16 - (id % 17); rest = id / 17; }
  const int sl = rest & 1, dir = (rest >> 1) & 1, h = (rest >> 2) & 3, b = rest >> 4, combo = rest >> 1;
  const int tid = threadIdx.x, lane = tid & 63, wave = tid >> 6, g = lane >> 4, n = lane & 15;
  const u16* PN = (const u16*)(p.ws + OFF_PN);
  u16* odst = dir ? (u16*)(p.ws + OFF_OB) : (u16*)(p.ws + OFF_Y) + (size_t)NTOK * 512;
  float* SL = (float*)(p.ws + OFF_SL);
  float* DS = (float*)(p.ws + OFF_DS);
  const float* gwp = (dir ? p.gw_b : p.gw_f) + (size_t)l * 16 * 256 + h * 64 + lane;
  const float* gbp = (dir ? p.gb_b : p.gb_f) + l * 256 + h * 64 + lane;
  f32x4 S[4][NE];
#pragma unroll
  for (int i = 0; i < 4; i++)
#pragma unroll
    for (int j = 0; j < NE; j++) S[i][j] = f32x4{0.f, 0.f, 0.f, 0.f};
  if (PASS == 2) {
    const float* sl_src = SL + ((size_t)(rest * 17 + seg)) * (1024 * NE) + lane * 4;
#pragma unroll
    for (int dt = 0; dt < 4; dt++)
#pragma unroll
      for (int et = 0; et < NE; et++) S[dt][et] = *(const f32x4*)(sl_src + (dt * NE + et) * 256);
  }
  float* ZL = (float*)(lds + G_ZL);
  float* TOT = (float*)(lds + G_TOT);
  float* DEC = (float*)(lds + G_DEC);
  float totsum = 0.f;

  int tb = 0, rowbase = 0;
  uint4 rq0, rq1, rk0, rk1, rz, rv, rv2;
  rq0 = rq1 = rz = uint4{0, 0, 0, 0};
  auto gload = [&](int ch) {
    int vld; const u16* vsrc;
    if (ch < 4) {
      tb = dir ? 192 - 64 * ch : 64 * ch; rowbase = NLAT + b * LC; vld = LC;
      vsrc = (const u16*)(p.ws + OFF_VTC) + (size_t)(b * VTR + 128 + h * 128 + sl * 64) * LC;
    } else {
      tb = dir ? SEQ - 64 * (ch - 3) : 64 * (ch - 4); rowbase = b * SEQ; vld = SEQ;
      vsrc = (const u16*)(p.ws + OFF_VT) + (size_t)(b * VTR + 128 + h * 128 + sl * 64) * SEQ;
    }
    {
      int row = tid >> 3, kc = tid & 7;
      int tok0 = dir ? tb + 63 - row : tb + row, tok1 = dir ? tb + 31 - row : tb + 32 + row;
      const u16* s0 = PN + (size_t)(rowbase + tok0) * PNLD + h * 64 + kc * 8;
      const u16* s1 = PN + (size_t)(rowbase + tok1) * PNLD + h * 64 + kc * 8;
      if (PASS == 2) { rq0 = *(const uint4*)(s0 + 640); rq1 = *(const uint4*)(s1 + 640); }
      rk0 = *(const uint4*)(s0 + 896); rk1 = *(const uint4*)(s1 + 896);
    }
    if (tid < 128) {
      int row = tid >> 1, hc = tid & 1;
      int tok = dir ? tb + 63 - row : tb + row;
      rz = *(const uint4*)(PN + (size_t)(rowbase + tok) * PNLD + 1664 + dir * 16 + hc * 8);
    }
    rv = *(const uint4*)(vsrc + (size_t)(tid >> 3) * vld + tb + (tid & 7) * 8);
    rv2 = *(const uint4*)(vsrc + (size_t)(32 + (tid >> 3)) * vld + tb + (tid & 7) * 8);
  };
  gload(seg * 4);

  for (int ci = 0; ci < 4; ci++) {
    const int ctb = tb, crowbase = rowbase;
    float gw[16];
#pragma unroll
    for (int r = 0; r < 16; r++) gw[r] = gwp[r * 256];
    const float gbias = gbp[0];
    __syncthreads();
    {
      int row = tid >> 3, kc = tid & 7;
      if (PASS == 2) {
        *(uint4*)(lds + G_QS + row * LROW + kc * 16) = rq0;
        *(uint4*)(lds + G_QS + (row + 32) * LROW + kc * 16) = rq1;
      }
      *(uint4*)(lds + G_KS + row * LROW + kc * 16) = rk0;
      *(uint4*)(lds + G_KS + (row + 32) * LROW + kc * 16) = rk1;
    }
    if (tid < 128) {
      int row = tid >> 1, hc = tid & 1;
      float* zd = ZL + row * 16 + hc * 8;
      zd[0] = __uint_as_float(rz.x << 16); zd[1] = __uint_as_float(rz.x & 0xffff0000u);
      zd[2] = __uint_as_float(rz.y << 16); zd[3] = __uint_as_float(rz.y & 0xffff0000u);
      zd[4] = __uint_as_float(rz.z << 16); zd[5] = __uint_as_float(rz.z & 0xffff0000u);
      zd[6] = __uint_as_float(rz.w << 16); zd[7] = __uint_as_float(rz.w & 0xffff0000u);
    }
    {
      int e = tid >> 3, kc = tid & 7;
      if (dir) {
        uint4 rr;
        rr.x = (rv.w >> 16) | (rv.w << 16); rr.y = (rv.z >> 16) | (rv.z << 16);
        rr.z = (rv.y >> 16) | (rv.y << 16); rr.w = (rv.x >> 16) | (rv.x << 16);
        *(uint4*)(lds + G_VT + e * LROW + (7 - kc) * 16) = rr;
        rr.x = (rv2.w >> 16) | (rv2.w << 16); rr.y = (rv2.z >> 16) | (rv2.z << 16);
        rr.z = (rv2.y >> 16) | (rv2.y << 16); rr.w = (rv2.x >> 16) | (rv2.x << 16);
        *(uint4*)(lds + G_VT + (32 + e) * LROW + (7 - kc) * 16) = rr;
      } else {
        *(uint4*)(lds + G_VT + e * LROW + kc * 16) = rv;
        *(uint4*)(lds + G_VT + (32 + e) * LROW + kc * 16) = rv2;
      }
    }
    __syncthreads();
    float bv[16];
    {
      float run = 0.f;
#pragma unroll
      for (int tt = 0; tt < 16; tt++) {
        const float4* zr = (const float4*)(ZL + (wave * 16 + tt) * 16);
        float z = gbias;
#pragma unroll
        for (int q = 0; q < 4; q++) {
          float4 zz = zr[q];
          z += zz.x * gw[q * 4 + 0] + zz.y * gw[q * 4 + 1] + zz.z * gw[q * 4 + 2] + zz.w * gw[q * 4 + 3];
        }
        float lsg = fminf(z, 0.f) - __logf(1.0f + __expf(-fabsf(z)));
        run += lsg * (1.0f / 16.0f);
        bv[tt] = run;
      }
      TOT[wave * 64 + lane] = run;
    }
    __syncthreads();
    {
      float off = 0.f, tot = 0.f;
#pragma unroll
      for (int s = 0; s < 4; s++) { float tv = TOT[s * 64 + lane]; if (s < wave) off += tv; tot += tv; }
      totsum += tot;
      const float dtot = __expf(tot);
      if (wave == 0) DEC[lane] = dtot;
      unsigned ktp[8];
#pragma unroll
      for (int tt = 0; tt < 16; tt++) {
        const int t = wave * 16 + tt;
        const float bq = bv[tt] + off;
        u16* ka = (u16*)(lds + G_KS + t * LROW) + lane;
        const float kv = bf2f(*ka);
        const float e1 = __expf(bq), e2 = __builtin_amdgcn_rcpf(e1);
        if (PASS == 2) {
          u16* qa = (u16*)(lds + G_QS + t * LROW) + lane;
          const float qv = bf2f(*qa);
          *qa = f2bf(qv * 0.125f * e1);
          *ka = f2bf(kv * e2);
        }
        const unsigned kt = f2bf(kv * (dtot * e2));
        if (tt & 1) ktp[tt >> 1] |= kt << 16; else ktp[tt >> 1] = kt;
      }
      uint4* kd = (uint4*)(lds + G_KT + lane * LROW + wave * 32);
      kd[0] = uint4{ktp[0], ktp[1], ktp[2], ktp[3]};
      kd[1] = uint4{ktp[4], ktp[5], ktp[6], ktp[7]};
    }
    __syncthreads();
    if (ci < 3) gload(seg * 4 + ci + 1);
    if (PASS == 2) {
      bf16x8 qf[2];
      qf[0] = *(const bf16x8*)(lds + G_QS + (wave * 16 + n) * LROW + g * 16);
      qf[1] = *(const bf16x8*)(lds + G_QS + (wave * 16 + n) * LROW + 64 + g * 16);
      f32x4 X[4];
#pragma unroll
      for (int jt = 0; jt < 4; jt++) {
        X[jt] = f32x4{0.f, 0.f, 0.f, 0.f};
#pragma unroll
        for (int s = 0; s < 2; s++) {
          bf16x8 kf = *(const bf16x8*)(lds + G_KS + (jt * 16 + n) * LROW + s * 64 + g * 16);
          X[jt] = MFMA16(kf, qf[s], X[jt]);
        }
#pragma unroll
        for (int r = 0; r < 4; r++) if (jt * 16 + 4 * g + r > wave * 16 + n) X[jt][r] = 0.f;
      }
      f32x4 o[NE];
#pragma unroll
      for (int et = 0; et < NE; et++) o[et] = f32x4{0.f, 0.f, 0.f, 0.f};
#pragma unroll
      for (int kk = 0; kk < 2; kk++) {
        union { bf16x8 v; unsigned u[4]; } pa;
        pa.u[0] = pack2(X[2 * kk][0], X[2 * kk][1]); pa.u[1] = pack2(X[2 * kk][2], X[2 * kk][3]);
        pa.u[2] = pack2(X[2 * kk + 1][0], X[2 * kk + 1][1]); pa.u[3] = pack2(X[2 * kk + 1][2], X[2 * kk + 1][3]);
        const char* qr = lds + G_QS + (wave * 16 + n) * LROW + kk * 64 + g * 8;
        s16x4 qa = *(const s16x4*)(qr), qb = *(const s16x4*)(qr + 32);
        bf16x8 qp = __builtin_shufflevector(qa, qb, 0, 1, 2, 3, 4, 5, 6, 7);
#pragma unroll
        for (int et = 0; et < NE; et++) {
          const char* vr = lds + G_VT + (et * 16 + n) * LROW + kk * 64 + g * 8;
          s16x4 va = *(const s16x4*)(vr), vb = *(const s16x4*)(vr + 32);
          bf16x8 vf = __builtin_shufflevector(va, vb, 0, 1, 2, 3, 4, 5, 6, 7);
          o[et] = MFMA16(pa.v, vf, o[et]);
          union { bf16x8 v; unsigned u[4]; } sb;
          sb.u[0] = pack2(S[2 * kk][et][0], S[2 * kk][et][1]); sb.u[1] = pack2(S[2 * kk][et][2], S[2 * kk][et][3]);
          sb.u[2] = pack2(S[2 * kk + 1][et][0], S[2 * kk + 1][et][1]); sb.u[3] = pack2(S[2 * kk + 1][et][2], S[2 * kk + 1][et][3]);
          o[et] = MFMA16(qp, sb.v, o[et]);
        }
      }
#pragma unroll
      for (int r = 0; r < 4; r++) {
        int i = wave * 16 + 4 * g + r;
        int tok = dir ? ctb + 63 - i : ctb + i;
        u16* orow = odst + (size_t)(crowbase + tok) * 512 + h * 128 + sl * 64 + n;
#pragma unroll
        for (int et = 0; et < NE; et++) orow[et * 16] = f2bf(o[et][r]);
      }
    }
    if (PASS == 1 || ci < 3) {
      bf16x8 vfr[NE][2];
#pragma unroll
      for (int et = 0; et < NE; et++)
#pragma unroll
        for (int s = 0; s < 2; s++) vfr[et][s] = *(const bf16x8*)(lds + G_VT + (et * 16 + n) * LROW + s * 64 + g * 16);
#pragma unroll
      for (int dt = 0; dt < 4; dt++) {
        bf16x8 kf0 = *(const bf16x8*)(lds + G_KT + (dt * 16 + n) * LROW + g * 16);
        bf16x8 kf1 = *(const bf16x8*)(lds + G_KT + (dt * 16 + n) * LROW + 64 + g * 16);
        const f32x4 dc = *(const f32x4*)(DEC + dt * 16 + 4 * g);
#pragma unroll
        for (int et = 0; et < NE; et++) {
          f32x4 u = {0.f, 0.f, 0.f, 0.f};
          u = MFMA16(kf0, vfr[et][0], u);
          u = MFMA16(kf1, vfr[et][1], u);
          S[dt][et] = S[dt][et] * dc + u;
        }
      }
    }
  }
  if (PASS == 1 && wave == 0) {
    float* dst = SL + ((size_t)(rest * 17 + seg)) * (1024 * NE) + lane * 4;
#pragma unroll
    for (int dt = 0; dt < 4; dt++)
#pragma unroll
      for (int et = 0; et < NE; et++) *(f32x4*)(dst + (dt * NE + et) * 256) = S[dt][et];
    if (sl == 0) DS[(size_t)(combo * 17 + seg) * 64 + lane] = totsum;
  }
}

DI void task_gla_prefix(const Params& p, int rest) {
  const int tid = threadIdx.x, combo = rest >> 1;
  constexpr int SSZ = 1024 * NE;
  float* SL = (float*)(p.ws + OFF_SL) + (size_t)rest * 17 * SSZ + tid * 16;
  const int tile = tid >> 4, g4 = (tid & 15) >> 2;
  const float* DS = (const float*)(p.ws + OFF_DS) + (size_t)combo * 17 * 64 + (tile / NE) * 16 + 4 * g4;
  f32x4 s0 = {0.f, 0.f, 0.f, 0.f}, s1 = s0, s2 = s0, s3 = s0;
#pragma unroll 2
  for (int seg = 0; seg < 16; seg++) {
    float* q = SL + (size_t)seg * SSZ;
    const f32x4 c0 = *(const f32x4*)(q), c1 = *(const f32x4*)(q + 4), c2 = *(const f32x4*)(q + 8), c3 = *(const f32x4*)(q + 12);
    const f32x4 dl = *(const f32x4*)(DS + seg * 64);
    *(f32x4*)(q) = s0; *(f32x4*)(q + 4) = s1; *(f32x4*)(q + 8) = s2; *(f32x4*)(q + 12) = s3;
    const f32x4 dc = {__expf(dl[0]), __expf(dl[1]), __expf(dl[2]), __expf(dl[3])};
    s0 = s0 * dc + c0; s1 = s1 * dc + c1; s2 = s2 * dc + c2; s3 = s3 * dc + c3;
  }
  float* q = SL + (size_t)16 * SSZ;
  *(f32x4*)(q) = s0; *(f32x4*)(q + 4) = s1; *(f32x4*)(q + 8) = s2; *(f32x4*)(q + 12) = s3;
}

DI void task_gla_out(const Params& p, int l, int task) {
  const int lane = threadIdx.x & 63, wave = threadIdx.x >> 6;
  const int row0 = task * 16 + wave * 4;
  u16* of = (u16*)(p.ws + OFF_Y) + (size_t)NTOK * 512 + (size_t)row0 * 512 + lane * 8;
  const u16* ob = (const u16*)(p.ws + OFF_OB) + (size_t)row0 * 512 + lane * 8;
  const u16* gr = (const u16*)(p.ws + OFF_PN) + (size_t)row0 * PNLD + 1152 + lane * 8;
  uint4 a[4], bb[4], rr[4];
#pragma unroll
  for (int q = 0; q < 4; q++) { a[q] = *(const uint4*)(of + q * 512); bb[q] = *(const uint4*)(ob + q * 512); rr[q] = *(const uint4*)(gr + (size_t)q * PNLD); }
  const float* gn = p.gla_norm + l * 128 + (lane & 15) * 8;
  float gnv[8];
#pragma unroll
  for (int i = 0; i < 8; i++) gnv[i] = gn[i];
#pragma unroll
  for (int q = 0; q < 4; q++) {
    const unsigned au[4] = {a[q].x, a[q].y, a[q].z, a[q].w}, bu[4] = {bb[q].x, bb[q].y, bb[q].z, bb[q].w}, ru[4] = {rr[q].x, rr[q].y, rr[q].z, rr[q].w};
    float v[8], rv[8], ss = 0.f;
#pragma unroll
    for (int i = 0; i < 4; i++) {
      v[2 * i] = __uint_as_float(au[i] << 16) + __uint_as_float(bu[i] << 16);
      v[2 * i + 1] = __uint_as_float(au[i] & 0xffff0000u) + __uint_as_float(bu[i] & 0xffff0000u);
      rv[2 * i] = __uint_as_float(ru[i] << 16);
      rv[2 * i + 1] = __uint_as_float(ru[i] & 0xffff0000u);
      ss += v[2 * i] * v[2 * i] + v[2 * i + 1] * v[2 * i + 1];
    }
    ss += __shfl_xor(ss, 1, 64); ss += __shfl_xor(ss, 2, 64); ss += __shfl_xor(ss, 4, 64); ss += __shfl_xor(ss, 8, 64);
    const float rstd = rsqrtf(ss * (1.0f / 128.0f) + 1e-6f);
    float o[8];
#pragma unroll
    for (int i = 0; i < 8; i++) o[i] = v[i] * rstd * gnv[i] * siluf_(rv[i]);
    uint4 w; w.x = pack2(o[0], o[1]); w.y = pack2(o[2], o[3]); w.z = pack2(o[4], o[5]); w.w = pack2(o[6], o[7]);
    *(uint4*)(of + q * 512) = w;
  }
}

constexpr size_t OFF_GQ = OFF_ACT;
static_assert(OFF_GQ + (size_t)3072 * NTOK <= OFF_Y, "gate alias");

DI void task_gates(const Params& p, int l, int tile, char* lds) {
  const int mt = tile / 12, nt = tile % 12;
  const int tid = threadIdx.x, lane = tid & 63, wave = tid >> 6;
  const int wm = wave >> 1, wn = wave & 1, g = lane >> 4, n = lane & 15;
  f32x4 acc[4][8];
#pragma unroll
  for (int i = 0; i < 4; i++)
#pragma unroll
    for (int j = 0; j < 8; j++) acc[i][j] = f32x4{0.f, 0.f, 0.f, 0.f};
  gemm_wide((const u16*)(p.ws + OFF_HB) + (size_t)mt * 128 * 32, NTOK, (const u16*)(p.ws + OFF_WMG) + (size_t)nt * 256 * 32, 3072, D, acc, lds);
  unsigned char* GQ = (unsigned char*)(p.ws + OFF_GQ);
  const float* bm = p.b_merge + l * 3072 + nt * 256 + wn * 128 + n;
#pragma unroll
  for (int ni = 0; ni < 8; ni++) {
    const float bias = bm[ni * 16];
    const size_t col = (size_t)(nt * 256 + wn * 128 + ni * 16 + n);
#pragma unroll
    for (int mi = 0; mi < 4; mi++) {
      const int row0 = mt * 128 + wm * 64 + mi * 16 + 4 * g;
      unsigned q0 = (unsigned)(sigmoidf_(acc[mi][ni][0] + bias) * 255.0f + 0.5f);
      unsigned q1 = (unsigned)(sigmoidf_(acc[mi][ni][1] + bias) * 255.0f + 0.5f);
      unsigned q2 = (unsigned)(sigmoidf_(acc[mi][ni][2] + bias) * 255.0f + 0.5f);
      unsigned q3 = (unsigned)(sigmoidf_(acc[mi][ni][3] + bias) * 255.0f + 0.5f);
      *(unsigned*)(GQ + col * NTOK + row0) = q0 | (q1 << 8) | (q2 << 16) | (q3 << 24);
    }
  }
}

DI void task_mg(const Params& p, int l, int tile, char* lds) {
  const int mt = tile >> 3, nt = tile & 7;
  const int tid = threadIdx.x, lane = tid & 63, wave = tid >> 6;
  const int wm = wave >> 1, wn = wave & 1, g = lane >> 4, n = lane & 15;
  f32x4 mix[4][4];
  zero_acc<4>(mix);
  const unsigned char* GQ = (const unsigned char*)(p.ws + OFF_GQ);
#pragma unroll 1
  for (int br = 0; br < 3; br++) {
    f32x4 acc[4][4];
    zero_acc<4>(acc);
    gemm_tile<4, 0>((const u16*)(p.ws + OFF_Y) + (size_t)br * NTOK * 512 + (size_t)mt * 128 * 512, 512,
                 (const u16*)(p.ws + OFF_WBR) + (size_t)br * 1024 * 512 + (size_t)nt * 128 * 512, 512, 512, acc, lds);
#pragma unroll
    for (int ni = 0; ni < 4; ni++) {
      const size_t col = (size_t)(br * 1024 + nt * 128 + wn * 64 + ni * 16 + n);
#pragma unroll
      for (int mi = 0; mi < 4; mi++) {
        const int row0 = mt * 128 + wm * 64 + mi * 16 + 4 * g;
        const unsigned q = *(const unsigned*)(GQ + col * NTOK + row0);
        mix[mi][ni][0] += (float)(q & 255u) * (1.0f / 255.0f) * acc[mi][ni][0];
        mix[mi][ni][1] += (float)((q >> 8) & 255u) * (1.0f / 255.0f) * acc[mi][ni][1];
        mix[mi][ni][2] += (float)((q >> 16) & 255u) * (1.0f / 255.0f) * acc[mi][ni][2];
        mix[mi][ni][3] += (float)(q >> 24) * (1.0f / 255.0f) * acc[mi][ni][3];
      }
    }
  }
  u16* mx = (u16*)(p.ws + OFF_MIXED);
#pragma unroll
  for (int mi = 0; mi < 4; mi++)
#pragma unroll
    for (int ni = 0; ni < 4; ni++)
#pragma unroll
      for (int r = 0; r < 4; r++)
      {
        const int row = mt * 128 + wm * 64 + mi * 16 + 4 * g + r, col = nt * 128 + wn * 64 + ni * 16 + n;
        mx[((size_t)(col >> 5) * NTOK + row) * 32 + (col & 31)] = f2bf(mix[mi][ni][r]);
      }
}

DI void task_res_wide(const Params& p, int l, int tile, const u16* A, int lda, const u16* Wt, int K, int gate_idx, bool first, char* lds) {
  const int mt = tile >> 2, nt = tile & 3;
  const int tid = threadIdx.x, lane = tid & 63, wave = tid >> 6;
  const int wm = wave >> 1, wn = wave & 1, g = lane >> 4, n = lane & 15;
  f32x4 acc[4][8];
#pragma unroll
  for (int i = 0; i < 4; i++)
#pragma unroll
    for (int j = 0; j < 8; j++) acc[i][j] = f32x4{0.f, 0.f, 0.f, 0.f};
  gemm_wide(A + (size_t)mt * 128 * 32, NTOK, Wt + (size_t)nt * 256 * 32, D, K, acc, lds);
  const float* gt = modp(p, l, mt * 128) + gate_idx * D + nt * 256 + wn * 128 + n;
#pragma unroll
  for (int ni = 0; ni < 8; ni++) {
    const float gv = gt[ni * 16];
#pragma unroll
    for (int mi = 0; mi < 4; mi++)
#pragma unroll
      for (int r = 0; r < 4; r++) {
        int row = mt * 128 + wm * 64 + mi * 16 + 4 * g + r, col = nt * 256 + wn * 128 + ni * 16 + n;
        const float* xs = first ? xsrc(p, l, row) : (const float*)xdst(p, row);
        xdst(p, row)[col] = xs[col] + gv * acc[mi][ni][r];
      }
  }
}

DI void task_res_ctx(const Params& p, int l, int tile, const u16* A, int lda, const u16* Wt, int K, int gate_idx, bool first, char* lds) {
  const int mt = 128 + (tile >> 4), nt = tile & 15;
  const int tid = threadIdx.x, lane = tid & 63, wave = tid >> 6;
  const int wm = wave >> 1, wn = wave & 1, g = lane >> 4, n = lane & 15;
  f32x4 acc[4][2];
  zero_acc<2>(acc);
  gemm_tile<2, 1>(A + (size_t)mt * 128 * 32, NTOK, Wt + (size_t)nt * 64 * 32, D, K, acc, lds);
  const float* gt = modp(p, l, mt * 128) + gate_idx * D + nt * 64 + wn * 32 + n;
#pragma unroll
  for (int ni = 0; ni < 2; ni++) {
    const float gv = gt[ni * 16];
#pragma unroll
    for (int mi = 0; mi < 4; mi++)
#pragma unroll
      for (int r = 0; r < 4; r++) {
        int row = mt * 128 + wm * 64 + mi * 16 + 4 * g + r, col = nt * 64 + wn * 32 + ni * 16 + n;
        const float* xs = first ? xsrc(p, l, row) : (const float*)xdst(p, row);
        xdst(p, row)[col] = xs[col] + gv * acc[mi][ni][r];
      }
  }
}

DI void task_f1(const Params& p, int tile, char* lds) {
  const int mt = tile / 22, nt = tile % 22;
  const int tid = threadIdx.x, lane = tid & 63, wave = tid >> 6;
  const int wm = wave >> 1, wn = wave & 1, g = lane >> 4, n = lane & 15;
  f32x4 acc[4][8];
#pragma unroll
  for (int i = 0; i < 4; i++)
#pragma unroll
    for (int j = 0; j < 8; j++) acc[i][j] = f32x4{0.f, 0.f, 0.f, 0.f};
  gemm_wide((const u16*)(p.ws + OFF_HB) + (size_t)mt * 128 * 32, NTOK, (const u16*)(p.ws + OFF_WF1) + (size_t)nt * 256 * 32, 2 * FH, D, acc, lds);
  u16* act = (u16*)(p.ws + OFF_ACT);
#pragma unroll
  for (int mi = 0; mi < 4; mi++)
#pragma unroll
    for (int ni = 0; ni < 4; ni++)
#pragma unroll
      for (int r = 0; r < 4; r++) {
        int row = mt * 128 + wm * 64 + mi * 16 + 4 * g + r, col = nt * 128 + wn * 64 + ni * 16 + n;
        act[((size_t)(col >> 5) * NTOK + row) * 32 + (col & 31)] = f2bf(siluf_(acc[mi][ni][r]) * acc[mi][ni + 4][r]);
      }
}

#define XB_TMO      128
#define XB_XCNT(j)  (256  + 64 * (j))
#define XB_XSUB(j)  (1280 + 64 * (j))
#define XB_XGEN(j)  (2304 + 64 * (j))
#define XB_TOP      3328
#define XB_TOPGEN   3392
#define XCD_BAR_WORDS 3456
#define XB_SPIN_CAP (1u << 18)
#define LAS __attribute__((address_space(3)))

__device__ __forceinline__ unsigned xb_ld(unsigned* p)              { return __hip_atomic_load(p, __ATOMIC_RELAXED, __HIP_MEMORY_SCOPE_AGENT); }
__device__ __forceinline__ unsigned xb_add(unsigned* p, unsigned v) { return __hip_atomic_fetch_add(p, v, __ATOMIC_RELAXED, __HIP_MEMORY_SCOPE_AGENT); }
__device__ __forceinline__ unsigned xb_xcc_id() { return (unsigned)__builtin_amdgcn_s_getreg((3 << 11) | 20) & 0xFu; }
#define XB_SPIN(cond, bar) do { unsigned _sp = 0; while (cond) { __builtin_amdgcn_s_sleep(1); \
    if ((++_sp & 255u) == 0u) { if (xb_ld(&(bar)[XB_TMO])) break; if (_sp > XB_SPIN_CAP) { atomicAdd(&(bar)[XB_TMO], 1u); break; } } } } while (0)

struct XcdBarrier {
    unsigned* bar; unsigned x;
    volatile LAS unsigned* st;
};

__device__ __forceinline__ XcdBarrier xcd_barrier_post(unsigned* bar, volatile LAS unsigned* st) {
    XcdBarrier b; b.bar = bar; b.x = xb_xcc_id(); b.st = st;
    if (threadIdx.x == 0) (void)xb_add(&bar[XB_XCNT(b.x)], 1u);
    return b;
}
__device__ __forceinline__ void xcd_barrier_complete(unsigned* bar, unsigned x, unsigned& nloc, unsigned& nx) {
    const unsigned G = gridDim.x * gridDim.y * gridDim.z;
    unsigned sum, cnt, mine, sp = 0u;
    for (;;) {
        sum = 0u; cnt = 0u; mine = 0u;
#pragma unroll
        for (unsigned j = 0; j < 16; ++j) { const unsigned c = xb_ld(&bar[XB_XCNT(j)]); sum += c; cnt += (c > 0u) ? 1u : 0u; mine = (j == x) ? c : mine; }
        if (sum == G) break;
        __builtin_amdgcn_s_sleep(1);
        if ((++sp & 255u) == 0u) { if (xb_ld(&bar[XB_TMO])) break; if (sp > XB_SPIN_CAP) { atomicAdd(&bar[XB_TMO], 1u); break; } }
    }
    nloc = mine > 0u ? mine : 1u; nx = cnt > 0u ? cnt : 1u;
}

__device__ __forceinline__ void xcd_barrier(const XcdBarrier& b) {
    asm volatile("s_waitcnt vmcnt(0)" ::: "memory");
    __syncthreads();
    if (threadIdx.x == 0) {
        unsigned* bar = b.bar;
        __builtin_amdgcn_s_waitcnt(0);
        unsigned nloc = b.st[0], nx = b.st[1];
        if (nloc == 0u) { xcd_barrier_complete(bar, b.x, nloc, nx); b.st[0] = nloc; b.st[1] = nx; }
        const unsigned old = xb_add(&bar[XB_XSUB(b.x)], 1u);
        const unsigned gen = old / nloc;
        if (old + 1u == (gen + 1u) * nloc) {
            __builtin_amdgcn_fence(__ATOMIC_RELEASE, "agent");
            asm volatile("s_waitcnt vmcnt(0)" ::: "memory");
            const unsigned og = xb_add(&bar[XB_TOP], 1u);
            const unsigned tg = og / nx;
            if (og + 1u == (tg + 1u) * nx) xb_add(&bar[XB_TOPGEN], 1u);
            else XB_SPIN(xb_ld(&bar[XB_TOPGEN]) == tg, bar);
            __builtin_amdgcn_fence(__ATOMIC_ACQUIRE, "agent");
            xb_add(&bar[XB_XGEN(b.x)], 1u);
            asm volatile("s_waitcnt vmcnt(0)" ::: "memory");
        } else {
            XB_SPIN(xb_ld(&bar[XB_XGEN(b.x)]) == gen, bar);
            __builtin_amdgcn_fence(__ATOMIC_ACQUIRE, "agent");
            asm volatile("s_waitcnt vmcnt(0)" ::: "memory");
        }
    }
    __syncthreads();
}


DI int xcd_swizzle(int t, int nb, int ntiles) {
  const int r = t / nb;
  if ((nb & 7) || (r + 1) * nb > ntiles) return t;
  const int b = t - r * nb, per = nb >> 3;
  return r * nb + (b & 7) * per + (b >> 3);
}

constexpr int NPHASE = 26;
constexpr int SMEM_BYTES = 2 * GBUF;

DI void run_phase(const Params& p, int ph, char* lds) {
  const int bid = blockIdx.x, nb = gridDim.x, wave = threadIdx.x >> 6;
  if (ph == 0) {
    for (int t = bid; t < 192 + 512 + CONV1_TASKS; t += nb) {
      if (t < 192) task_mod(p, t, lds); else if (t < 704) task_rope(p, t - 192); else task_conv1(p, 0, t - 704, lds);
    }
    return;
  }
  if (ph == 25) { for (int t = bid; t < NLAT / 16; t += nb) task_final_norm(p, t); return; }
  const int l = (ph - 1) / 12; int sp = (ph - 1) % 12;
  const bool last = l == 1;
  const int mtiles = last ? 128 : 136;
  if (sp >= 7) sp = (sp == 7) ? 11 : sp - 1;
  switch (sp) {
    case 0: for (int t = bid; t < NTOK / 16; t += nb) task_norm(p, l, t, 0); break;
    case 1: {
      for (int t = bid; t < 136 * 15; t += nb) task_g1(p, l, xcd_swizzle(t, nb, 136 * 15), lds);
      for (int t = (bid + nb - ((136 * 15) % nb)) % nb; t < 136; t += nb) task_g1_tail(p, l, t, lds);
    } break;
    case 2: for (int t = bid; t < 1024; t += nb) task_gla<1>(p, l, xcd_swizzle(t, nb, 1024), lds); break;
    case 3: {
      for (int t = bid; t < 64; t += nb) task_gla_prefix(p, t);
      for (int t = bid; t < 512; t += nb) attn_a_latent(p, l, xcd_swizzle(t, nb, 512) * 4 + wave);
      if (!last) for (int t = bid; t < 32; t += nb) attn_ctx(p, l, (31 - t) * 4 + wave, 0);
    } break;
    case 4: for (int t = bid; t < 1088; t += nb) task_gla<2>(p, l, xcd_swizzle(t, nb, 1088), lds); break;
    case 5: {
      __syncthreads();
      for (int t = bid; t < 512; t += nb) attn_c_latent(p, l, xcd_swizzle(t, nb, 512) * 4 + wave, lds);
      if (!last) for (int t = bid; t < 32; t += nb) attn_ctx(p, l, t * 4 + wave, 1);
      for (int t = bid; t < (last ? NLAT : NTOK) / 16; t += nb) task_gla_out(p, l, t);
    } break;
    case 6: for (int t = bid; t < mtiles * 12; t += nb) task_gates(p, l, xcd_swizzle(t, nb, mtiles * 12), lds); break;
    case 11: for (int t = bid; t < mtiles * 8; t += nb) task_mg(p, l, xcd_swizzle(t, nb, mtiles * 8), lds); break;
    case 7: {
      for (int t = bid; t < 512; t += nb) task_res_wide(p, l, xcd_swizzle(t, nb, 512), (const u16*)(p.ws + OFF_MIXED), D, (const u16*)(p.ws + OFF_WOUT), D, 2, true, lds);
      if (!last) for (int t = bid; t < 128; t += nb) task_res_ctx(p, l, t, (const u16*)(p.ws + OFF_MIXED), D, (const u16*)(p.ws + OFF_WOUT), D, 2, true, lds);
      for (int t = (bid + nb - (last ? 0 : 128)) % nb; t < CONV2_TASKS; t += nb) task_conv2(p, l, t, lds);
    } break;
    case 8: for (int t = bid; t < (last ? NLAT : NTOK) / 16; t += nb) task_norm(p, l, t, 1); break;
    case 9: for (int t = bid; t < mtiles * 22; t += nb) task_f1(p, xcd_swizzle(t, nb, mtiles * 22), lds); break;
    case 10: {
      for (int t = bid; t < 512; t += nb) task_res_wide(p, l, xcd_swizzle(t, nb, 512), (const u16*)(p.ws + OFF_ACT), FH, (const u16*)(p.ws + OFF_WF2), FH, 5, false, lds);
      if (!last) {
        for (int t = bid; t < 128; t += nb) task_res_ctx(p, l, t, (const u16*)(p.ws + OFF_ACT), FH, (const u16*)(p.ws + OFF_WF2), FH, 5, false, lds);
        for (int t = (bid + nb - 128) % nb; t < CONV1_TASKS; t += nb) task_conv1(p, 1, t, lds);
      }
    } break;
  }
}

#if MULTI_LAUNCH
__global__ void __launch_bounds__(256, 2) k_phase(Params p, int ph) {
  __shared__ __attribute__((aligned(16))) char smem[SMEM_BYTES];
  run_phase(p, ph, smem);
}
#endif

#if !MULTI_LAUNCH
__global__ void __launch_bounds__(256, 2) k_mega(Params p) {
  extern __shared__ __attribute__((aligned(16))) char smem[];
  __shared__ uint4 xb_words;
  if (threadIdx.x == 0) xb_words = make_uint4(0u, 0u, 0u, 0u);
  __syncthreads();
  XcdBarrier xb = xcd_barrier_post((unsigned*)(p.ws + OFF_BAR), (volatile LAS unsigned*)&xb_words);
  if (p.ws == nullptr) cg::this_grid().sync();
#define PH(k) run_phase(p, k, smem); xcd_barrier(xb);
  PH(0) PH(1) PH(2) PH(3) PH(4) PH(5) PH(6) PH(7) PH(8) PH(9) PH(10) PH(11) PH(12) PH(13) PH(14) PH(15) PH(16) PH(17) PH(18) PH(19) PH(20) PH(21) PH(22) PH(23) PH(24)
  run_phase(p, 25, smem);
}
#endif

extern "C" void kernel_launch(void* const* d_in, const int* in_sizes, int n_in, void* d_out, int out_size, void* d_ws, size_t ws_size,
                              hipStream_t stream) {
  Params p{};
  const float** f = (const float**)&p;
  for (int i = 0; i < 25; i++) f[i] = (const float*)d_in[i];
  p.out = (float*)d_out;
  p.ws = (char*)d_ws;
#if MULTI_LAUNCH
  for (int ph = 0; ph < NPHASE; ph++) hipLaunchKernelGGL(k_phase, dim3(512), dim3(256), 0, stream, p, ph);
#else
  static int grid_blocks = 0;
  if (!grid_blocks) {
    int dev = 0, cus = 0, per_cu = 0;
    hipGetDevice(&dev);
    hipDeviceGetAttribute(&cus, hipDeviceAttributeMultiprocessorCount, dev);
    (void)hipFuncSetAttribute((const void*)k_mega, hipFuncAttributeMaxDynamicSharedMemorySize, SMEM_BYTES);
    (void)hipOccupancyMaxActiveBlocksPerMultiprocessor(&per_cu, k_mega, 256, SMEM_BYTES);
    if (per_cu > 2) per_cu = 2;
    if (per_cu < 1) per_cu = 1;
    grid_blocks = cus * per_cu;
  }
  hipMemsetAsync((char*)d_ws + OFF_BAR, 0, XCD_BAR_WORDS * 4, stream);
  void* args[] = {&p};
  hipError_t e = hipLaunchCooperativeKernel((void*)k_mega, dim3(grid_blocks), dim3(256), args, SMEM_BYTES, stream);
  if (e != hipSuccess) fprintf(stderr, "cooperative launch failed: %s (grid %d)\n", hipGetErrorString(e), grid_blocks);
#endif
}
```

```cpp
#include <hip/hip_runtime.h>
#include <hip/hip_cooperative_groups.h>
#include <cstdio>
namespace cg = cooperative_groups;

#ifndef MULTI_LAUNCH
#define MULTI_LAUNCH 0
#endif

typedef unsigned short u16;
using bf16x8 = __attribute__((ext_vector_type(8))) short;
using s16x4  = __attribute__((ext_vector_type(4))) short;
using f32x4  = __attribute__((ext_vector_type(4))) float;
#define DI __device__ __forceinline__
#define MFMA16(a, b, c) __builtin_amdgcn_mfma_f32_16x16x32_bf16((a), (b), (c), 0, 0, 0)

constexpr int D = 1024, NB = 4, SEQ = 4096, LC = 256, NLAT = NB * SEQ, NCTX = NB * LC, NTOK = NLAT + NCTX;
constexpr int INT = 3872, INTP = 3968, FH = 2816, PNLD = 2720, VTR = 1152;
constexpr float LOG2E = 1.4426950408889634f;

constexpr size_t OFF_WIN  = 0;
constexpr size_t OFF_WMG  = OFF_WIN + (size_t)INTP * D * 2;
constexpr size_t OFF_WBR  = OFF_WMG + (size_t)3072 * D * 2;
constexpr size_t OFF_WOUT = OFF_WBR + (size_t)3 * 1024 * 512 * 2;
constexpr size_t OFF_WF1  = OFF_WOUT + (size_t)D * D * 2;
constexpr size_t OFF_WF2  = OFF_WF1 + (size_t)2 * FH * D * 2;
constexpr size_t OFF_PAD  = OFF_WF2 + (size_t)D * FH * 2;
constexpr size_t OFF_MOD  = OFF_PAD + (1u << 20);
constexpr size_t OFF_ROPE = OFF_MOD + (size_t)2 * 5 * 6144 * 4;
constexpr size_t OFF_XC   = OFF_ROPE + (size_t)SEQ * 32 * 2 * 4;
constexpr size_t OFF_HB   = OFF_XC + (size_t)NCTX * D * 4;
constexpr size_t OFF_PN   = OFF_HB + (size_t)NTOK * D * 2;
constexpr size_t OFF_VT   = OFF_PN + (size_t)NTOK * PNLD * 2;
constexpr size_t OFF_VTC  = OFF_VT + (size_t)NB * VTR * SEQ * 2;
constexpr size_t OFF_Y    = OFF_VTC + (size_t)NB * VTR * LC * 2;
constexpr size_t WS_END   = OFF_Y + (size_t)3 * NTOK * 512 * 2;
static_assert(WS_END <= ((size_t)256 << 20), "workspace too large");
constexpr size_t OFF_OB    = OFF_WF1;
static_assert(OFF_OB + (size_t)NTOK * 512 * 2 <= OFF_MOD, "o_b alias");
constexpr size_t OFF_BAR   = OFF_PAD + (768u << 10);
constexpr size_t OFF_MIXED = OFF_PN;
constexpr size_t OFF_ACT   = OFF_PN + (size_t)NTOK * D * 2;
static_assert(OFF_ACT + (size_t)NTOK * FH * 2 <= OFF_Y, "act alias");

struct Params {
  const float *x, *c, *ctx, *c_ctx, *w_ada, *b_ada, *norm_mix, *w_in, *sink, *gw_f, *gb_f, *gw_b, *gb_b, *gla_norm, *rpb,
      *w_ba, *w_bb, *w_bc, *w_merge, *b_merge, *w_out, *norm_ffn, *w_ffn_in, *w_ffn_out, *final_norm;
  float* out;
  char* ws;
};

typedef __bf16 bf2_t __attribute__((ext_vector_type(2)));
DI u16 f2bf(float x) { __bf16 v = (__bf16)x; return __builtin_bit_cast(u16, v); }
DI float bf2f(u16 h) { return __uint_as_float(((unsigned)h) << 16); }
DI unsigned pack2(float a, float b) { bf2_t v = {(__bf16)a, (__bf16)b}; return __builtin_bit_cast(unsigned, v); }
DI float wave_sum(float v) { for (int o = 32; o; o >>= 1) v += __shfl_xor(v, o, 64); return v; }
DI float sigmoidf_(float x) { return __builtin_amdgcn_rcpf(1.0f + __expf(-x)); }
DI float siluf_(float x) { return x * __builtin_amdgcn_rcpf(1.0f + __expf(-x)); }

DI const float* xsrc(const Params& p, int l, int row) {
  if (row < NLAT) return (l == 0 ? p.x : p.out) + (size_t)row * D;
  return (l == 0 ? p.ctx : (const float*)(p.ws + OFF_XC)) + (size_t)(row - NLAT) * D;
}
DI float* xdst(const Params& p, int row) {
  if (row < NLAT) return p.out + (size_t)row * D;
  return (float*)(p.ws + OFF_XC) + (size_t)(row - NLAT) * D;
}
DI const float* modp(const Params& p, int l, int row) {
  int s = row < NLAT ? (row >> 12) : 4;
  return (const float*)(p.ws + OFF_MOD) + (size_t)(l * 5 + s) * 6144;
}

constexpr int LROW = 144;
constexpr int LDS_A = 0, LDS_B = 128 * LROW;

constexpr int GROW = 128;
constexpr int G_A = 0, G_B = 128 * GROW;
constexpr int GBUF = 2 * 128 * GROW;
template <int NI, int CH>
DI void gemm_tile(const u16* __restrict__ A, int lda, const u16* __restrict__ Bt, int ldb, int K,
                  f32x4 (&acc)[4][NI], char* lds) {
  const int tid = threadIdx.x, lane = tid & 63, wave = tid >> 6;
  const int wm = wave >> 1, wn = wave & 1, g = lane >> 4, n = lane & 15;
  const int lrow = tid >> 3, lkc = tid & 7;
  const u16* ap = CH ? A + (size_t)lrow * 32 + (size_t)(lkc >> 2) * lda * 32 + (lkc & 3) * 8 : A + (size_t)lrow * lda + lkc * 8;
  const u16* bp = CH ? Bt + (size_t)lrow * 32 + (size_t)(lkc >> 2) * ldb * 32 + (lkc & 3) * 8 : Bt + (size_t)lrow * ldb + lkc * 8;
  const size_t sa = CH ? (size_t)32 * 32 : (size_t)32 * lda, sb = CH ? (size_t)32 * 32 : (size_t)32 * ldb;
  const size_t ka = CH ? (size_t)lda : 1, kb = CH ? (size_t)ldb : 1;
  const int wsw = (lkc ^ ((lrow >> 1) & 7)) * 16;
  const int rsw0 = (g ^ ((n >> 1) & 7)) * 16, rsw1 = ((4 + g) ^ ((n >> 1) & 7)) * 16;
  uint4 ra0, ra1, ra2, ra3, rb0, rb1, rb2, rb3;
#define GLOADS(kk)                                                                                                   \
  {                                                                                                                  \
    ra0 = *(const uint4*)(ap + (kk) * ka); ra1 = *(const uint4*)(ap + sa + (kk) * ka);                               \
    ra2 = *(const uint4*)(ap + 2 * sa + (kk) * ka); ra3 = *(const uint4*)(ap + 3 * sa + (kk) * ka);                  \
    rb0 = *(const uint4*)(bp + (kk) * kb); rb1 = *(const uint4*)(bp + sb + (kk) * kb);                               \
    if (NI == 4) { rb2 = *(const uint4*)(bp + 2 * sb + (kk) * kb); rb3 = *(const uint4*)(bp + 3 * sb + (kk) * kb); } \
  }
#define LSTORES(buf)                                                                                                 \
  {                                                                                                                  \
    char* wa_ = lds + (buf) * GBUF + G_A + lrow * GROW + wsw;                                                        \
    char* wb_ = lds + (buf) * GBUF + G_B + lrow * GROW + wsw;                                                        \
    *(uint4*)(wa_) = ra0; *(uint4*)(wa_ + 32 * GROW) = ra1; *(uint4*)(wa_ + 64 * GROW) = ra2; *(uint4*)(wa_ + 96 * GROW) = ra3; \
    *(uint4*)(wb_) = rb0; *(uint4*)(wb_ + 32 * GROW) = rb1;                                                          \
    if (NI == 4) { *(uint4*)(wb_ + 64 * GROW) = rb2; *(uint4*)(wb_ + 96 * GROW) = rb3; }                             \
  }
  GLOADS(0);
  __syncthreads();
  LSTORES(0);
  GLOADS(64);
  __syncthreads();
  const int nk = K >> 6;
#pragma unroll 1
  for (int it = 0; it < nk; it++) {
    const int cur = it & 1;
    if (it + 1 < nk) LSTORES(cur ^ 1);
    if (it + 2 < nk) GLOADS((it + 2) * 64);
    const char* fa = lds + cur * GBUF + G_A + (wm * 64 + n) * GROW;
    const char* fb = lds + cur * GBUF + G_B + (wn * 16 * NI + n) * GROW;
#pragma unroll
    for (int ks = 0; ks < 2; ks++) {
      const int rsw = ks ? rsw1 : rsw0;
      bf16x8 af[4], bfr[NI];
#pragma unroll
      for (int i = 0; i < 4; i++) af[i] = *(const bf16x8*)(fa + i * 16 * GROW + rsw);
#pragma unroll
      for (int i = 0; i < NI; i++) bfr[i] = *(const bf16x8*)(fb + i * 16 * GROW + rsw);
#pragma unroll
      for (int mi = 0; mi < 4; mi++)
#pragma unroll
        for (int ni = 0; ni < NI; ni++) acc[mi][ni] = MFMA16(af[mi], bfr[ni], acc[mi][ni]);
    }
    __syncthreads();
  }
#undef GLOADS
#undef LSTORES
}

template <int NI>
DI void zero_acc(f32x4 (&acc)[4][NI]) {
#pragma unroll
  for (int i = 0; i < 4; i++)
#pragma unroll
    for (int j = 0; j < NI; j++) acc[i][j] = f32x4{0.f, 0.f, 0.f, 0.f};
}

constexpr int LROW2 = 64;
constexpr int W_A = 0, W_B = 128 * LROW2, WBUF = 384 * LROW2;
DI void gemm_wide(const u16* __restrict__ A, int lda, const u16* __restrict__ Bt, int ldb, int K, f32x4 (&acc)[4][8], char* lds) {
  const int tid = threadIdx.x, lane = tid & 63, wave = tid >> 6;
  const int wm = wave >> 1, wn = wave & 1, g = lane >> 4, n = lane & 15;
  const int lrow = tid >> 2, lkc = tid & 3;
  const u16* ap = A + (size_t)lrow * 32 + lkc * 8;
  const u16* bp = Bt + (size_t)lrow * 32 + lkc * 8;
  const size_t sa = (size_t)64 * 32, sb = (size_t)64 * 32;
  const size_t ka = (size_t)lda, kb = (size_t)ldb;
  uint4 ra0, ra1, rb0, rb1, rb2, rb3;
  const int wsw = (lkc ^ ((0 - (lrow >> 2)) & 3)) * 16;
  const int rsw = (g ^ ((0 - (n >> 2)) & 3)) * 16;
#define GLOADS(kk)                                                                           \
  {                                                                                          \
    ra0 = *(const uint4*)(ap + (kk) * ka); ra1 = *(const uint4*)(ap + sa + (kk) * ka);       \
    rb0 = *(const uint4*)(bp + (kk) * kb); rb1 = *(const uint4*)(bp + sb + (kk) * kb);       \
    rb2 = *(const uint4*)(bp + 2 * sb + (kk) * kb); rb3 = *(const uint4*)(bp + 3 * sb + (kk) * kb); \
  }
#define LSTORES(buf)                                                                         \
  {                                                                                          \
    char* wa_ = lds + (buf) * WBUF + W_A + lrow * LROW2 + wsw;                               \
    char* wb_ = lds + (buf) * WBUF + W_B + lrow * LROW2 + wsw;                               \
    *(uint4*)(wa_) = ra0; *(uint4*)(wa_ + 64 * LROW2) = ra1;                                 \
    *(uint4*)(wb_) = rb0; *(uint4*)(wb_ + 64 * LROW2) = rb1;                                 \
    *(uint4*)(wb_ + 128 * LROW2) = rb2; *(uint4*)(wb_ + 192 * LROW2) = rb3;                  \
  }
#define HALF(h)                                                                              \
  {                                                                                          \
    bf16x8 bfr[4];                                                                           \
    _Pragma("unroll") for (int i = 0; i < 4; i++) bfr[i] = *(const bf16x8*)(fb + ((h) * 4 + i) * 16 * LROW2); \
    _Pragma("unroll") for (int mi = 0; mi < 4; mi++)                                         \
      _Pragma("unroll") for (int ni = 0; ni < 4; ni++) acc[mi][(h) * 4 + ni] = MFMA16(af[mi], bfr[ni], acc[mi][(h) * 4 + ni]); \
  }
  GLOADS(0);
  __syncthreads();
  LSTORES(0);
  GLOADS(32);
  __syncthreads();
  const int nk = K >> 5;
#pragma unroll 1
  for (int it = 0; it < nk; it++) {
    const int cur = it & 1;
    const char* fa = lds + cur * WBUF + W_A + (wm * 64 + n) * LROW2 + rsw;
    const char* fb = lds + cur * WBUF + W_B + (wn * 128 + n) * LROW2 + rsw;
    bf16x8 af[4];
#pragma unroll
    for (int i = 0; i < 4; i++) af[i] = *(const bf16x8*)(fa + i * 16 * LROW2);
    HALF(0);
    if (it + 1 < nk) LSTORES(cur ^ 1);
    if (it + 2 < nk) GLOADS((it + 2) * 32);
    HALF(1);
    __syncthreads();
  }
#undef GLOADS
#undef LSTORES
#undef HALF
}

DI void task_mod(const Params& p, int task, char* lds) {
  const int tid = threadIdx.x, lane = tid & 63, wave = tid >> 6;
  const int l = task / 96, cb = task % 96;
  float* sc = (float*)lds;
  float* red = sc + 5 * 1024;
  __syncthreads();
  for (int i = tid; i < 5 * 1024; i += 256) {
    int s = i >> 10, k = i & 1023;
    float v = s < 4 ? p.c[s * 1024 + k] : p.c_ctx[k];
    sc[i] = siluf_(v);
  }
  __syncthreads();
  const int ncol = cb * 64 + lane;
  const float* w = p.w_ada + (size_t)l * 1024 * 6144 + ncol;
  float a0 = 0, a1 = 0, a2 = 0, a3 = 0, a4 = 0;
#pragma unroll 16
  for (int k = wave * 256; k < wave * 256 + 256; k++) {
    float wv = w[(size_t)k * 6144];
    a0 += sc[k] * wv; a1 += sc[1024 + k] * wv; a2 += sc[2048 + k] * wv; a3 += sc[3072 + k] * wv; a4 += sc[4096 + k] * wv;
  }
  red[(wave * 5 + 0) * 64 + lane] = a0; red[(wave * 5 + 1) * 64 + lane] = a1; red[(wave * 5 + 2) * 64 + lane] = a2;
  red[(wave * 5 + 3) * 64 + lane] = a3; red[(wave * 5 + 4) * 64 + lane] = a4;
  __syncthreads();
  float* mod = (float*)(p.ws + OFF_MOD);
  for (int i = tid; i < 320; i += 256) {
    int s = i >> 6, ln = i & 63;
    float v = red[(0 * 5 + s) * 64 + ln] + red[(1 * 5 + s) * 64 + ln] + red[(2 * 5 + s) * 64 + ln] + red[(3 * 5 + s) * 64 + ln];
    int nc = cb * 64 + ln;
    mod[(size_t)(l * 5 + s) * 6144 + nc] = v + p.b_ada[l * 6144 + nc];
  }
}

DI void task_rope(const Params& p, int task) {
  int e = task * 256 + threadIdx.x;
  int t = e >> 5, i = e & 31;
  float pos = (i < 16) ? (float)(t >> 6) : (float)(t & 63);
  float inv = exp2f(-(float)(i & 15) * (13.287712379549449f / 16.0f));
  float ang = pos * inv;
  float kq = rintf(ang * 0.15915494309189535f);
  float rr = fmaf(-kq, 6.28125f, ang);
  rr = fmaf(-kq, 0.0019353071795864769f, rr);
  float s = sinf(rr), c = cosf(rr);
  float* rc = (float*)(p.ws + OFF_ROPE);
  rc[e] = c; rc[SEQ * 32 + e] = s;
}

DI void conv_tile(const float* __restrict__ src, int K, int N, int kt, int nt, u16* __restrict__ dst, int mode, int R, char* lds) {
  float* tile = (float*)lds;
  const int tid = threadIdx.x;
  const int k0 = kt * 128, n0 = nt * 64;
  __syncthreads();
  {
    float4 v[8];
#pragma unroll
    for (int i = 0; i < 8; i++) {
      int idx = tid + 256 * i, kk = idx >> 4, n4 = (idx & 15) * 4;
      v[i] = float4{0.f, 0.f, 0.f, 0.f};
      if (n0 + n4 < N) v[i] = *(const float4*)(src + (size_t)(k0 + kk) * N + n0 + n4);
    }
#pragma unroll
    for (int i = 0; i < 8; i++) {
      int idx = tid + 256 * i, kk = idx >> 4, n4 = (idx & 15) * 4;
      float* t = tile + kk * 65 + n4;
      t[0] = v[i].x; t[1] = v[i].y; t[2] = v[i].z; t[3] = v[i].w;
    }
  }
  __syncthreads();
#pragma unroll
  for (int i = 0; i < 4; i++) {
    int cidx = tid + 256 * i, nn = cidx >> 4, kc = cidx & 15;
    int ncol = n0 + nn;
    if (ncol < N) {
      int drow = ncol;
      if (mode == 1) {
        int up = ncol >= FH, j = up ? ncol - FH : ncol;
        drow = (j >> 7) * 256 + ((j >> 6) & 1) * 128 + up * 64 + (j & 63);
      }
      uint4 o;
      o.x = pack2(tile[(kc * 8 + 0) * 65 + nn], tile[(kc * 8 + 1) * 65 + nn]);
      o.y = pack2(tile[(kc * 8 + 2) * 65 + nn], tile[(kc * 8 + 3) * 65 + nn]);
      o.z = pack2(tile[(kc * 8 + 4) * 65 + nn], tile[(kc * 8 + 5) * 65 + nn]);
      o.w = pack2(tile[(kc * 8 + 6) * 65 + nn], tile[(kc * 8 + 7) * 65 + nn]);
      const int kd = k0 + kc * 8;
      if (R > 0) *(uint4*)(dst + ((size_t)(kd >> 5) * R + drow) * 32 + (kd & 31)) = o;
      else *(uint4*)(dst + (size_t)drow * K + kd) = o;
    }
  }
}

constexpr int CONV1_TASKS = 488 + 384 + 192 + 128 + 1;
constexpr int CONV2_TASKS = 704 + 352;
DI void task_conv1(const Params& p, int l, int t, char* lds) {
  if (t < 488) { conv_tile(p.w_in + (size_t)l * D * INT, D, INT, t / 61, t % 61, (u16*)(p.ws + OFF_WIN), 0, INTP, lds); return; }
  t -= 488;
  if (t < 384) { conv_tile(p.w_merge + (size_t)l * D * 3072, D, 3072, t / 48, t % 48, (u16*)(p.ws + OFF_WMG), 0, 3072, lds); return; }
  t -= 384;
  if (t < 192) {
    int br = t / 64, tt = t % 64;
    const float* src = (br == 0 ? p.w_ba : br == 1 ? p.w_bb : p.w_bc) + (size_t)l * 512 * D;
    conv_tile(src, 512, D, tt / 16, tt % 16, (u16*)(p.ws + OFF_WBR) + (size_t)br * 1024 * 512, 0, 0, lds);
    return;
  }
  t -= 192;
  if (t < 128) { conv_tile(p.w_out + (size_t)l * D * D, D, D, t / 16, t % 16, (u16*)(p.ws + OFF_WOUT), 0, D, lds); return; }
  uint4 z = {0, 0, 0, 0};
  for (int i = threadIdx.x; i < 32 * (INTP - INT) * 4; i += 256) {
    const int ch = i / ((INTP - INT) * 4), off = i % ((INTP - INT) * 4);
    *(uint4*)((u16*)(p.ws + OFF_WIN) + ((size_t)ch * INTP + INT) * 32 + off * 8) = z;
  }
}
DI void task_conv2(const Params& p, int l, int t, char* lds) {
  if (t < 704) { conv_tile(p.w_ffn_in + (size_t)l * D * 2 * FH, D, 2 * FH, t / 88, t % 88, (u16*)(p.ws + OFF_WF1), 1, 2 * FH, lds); return; }
  t -= 704;
  conv_tile(p.w_ffn_out + (size_t)l * FH * D, FH, D, t / 16, t % 16, (u16*)(p.ws + OFF_WF2), 0, D, lds);
}

DI void task_norm(const Params& p, int l, int task, int which) {
  const int lane = threadIdx.x & 63, wave = threadIdx.x >> 6;
  const int row0 = task * 16 + wave * 4;
  const float* g = (which == 0 ? p.norm_mix : p.norm_ffn) + l * D;
  const float* md = modp(p, l, row0) + (which ? 3 * D : 0);
  float4 v[4][4];
#pragma unroll
  for (int r = 0; r < 4; r++) {
    const float* xr = which == 0 ? xsrc(p, l, row0 + r) : (const float*)xdst(p, row0 + r);
#pragma unroll
    for (int i = 0; i < 4; i++) v[r][i] = *(const float4*)(xr + i * 256 + lane * 4);
  }
  float rstd[4];
#pragma unroll
  for (int r = 0; r < 4; r++) {
    float ss = 0.f;
#pragma unroll
    for (int i = 0; i < 4; i++) ss += v[r][i].x * v[r][i].x + v[r][i].y * v[r][i].y + v[r][i].z * v[r][i].z + v[r][i].w * v[r][i].w;
    ss = wave_sum(ss);
    rstd[r] = rsqrtf(ss * (1.0f / 1024.0f) + 1e-6f);
  }
  u16* hb = (u16*)(p.ws + OFF_HB) + (size_t)row0 * 32;
#pragma unroll
  for (int i = 0; i < 4; i++) {
    const int cidx = i * 256 + lane * 4;
    const float4 gg = *(const float4*)(g + cidx), sh = *(const float4*)(md + cidx), sc = *(const float4*)(md + D + cidx);
    const float a0 = gg.x * (1.f + sc.x), a1 = gg.y * (1.f + sc.y), a2 = gg.z * (1.f + sc.z), a3 = gg.w * (1.f + sc.w);
#pragma unroll
    for (int r = 0; r < 4; r++) {
      uint2 o;
      o.x = pack2(v[r][i].x * rstd[r] * a0 + sh.x, v[r][i].y * rstd[r] * a1 + sh.y);
      o.y = pack2(v[r][i].z * rstd[r] * a2 + sh.z, v[r][i].w * rstd[r] * a3 + sh.w);
      *(uint2*)(hb + (size_t)(cidx >> 5) * NTOK * 32 + r * 32 + (cidx & 31)) = o;
    }
  }
}
DI void task_final_norm(const Params& p, int task) {
  const int lane = threadIdx.x & 63, wave = threadIdx.x >> 6;
  float* xr = p.out + (size_t)(task * 16 + wave * 4) * D;
  float4 v[4][4];
#pragma unroll
  for (int r = 0; r < 4; r++)
#pragma unroll
    for (int i = 0; i < 4; i++) v[r][i] = *(const float4*)(xr + (size_t)r * D + i * 256 + lane * 4);
  float rstd[4];
#pragma unroll
  for (int r = 0; r < 4; r++) {
    float ss = 0.f;
#pragma unroll
    for (int i = 0; i < 4; i++) ss += v[r][i].x * v[r][i].x + v[r][i].y * v[r][i].y + v[r][i].z * v[r][i].z + v[r][i].w * v[r][i].w;
    ss = wave_sum(ss);
    rstd[r] = rsqrtf(ss * (1.0f / 1024.0f) + 1e-6f);
  }
#pragma unroll
  for (int i = 0; i < 4; i++) {
    const int cidx = i * 256 + lane * 4;
    const float4 gg = *(const float4*)(p.final_norm + cidx);
#pragma unroll
    for (int r = 0; r < 4; r++) {
      float4 o = {v[r][i].x * rstd[r] * gg.x, v[r][i].y * rstd[r] * gg.y, v[r][i].z * rstd[r] * gg.z, v[r][i].w * rstd[r] * gg.w};
      *(float4*)(xr + (size_t)r * D + cidx) = o;
    }
  }
}

DI void task_g1(const Params& p, int l, int tile, char* lds) {
  const int mt = tile / 15, nt = tile % 15;
  const int tid = threadIdx.x, lane = tid & 63, wave = tid >> 6;
  const int wm = wave >> 1, wn = wave & 1, g = lane >> 4, n = lane & 15;
  f32x4 acc[4][8];
#pragma unroll
  for (int i = 0; i < 4; i++)
#pragma unroll
    for (int j = 0; j < 8; j++) acc[i][j] = f32x4{0.f, 0.f, 0.f, 0.f};
  gemm_wide((const u16*)(p.ws + OFF_HB) + (size_t)mt * 128 * 32, NTOK, (const u16*)(p.ws + OFF_WIN) + (size_t)nt * 256 * 32, INTP, D, acc, lds);
  const int cw = nt * 256 + wn * 128;
  const int rw = mt * 128 + wm * 64;
  if (mt < 128) {
    const float* rc = (const float*)(p.ws + OFF_ROPE);
    const float* rs = rc + SEQ * 32;
#pragma unroll
    for (int hh = 0; hh < 2; hh++) {
      if (cw + hh * 64 >= 640) continue;
#pragma unroll
      for (int mi = 0; mi < 4; mi++)
#pragma unroll
        for (int ni = 0; ni < 2; ni++)
#pragma unroll
          for (int r = 0; r < 4; r++) {
            int t = (rw + mi * 16 + 4 * g + r) & 4095;
            float c = rc[t * 32 + ni * 16 + n], sn = rs[t * 32 + ni * 16 + n];
            float x1 = acc[mi][hh * 4 + ni][r], x2 = acc[mi][hh * 4 + ni + 2][r];
            acc[mi][hh * 4 + ni][r] = x1 * c - x2 * sn;
            acc[mi][hh * 4 + ni + 2][r] = x1 * sn + x2 * c;
          }
    }
  }
  u16* PN = (u16*)(p.ws + OFF_PN);
  u16* VT = (u16*)(p.ws + OFF_VT);
  u16* VTc = (u16*)(p.ws + OFF_VTC);
#pragma unroll
  for (int ni = 0; ni < 8; ni++) {
    const int c16 = cw + ni * 16;
    if (c16 >= INT) continue;
    int tr = -1, nat = 0;
    if (c16 < 640) nat = c16;
    else if (c16 < 768) tr = c16 - 640;
    else if (c16 < 1280) nat = c16 - 128;
    else if (c16 < 1792) tr = 128 + c16 - 1280;
    else if (c16 < 3360) nat = c16 - 640;
    else tr = 640 + c16 - 3360;
#pragma unroll
    for (int mi = 0; mi < 4; mi++) {
      const int row0 = rw + mi * 16 + 4 * g;
      if (tr < 0) {
#pragma unroll
        for (int r = 0; r < 4; r++) PN[(size_t)(row0 + r) * PNLD + nat + n] = f2bf(acc[mi][ni][r]);
      } else {
        uint2 o; o.x = pack2(acc[mi][ni][0], acc[mi][ni][1]); o.y = pack2(acc[mi][ni][2], acc[mi][ni][3]);
        if (mt < 128) {
          int b = row0 >> 12, tok = row0 & 4095;
          *(uint2*)(VT + ((size_t)(b * VTR + tr + n)) * SEQ + tok) = o;
        } else {
          int rr = row0 - NLAT, b = rr >> 8, tok = rr & 255;
          *(uint2*)(VTc + ((size_t)(b * VTR + tr + n)) * LC + tok) = o;
        }
      }
    }
  }
}

DI void task_g1_tail(const Params& p, int l, int mt, char* lds) {
  const int tid = threadIdx.x, lane = tid & 63, wave = tid >> 6;
  const int wm = wave >> 1, wn = wave & 1, g = lane >> 4, n = lane & 15;
  f32x4 acc[4][2];
  zero_acc<2>(acc);
  gemm_tile<2, 1>((const u16*)(p.ws + OFF_HB) + (size_t)mt * 128 * 32, NTOK, (const u16*)(p.ws + OFF_WIN) + (size_t)3840 * 32, INTP, D, acc, lds);
  if (wn != 0) return;
  u16* VT = (u16*)(p.ws + OFF_VT);
  u16* VTc = (u16*)(p.ws + OFF_VTC);
#pragma unroll
  for (int ni = 0; ni < 2; ni++) {
    const int tr = 640 + (3840 - 3360) + ni * 16;
#pragma unroll
    for (int mi = 0; mi < 4; mi++) {
      const int row0 = mt * 128 + wm * 64 + mi * 16 + 4 * g;
      uint2 o; o.x = pack2(acc[mi][ni][0], acc[mi][ni][1]); o.y = pack2(acc[mi][ni][2], acc[mi][ni][3]);
      if (mt < 128) {
        int b = row0 >> 12, tok = row0 & 4095;
        *(uint2*)(VT + ((size_t)(b * VTR + tr + n)) * SEQ + tok) = o;
      } else {
        int rr = row0 - NLAT, b = rr >> 8, tok = rr & 255;
        *(uint2*)(VTc + ((size_t)(b * VTR + tr + n)) * LC + tok) = o;
      }
    }
  }
}

constexpr float QSC = 0.125f * LOG2E;

template <class QF, class OF, class M0F, class TileFn, class ScoreFn, class SkipFn>
DI void attn_core4(QF qptr, OF optr, M0F m0f, float l0, int ntiles, TileFn tilefn, ScoreFn scorefn, SkipFn skipfn) {
  const int lane = threadIdx.x & 63, g = lane >> 4, n = lane & 15;
  bf16x8 qf[4][2];
  f32x4 o[4][4];
  float m[4], ls[4];
#pragma unroll
  for (int gi = 0; gi < 4; gi++) {
    const u16* q = qptr(gi);
    qf[gi][0] = *(const bf16x8*)(q + (size_t)n * PNLD + g * 8);
    qf[gi][1] = *(const bf16x8*)(q + (size_t)n * PNLD + 32 + g * 8);
#pragma unroll
    for (int i = 0; i < 4; i++) o[gi][i] = f32x4{0.f, 0.f, 0.f, 0.f};
    m[gi] = m0f(gi);
    ls[gi] = (g == 0) ? l0 : 0.f;
  }
  const u16* kp; const u16* vp; int vld, aux;
  tilefn(0, kp, vp, vld, aux);
  bf16x8 kn0, kn1, kn2, kn3;
  s16x4 vn0, vn1, vn2, vn3, vn4, vn5, vn6, vn7;
#define LOADK()                                                                     \
  {                                                                                 \
    const u16* kr = kp + (size_t)n * PNLD + g * 8;                                  \
    kn0 = *(const bf16x8*)(kr); kn1 = *(const bf16x8*)(kr + (size_t)16 * PNLD);     \
    kn2 = *(const bf16x8*)(kr + 32); kn3 = *(const bf16x8*)(kr + (size_t)16 * PNLD + 32); \
  }
#define LOADV()                                                                     \
  {                                                                                 \
    const u16* vr = vp + (size_t)n * vld + 4 * g;                                   \
    vn0 = *(const s16x4*)(vr); vn1 = *(const s16x4*)(vr + 16);                      \
    vn2 = *(const s16x4*)(vr + (size_t)16 * vld); vn3 = *(const s16x4*)(vr + (size_t)16 * vld + 16); \
    vn4 = *(const s16x4*)(vr + (size_t)32 * vld); vn5 = *(const s16x4*)(vr + (size_t)32 * vld + 16); \
    vn6 = *(const s16x4*)(vr + (size_t)48 * vld); vn7 = *(const s16x4*)(vr + (size_t)48 * vld + 16); \
  }
  LOADK();
  LOADV();
#pragma unroll 1
  for (int t = 0; t < ntiles; t++) {
    const int auxc = aux;
    const bool more = t + 1 < ntiles;
    bf16x8 vf[4];
    vf[0] = __builtin_shufflevector(vn0, vn1, 0, 1, 2, 3, 4, 5, 6, 7);
    vf[1] = __builtin_shufflevector(vn2, vn3, 0, 1, 2, 3, 4, 5, 6, 7);
    vf[2] = __builtin_shufflevector(vn4, vn5, 0, 1, 2, 3, 4, 5, 6, 7);
    vf[3] = __builtin_shufflevector(vn6, vn7, 0, 1, 2, 3, 4, 5, 6, 7);
#pragma unroll
    for (int hf = 0; hf < 2; hf++) {
      f32x4 s0[2], s1[2];
#pragma unroll
      for (int gg = 0; gg < 2; gg++) {
        const int gi = hf * 2 + gg;
        s0[gg] = f32x4{0.f, 0.f, 0.f, 0.f}; s1[gg] = f32x4{0.f, 0.f, 0.f, 0.f};
        if (skipfn(gi, auxc)) continue;
        s0[gg] = MFMA16(kn0, qf[gi][0], s0[gg]); s1[gg] = MFMA16(kn1, qf[gi][0], s1[gg]);
        s0[gg] = MFMA16(kn2, qf[gi][1], s0[gg]); s1[gg] = MFMA16(kn3, qf[gi][1], s1[gg]);
      }
      if (hf == 1 && more) { tilefn(t + 1, kp, vp, vld, aux); LOADK(); }
#pragma unroll
      for (int gg = 0; gg < 2; gg++) {
        const int gi = hf * 2 + gg;
        if (skipfn(gi, auxc)) continue;
        float sc[8];
#pragma unroll
        for (int r = 0; r < 4; r++) {
          sc[r] = scorefn(gi, auxc, 4 * g + r, n, s0[gg][r]);
          sc[4 + r] = scorefn(gi, auxc, 16 + 4 * g + r, n, s1[gg][r]);
        }
        float mx = fmaxf(fmaxf(fmaxf(sc[0], sc[1]), fmaxf(sc[2], sc[3])), fmaxf(fmaxf(sc[4], sc[5]), fmaxf(sc[6], sc[7])));
        mx = fmaxf(mx, __shfl_xor(mx, 16, 64));
        mx = fmaxf(mx, __shfl_xor(mx, 32, 64));
        const float mn = fmaxf(m[gi], mx);
        const float alpha = __builtin_amdgcn_exp2f(m[gi] - mn);
        float pv[8], ps = 0.f;
#pragma unroll
        for (int r = 0; r < 8; r++) { pv[r] = __builtin_amdgcn_exp2f(sc[r] - mn); ps += pv[r]; }
        ls[gi] = ls[gi] * alpha + ps;
        m[gi] = mn;
        union { bf16x8 v; unsigned u[4]; } pf;
        pf.u[0] = pack2(pv[0], pv[1]); pf.u[1] = pack2(pv[2], pv[3]); pf.u[2] = pack2(pv[4], pv[5]); pf.u[3] = pack2(pv[6], pv[7]);
#pragma unroll
        for (int d4 = 0; d4 < 4; d4++) {
          o[gi][d4] *= alpha;
          o[gi][d4] = MFMA16(vf[d4], pf.v, o[gi][d4]);
        }
      }
    }
    if (more) LOADV();
  }
#undef LOADK
#undef LOADV
#pragma unroll
  for (int gi = 0; gi < 4; gi++) {
    float lsum = ls[gi];
    lsum += __shfl_xor(lsum, 16, 64);
    lsum += __shfl_xor(lsum, 32, 64);
    const float inv = 1.0f / lsum;
    u16* ob = optr(gi);
#pragma unroll
    for (int d4 = 0; d4 < 4; d4++) {
      uint2 w; w.x = pack2(o[gi][d4][0] * inv, o[gi][d4][1] * inv); w.y = pack2(o[gi][d4][2] * inv, o[gi][d4][3] * inv);
      *(uint2*)(ob + (size_t)n * 512 + d4 * 16 + 4 * g) = w;
    }
  }
}

DI void attn_a_latent(const Params& p, int l, int wt) {
  wt = __builtin_amdgcn_readfirstlane(wt);
  const int kvh = wt & 1, qt = (wt >> 1) & 255, b = wt >> 9, q0 = qt * 16;
  const u16* PN = (const u16*)(p.ws + OFF_PN);
  const u16* VT = (const u16*)(p.ws + OFF_VT);
  const u16* VTc = (const u16*)(p.ws + OFF_VTC);
  int jlo = (q0 - 128) & ~31; if (jlo < 0) jlo = 0;
  int jhi = (q0 + 144 + 31) & ~31; if (jhi > SEQ) jhi = SEQ;
  const int ntiles = 8 + (jhi - jlo) / 32;
  const u16* kc = PN + (size_t)(NLAT + b * LC) * PNLD + 512 + kvh * 64;
  const u16* kl = PN + (size_t)(b * SEQ) * PNLD + 512 + kvh * 64;
  const u16* vc = VTc + (size_t)(b * VTR + kvh * 64) * LC;
  const u16* vl = VT + (size_t)(b * VTR + kvh * 64) * SEQ;
  const u16* qb = PN + (size_t)(b * SEQ + q0) * PNLD + kvh * 256;
  u16* ob = (u16*)(p.ws + OFF_Y) + (size_t)(b * SEQ + q0) * 512 + kvh * 256;
  const float* sk = p.sink + l * 8 + kvh * 4;
  auto tilefn = [&](int t, const u16*& kp, const u16*& vp, int& vld, int& aux) {
    if (t < 8) { kp = kc + (size_t)(t * 32) * PNLD; vp = vc + t * 32; vld = LC; aux = -1; }
    else { int j0 = jlo + (t - 8) * 32; kp = kl + (size_t)j0 * PNLD; vp = vl + j0; vld = SEQ; aux = j0; }
  };
  auto scorefn = [&](int gi, int aux, int kidx, int n, float dot) -> float {
    float s = dot * QSC;
    if (aux >= 0) { int dj = aux + kidx - (q0 + n); if (dj > 128 || dj < -128) s = -INFINITY; }
    return s;
  };
  attn_core4([&](int gi) { return qb + gi * 64; }, [&](int gi) { return ob + gi * 64; }, [&](int gi) { return sk[gi] * LOG2E; }, 1.0f,
             ntiles, tilefn, scorefn, [&](int gi, int aux) { return false; });
}

DI void attn_c_latent(const Params& p, int l, int wt, char* lds) {
  wt = __builtin_amdgcn_readfirstlane(wt);
  const int head = wt & 7, r = (wt >> 3) & 63, b = wt >> 9;
  const u16* PN = (const u16*)(p.ws + OFF_PN);
  const u16* VT = (const u16*)(p.ws + OFF_VT);
  const u16* VTc = (const u16*)(p.ws + OFF_VTC);
  int rs = r - 4; rs = rs < 0 ? 0 : (rs > 56 ? 56 : rs);
  const int tok0 = b * SEQ + r * 64;
  const u16* kc = PN + (size_t)(NLAT + b * LC) * PNLD + 2208 + head * 64;
  const u16* kl = PN + (size_t)(b * SEQ) * PNLD + 2208 + head * 64;
  const u16* vc = VTc + (size_t)(b * VTR + 640 + head * 64) * LC;
  const u16* vl = VT + (size_t)(b * VTR + 640 + head * 64) * SEQ;
  float* rpb = (float*)(lds + (threadIdx.x >> 6) * 2048);
  {
    const float* src = p.rpb + (size_t)(l * 8 + head) * 15 * 31;
    const int lane_ = threadIdx.x & 63;
    for (int i = lane_; i < 465; i += 64) rpb[i] = src[i] * LOG2E;
  }
  const u16* qb = PN + (size_t)tok0 * PNLD + 1696 + head * 64;
  u16* ob = (u16*)(p.ws + OFF_Y) + (size_t)2 * NTOK * 512 + (size_t)tok0 * 512 + head * 64;
  auto tilefn = [&](int t, const u16*& kp, const u16*& vp, int& vld, int& aux) {
    if (t < 8) { kp = kc + (size_t)(t * 32) * PNLD; vp = vc + t * 32; vld = LC; aux = -1; }
    else { int a = t - 8; int tk = (rs + (a >> 1)) * 64 + (a & 1) * 32; kp = kl + (size_t)tk * PNLD; vp = vl + tk; vld = SEQ; aux = a; }
  };
  auto scorefn = [&](int gi, int aux, int kidx, int n, float dot) -> float {
    float s = dot * QSC;
    if (aux >= 0) {
      int kcol = (aux & 1) * 32 + kidx, qcol = gi * 16 + n;
      int wsx = qcol - 8; wsx = wsx < 0 ? 0 : (wsx > 48 ? 48 : wsx);
      int drow = rs + (aux >> 1) - r + 7;
      int dc = kcol - qcol; dc = dc < -15 ? -15 : (dc > 15 ? 15 : dc);
      float bias = rpb[drow * 31 + dc + 15];
      s = (kcol >= wsx && kcol < wsx + 16) ? s + bias : -INFINITY;
    }
    return s;
  };
  attn_core4([&](int gi) { return qb + (size_t)gi * 16 * PNLD; }, [&](int gi) { return ob + (size_t)gi * 16 * 512; },
             [&](int gi) { return -INFINITY; }, 0.0f, 24, tilefn, scorefn,
             [&](int gi, int aux) { return aux >= 0 && ((gi == 0 && (aux & 1)) || (gi == 3 && !(aux & 1))); });
}

DI void attn_ctx(const Params& p, int l, int wt, int which) {
  wt = __builtin_amdgcn_readfirstlane(wt);
  const u16* PN = (const u16*)(p.ws + OFF_PN);
  const u16* VTc = (const u16*)(p.ws + OFF_VTC);
  if (which == 0) {
    const int kvh = wt & 1, qt = (wt >> 1) & 15, b = wt >> 5;
    const int row0 = NLAT + b * LC + qt * 16;
    const u16* kc = PN + (size_t)(NLAT + b * LC) * PNLD + 512 + kvh * 64;
    const u16* vc = VTc + (size_t)(b * VTR + kvh * 64) * LC;
    const u16* qb = PN + (size_t)row0 * PNLD + kvh * 256;
    u16* ob = (u16*)(p.ws + OFF_Y) + (size_t)row0 * 512 + kvh * 256;
    const float* sk = p.sink + l * 8 + kvh * 4;
    attn_core4([&](int gi) { return qb + gi * 64; }, [&](int gi) { return ob + gi * 64; }, [&](int gi) { return sk[gi] * LOG2E; }, 1.0f, 8,
               [&](int t, const u16*& kp, const u16*& vp, int& vld, int& aux) { kp = kc + (size_t)(t * 32) * PNLD; vp = vc + t * 32; vld = LC; aux = -1; },
               [&](int gi, int aux, int kidx, int n, float dot) -> float { return dot * QSC; }, [&](int gi, int aux) { return false; });
  } else {
    const int head = wt & 7, q4 = (wt >> 3) & 3, b = wt >> 5;
    const int row0 = NLAT + b * LC + q4 * 64;
    const u16* kc = PN + (size_t)(NLAT + b * LC) * PNLD + 2208 + head * 64;
    const u16* vc = VTc + (size_t)(b * VTR + 640 + head * 64) * LC;
    const u16* qb = PN + (size_t)row0 * PNLD + 1696 + head * 64;
    u16* ob = (u16*)(p.ws + OFF_Y) + (size_t)2 * NTOK * 512 + (size_t)row0 * 512 + head * 64;
    attn_core4([&](int gi) { return qb + (size_t)gi * 16 * PNLD; }, [&](int gi) { return ob + (size_t)gi * 16 * 512; },
               [&](int gi) { return -INFINITY; }, 0.0f, 8,
               [&](int t, const u16*& kp, const u16*& vp, int& vld, int& aux) { kp = kc + (size_t)(t * 32) * PNLD; vp = vc + t * 32; vld = LC; aux = -1; },
               [&](int gi, int aux, int kidx, int n, float dot) -> float { return dot * QSC; }, [&](int gi, int aux) { return false; });
  }
}

constexpr int G_QS = 0, G_KS = 9216, G_KT = 18432, G_VT = 27648, G_ZL = 36864, G_TOT = 40960, G_DEC = 41984, G_END = 42240;
constexpr int NE = 4;
constexpr size_t OFF_SL = OFF_Y + (size_t)2 * NTOK * 512 * 2;
constexpr size_t OFF_DS = OFF_PAD + (524288u);

template <int PASS>
DI void task_gla(const Params& p, int l, int id, char* lds) {
  int seg, rest;
  if (PASS == 1) { seg = id & 15; rest = id >> 4; } else { seg = 16 - (id % 17); rest = id / 17; }
  const int sl = rest & 1, dir = (rest >> 1) & 1, h = (rest >> 2) & 3, b = rest >> 4, combo = rest >> 1;
  const int tid = threadIdx.x, lane = tid & 63, wave = tid >> 6, g = lane >> 4, n = lane & 15;
  const u16* PN = (const u16*)(p.ws + OFF_PN);
  u16* odst = dir ? (u16*)(p.ws + OFF_OB) : (u16*)(p.ws + OFF_Y) + (size_t)NTOK * 512;
  float* SL = (float*)(p.ws + OFF_SL);
  float* DS = (float*)(p.ws + OFF_DS);
  const float* gwp = (dir ? p.gw_b : p.gw_f) + (size_t)l * 16 * 256 + h * 64 + lane;
  const float* gbp = (dir ? p.gb_b : p.gb_f) + l * 256 + h * 64 + lane;
  f32x4 S[4][NE];
#pragma unroll
  for (int i = 0; i < 4; i++)
#pragma unroll
    for (int j = 0; j < NE; j++) S[i][j] = f32x4{0.f, 0.f, 0.f, 0.f};
  if (PASS == 2) {
    const float* sl_src = SL + ((size_t)(rest * 17 + seg)) * (1024 * NE) + lane * 4;
#pragma unroll
    for (int dt = 0; dt < 4; dt++)
#pragma unroll
      for (int et = 0; et < NE; et++) S[dt][et] = *(const f32x4*)(sl_src + (dt * NE + et) * 256);
  }
  float* ZL = (float*)(lds + G_ZL);
  float* TOT = (float*)(lds + G_TOT);
  float* DEC = (float*)(lds + G_DEC);
  float totsum = 0.f;

  int tb = 0, rowbase = 0;
  uint4 rq0, rq1, rk0, rk1, rz, rv, rv2;
  rq0 = rq1 = rz = uint4{0, 0, 0, 0};
  auto gload = [&](int ch) {
    int vld; const u16* vsrc;
    if (ch < 4) {
      tb = dir ? 192 - 64 * ch : 64 * ch; rowbase = NLAT + b * LC; vld = LC;
      vsrc = (const u16*)(p.ws + OFF_VTC) + (size_t)(b * VTR + 128 + h * 128 + sl * 64) * LC;
    } else {
      tb = dir ? SEQ - 64 * (ch - 3) : 64 * (ch - 4); rowbase = b * SEQ; vld = SEQ;
      vsrc = (const u16*)(p.ws + OFF_VT) + (size_t)(b * VTR + 128 + h * 128 + sl * 64) * SEQ;
    }
    {
      int row = tid >> 3, kc = tid & 7;
      int tok0 = dir ? tb + 63 - row : tb + row, tok1 = dir ? tb + 31 - row : tb + 32 + row;
      const u16* s0 = PN + (size_t)(rowbase + tok0) * PNLD + h * 64 + kc * 8;
      const u16* s1 = PN + (size_t)(rowbase + tok1) * PNLD + h * 64 + kc * 8;
      if (PASS == 2) { rq0 = *(const uint4*)(s0 + 640); rq1 = *(const uint4*)(s1 + 640); }
      rk0 = *(const uint4*)(s0 + 896); rk1 = *(const uint4*)(s1 + 896);
    }
    if (tid < 128) {
      int row = tid >> 1, hc = tid & 1;
      int tok = dir ? tb + 63 - row : tb + row;
      rz = *(const uint4*)(PN + (size_t)(rowbase + tok) * PNLD + 1664 + dir * 16 + hc * 8);
    }
    rv = *(const uint4*)(vsrc + (size_t)(tid >> 3) * vld + tb + (tid & 7) * 8);
    rv2 = *(const uint4*)(vsrc + (size_t)(32 + (tid >> 3)) * vld + tb + (tid & 7) * 8);
  };
  gload(seg * 4);

  for (int ci = 0; ci < 4; ci++) {
    const int ctb = tb, crowbase = rowbase;
    float gw[16];
#pragma unroll
    for (int r = 0; r < 16; r++) gw[r] = gwp[r * 256];
    const float gbias = gbp[0];
    __syncthreads();
    {
      int row = tid >> 3, kc = tid & 7;
      if (PASS == 2) {
        *(uint4*)(lds + G_QS + row * LROW + kc * 16) = rq0;
        *(uint4*)(lds + G_QS + (row + 32) * LROW + kc * 16) = rq1;
      }
      *(uint4*)(lds + G_KS + row * LROW + kc * 16) = rk0;
      *(uint4*)(lds + G_KS + (row + 32) * LROW + kc * 16) = rk1;
    }
    if (tid < 128) {
      int row = tid >> 1, hc = tid & 1;
      float* zd = ZL + row * 16 + hc * 8;
      zd[0] = __uint_as_float(rz.x << 16); zd[1] = __uint_as_float(rz.x & 0xffff0000u);
      zd[2] = __uint_as_float(rz.y << 16); zd[3] = __uint_as_float(rz.y & 0xffff0000u);
      zd[4] = __uint_as_float(rz.z << 16); zd[5] = __uint_as_float(rz.z & 0xffff0000u);
      zd[6] = __uint_as_float(rz.w << 16); zd[7] = __uint_as_float(rz.w & 0xffff0000u);
    }
    {
      int e = tid >> 3, kc = tid & 7;
      if (dir) {
        uint4 rr;
        rr.x = (rv.w >> 16) | (rv.w << 16); rr.y = (rv.z >> 16) | (rv.z << 16);
        rr.z = (rv.y >> 16) | (rv.y << 16); rr.w = (rv.x >> 16) | (rv.x << 16);
        *(uint4*)(lds + G_VT + e * LROW + (7 - kc) * 16) = rr;
        rr.x = (rv2.w >> 16) | (rv2.w << 16); rr.y = (rv2.z >> 16) | (rv2.z << 16);
        rr.z = (rv2.y >> 16) | (rv2.y << 16); rr.w = (rv2.x >> 16) | (rv2.x << 16);
        *(uint4*)(lds + G_VT + (32 + e) * LROW + (7 - kc) * 16) = rr;
      } else {
        *(uint4*)(lds + G_VT + e * LROW + kc * 16) = rv;
        *(uint4*)(lds + G_VT + (32 + e) * LROW + kc * 16) = rv2;
      }
    }
    __syncthreads();
    float bv[16];
    {
      float run = 0.f;
#pragma unroll
      for (int tt = 0; tt < 16; tt++) {
        const float4* zr = (const float4*)(ZL + (wave * 16 + tt) * 16);
        float z = gbias;
#pragma unroll
        for (int q = 0; q < 4; q++) {
          float4 zz = zr[q];
          z += zz.x * gw[q * 4 + 0] + zz.y * gw[q * 4 + 1] + zz.z * gw[q * 4 + 2] + zz.w * gw[q * 4 + 3];
        }
        float lsg = fminf(z, 0.f) - __logf(1.0f + __expf(-fabsf(z)));
        run += lsg * (1.0f / 16.0f);
        bv[tt] = run;
      }
      TOT[wave * 64 + lane] = run;
    }
    __syncthreads();
    {
      float off = 0.f, tot = 0.f;
#pragma unroll
      for (int s = 0; s < 4; s++) { float tv = TOT[s * 64 + lane]; if (s < wave) off += tv; tot += tv; }
      totsum += tot;
      const float dtot = __expf(tot);
      if (wave == 0) DEC[lane] = dtot;
      unsigned ktp[8];
#pragma unroll
      for (int tt = 0; tt < 16; tt++) {
        const int t = wave * 16 + tt;
        const float bq = bv[tt] + off;
        u16* ka = (u16*)(lds + G_KS + t * LROW) + lane;
        const float kv = bf2f(*ka);
        const float e1 = __expf(bq), e2 = __builtin_amdgcn_rcpf(e1);
        if (PASS == 2) {
          u16* qa = (u16*)(lds + G_QS + t * LROW) + lane;
          const float qv = bf2f(*qa);
          *qa = f2bf(qv * 0.125f * e1);
          *ka = f2bf(kv * e2);
        }
        const unsigned kt = f2bf(kv * (dtot * e2));
        if (tt & 1) ktp[tt >> 1] |= kt << 16; else ktp[tt >> 1] = kt;
      }
      uint4* kd = (uint4*)(lds + G_KT + lane * LROW + wave * 32);
      kd[0] = uint4{ktp[0], ktp[1], ktp[2], ktp[3]};
      kd[1] = uint4{ktp[4], ktp[5], ktp[6], ktp[7]};
    }
    __syncthreads();
    if (ci < 3) gload(seg * 4 + ci + 1);
    if (PASS == 2) {
      bf16x8 qf[2];
      qf[0] = *(const bf16x8*)(lds + G_QS + (wave * 16 + n) * LROW + g * 16);
      qf[1] = *(const bf16x8*)(lds + G_QS + (wave * 16 + n) * LROW + 64 + g * 16);
      f32x4 X[4];
#pragma unroll
      for (int jt = 0; jt < 4; jt++) {
        X[jt] = f32x4{0.f, 0.f, 0.f, 0.f};
#pragma unroll
        for (int s = 0; s < 2; s++) {
          bf16x8 kf = *(const bf16x8*)(lds + G_KS + (jt * 16 + n) * LROW + s * 64 + g * 16);
          X[jt] = MFMA16(kf, qf[s], X[jt]);
        }
#pragma unroll
        for (int r = 0; r < 4; r++) if (jt * 16 + 4 * g + r > wave * 16 + n) X[jt][r] = 0.f;
      }
      f32x4 o[NE];
#pragma unroll
      for (int et = 0; et < NE; et++) o[et] = f32x4{0.f, 0.f, 0.f, 0.f};
#pragma unroll
      for (int kk = 0; kk < 2; kk++) {
        union { bf16x8 v; unsigned u[4]; } pa;
        pa.u[0] = pack2(X[2 * kk][0], X[2 * kk][1]); pa.u[1] = pack2(X[2 * kk][2], X[2 * kk][3]);
        pa.u[2] = pack2(X[2 * kk + 1][0], X[2 * kk + 1][1]); pa.u[3] = pack2(X[2 * kk + 1][2], X[2 * kk + 1][3]);
        const char* qr = lds + G_QS + (wave * 16 + n) * LROW + kk * 64 + g * 8;
        s16x4 qa = *(const s16x4*)(qr), qb = *(const s16x4*)(qr + 32);
        bf16x8 qp = __builtin_shufflevector(qa, qb, 0, 1, 2, 3, 4, 5, 6, 7);
#pragma unroll
        for (int et = 0; et < NE; et++) {
          const char* vr = lds + G_VT + (et * 16 + n) * LROW + kk * 64 + g * 8;
          s16x4 va = *(const s16x4*)(vr), vb = *(const s16x4*)(vr + 32);
          bf16x8 vf = __builtin_shufflevector(va, vb, 0, 1, 2, 3, 4, 5, 6, 7);
          o[et] = MFMA16(pa.v, vf, o[et]);
          union { bf16x8 v; unsigned u[4]; } sb;
          sb.u[0] = pack2(S[2 * kk][et][0], S[2 * kk][et][1]); sb.u[1] = pack2(S[2 * kk][et][2], S[2 * kk][et][3]);
          sb.u[2] = pack2(S[2 * kk + 1][et][0], S[2 * kk + 1][et][1]); sb.u[3] = pack2(S[2 * kk + 1][et][2], S[2 * kk + 1][et][3]);
          o[et] = MFMA16(qp, sb.v, o[et]);
        }
      }
#pragma unroll
      for (int r = 0; r < 4; r++) {
        int i = wave * 16 + 4 * g + r;
        int tok = dir ? ctb + 63 - i : ctb + i;
        u16* orow = odst + (size_t)(crowbase + tok) * 512 + h * 128 + sl * 64 + n;
#pragma unroll
        for (int et = 0; et < NE; et++) orow[et * 16] = f2bf(o[et][r]);
      }
    }
    if (PASS == 1 || ci < 3) {
      bf16x8 vfr[NE][2];
#pragma unroll
      for (int et = 0; et < NE; et++)
#pragma unroll
        for (int s = 0; s < 2; s++) vfr[et][s] = *(const bf16x8*)(lds + G_VT + (et * 16 + n) * LROW + s * 64 + g * 16);
#pragma unroll
      for (int dt = 0; dt < 4; dt++) {
        bf16x8 kf0 = *(const bf16x8*)(lds + G_KT + (dt * 16 + n) * LROW + g * 16);
        bf16x8 kf1 = *(const bf16x8*)(lds + G_KT + (dt * 16 + n) * LROW + 64 + g * 16);
        const f32x4 dc = *(const f32x4*)(DEC + dt * 16 + 4 * g);
#pragma unroll
        for (int et = 0; et < NE; et++) {
          f32x4 u = {0.f, 0.f, 0.f, 0.f};
          u = MFMA16(kf0, vfr[et][0], u);
          u = MFMA16(kf1, vfr[et][1], u);
          S[dt][et] = S[dt][et] * dc + u;
        }
      }
    }
  }
  if (PASS == 1 && wave == 0) {
    float* dst = SL + ((size_t)(rest * 17 + seg)) * (1024 * NE) + lane * 4;
#pragma unroll
    for (int dt = 0; dt < 4; dt++)
#pragma unroll
      for (int et = 0; et < NE; et++) *(f32x4*)(dst + (dt * NE + et) * 256) = S[dt][et];
    if (sl == 0) DS[(size_t)(combo * 17 + seg) * 64 + lane] = totsum;
  }
}

DI void task_gla_prefix(const Params& p, int rest) {
  const int tid = threadIdx.x, combo = rest >> 1;
  constexpr int SSZ = 1024 * NE;
  float* SL = (float*)(p.ws + OFF_SL) + (size_t)rest * 17 * SSZ + tid * 16;
  const int tile = tid >> 4, g4 = (tid & 15) >> 2;
  const float* DS = (const float*)(p.ws + OFF_DS) + (size_t)combo * 17 * 64 + (tile / NE) * 16 + 4 * g4;
  f32x4 s0 = {0.f, 0.f, 0.f, 0.f}, s1 = s0, s2 = s0, s3 = s0;
#pragma unroll 2
  for (int seg = 0; seg < 16; seg++) {
    float* q = SL + (size_t)seg * SSZ;
    const f32x4 c0 = *(const f32x4*)(q), c1 = *(const f32x4*)(q + 4), c2 = *(const f32x4*)(q + 8), c3 = *(const f32x4*)(q + 12);
    const f32x4 dl = *(const f32x4*)(DS + seg * 64);
    *(f32x4*)(q) = s0; *(f32x4*)(q + 4) = s1; *(f32x4*)(q + 8) = s2; *(f32x4*)(q + 12) = s3;
    const f32x4 dc = {__expf(dl[0]), __expf(dl[1]), __expf(dl[2]), __expf(dl[3])};
    s0 = s0 * dc + c0; s1 = s1 * dc + c1; s2 = s2 * dc + c2; s3 = s3 * dc + c3;
  }
  float* q = SL + (size_t)16 * SSZ;
  *(f32x4*)(q) = s0; *(f32x4*)(q + 4) = s1; *(f32x4*)(q + 8) = s2; *(f32x4*)(q + 12) = s3;
}

DI void task_gla_out(const Params& p, int l, int task) {
  const int lane = threadIdx.x & 63, wave = threadIdx.x >> 6;
  const int row0 = task * 16 + wave * 4;
  u16* of = (u16*)(p.ws + OFF_Y) + (size_t)NTOK * 512 + (size_t)row0 * 512 + lane * 8;
  const u16* ob = (const u16*)(p.ws + OFF_OB) + (size_t)row0 * 512 + lane * 8;
  const u16* gr = (const u16*)(p.ws + OFF_PN) + (size_t)row0 * PNLD + 1152 + lane * 8;
  uint4 a[4], bb[4], rr[4];
#pragma unroll
  for (int q = 0; q < 4; q++) { a[q] = *(const uint4*)(of + q * 512); bb[q] = *(const uint4*)(ob + q * 512); rr[q] = *(const uint4*)(gr + (size_t)q * PNLD); }
  const float* gn = p.gla_norm + l * 128 + (lane & 15) * 8;
  float gnv[8];
#pragma unroll
  for (int i = 0; i < 8; i++) gnv[i] = gn[i];
#pragma unroll
  for (int q = 0; q < 4; q++) {
    const unsigned au[4] = {a[q].x, a[q].y, a[q].z, a[q].w}, bu[4] = {bb[q].x, bb[q].y, bb[q].z, bb[q].w}, ru[4] = {rr[q].x, rr[q].y, rr[q].z, rr[q].w};
    float v[8], rv[8], ss = 0.f;
#pragma unroll
    for (int i = 0; i < 4; i++) {
      v[2 * i] = __uint_as_float(au[i] << 16) + __uint_as_float(bu[i] << 16);
      v[2 * i + 1] = __uint_as_float(au[i] & 0xffff0000u) + __uint_as_float(bu[i] & 0xffff0000u);
      rv[2 * i] = __uint_as_float(ru[i] << 16);
      rv[2 * i + 1] = __uint_as_float(ru[i] & 0xffff0000u);
      ss += v[2 * i] * v[2 * i] + v[2 * i + 1] * v[2 * i + 1];
    }
    ss += __shfl_xor(ss, 1, 64); ss += __shfl_xor(ss, 2, 64); ss += __shfl_xor(ss, 4, 64); ss += __shfl_xor(ss, 8, 64);
    const float rstd = rsqrtf(ss * (1.0f / 128.0f) + 1e-6f);
    float o[8];
#pragma unroll
    for (int i = 0; i < 8; i++) o[i] = v[i] * rstd * gnv[i] * siluf_(rv[i]);
    uint4 w; w.x = pack2(o[0], o[1]); w.y = pack2(o[2], o[3]); w.z = pack2(o[4], o[5]); w.w = pack2(o[6], o[7]);
    *(uint4*)(of + q * 512) = w;
  }
}

constexpr size_t OFF_GQ = OFF_ACT;
static_assert(OFF_GQ + (size_t)3072 * NTOK <= OFF_Y, "gate alias");

DI void task_gates(const Params& p, int l, int tile, char* lds) {
  const int mt = tile / 12, nt = tile % 12;
  const int tid = threadIdx.x, lane = tid & 63, wave = tid >> 6;
  const int wm = wave >> 1, wn = wave & 1, g = lane >> 4, n = lane & 15;
  f32x4 acc[4][8];
#pragma unroll
  for (int i = 0; i < 4; i++)
#pragma unroll
    for (int j = 0; j < 8; j++) acc[i][j] = f32x4{0.f, 0.f, 0.f, 0.f};
  gemm_wide((const u16*)(p.ws + OFF_HB) + (size_t)mt * 128 * 32, NTOK, (const u16*)(p.ws + OFF_WMG) + (size_t)nt * 256 * 32, 3072, D, acc, lds);
  unsigned char* GQ = (unsigned char*)(p.ws + OFF_GQ);
  const float* bm = p.b_merge + l * 3072 + nt * 256 + wn * 128 + n;
#pragma unroll
  for (int ni = 0; ni < 8; ni++) {
    const float bias = bm[ni * 16];
    const size_t col = (size_t)(nt * 256 + wn * 128 + ni * 16 + n);
#pragma unroll
    for (int mi = 0; mi < 4; mi++) {
      const int row0 = mt * 128 + wm * 64 + mi * 16 + 4 * g;
      unsigned q0 = (unsigned)(sigmoidf_(acc[mi][ni][0] + bias) * 255.0f + 0.5f);
      unsigned q1 = (unsigned)(sigmoidf_(acc[mi][ni][1] + bias) * 255.0f + 0.5f);
      unsigned q2 = (unsigned)(sigmoidf_(acc[mi][ni][2] + bias) * 255.0f + 0.5f);
      unsigned q3 = (unsigned)(sigmoidf_(acc[mi][ni][3] + bias) * 255.0f + 0.5f);
      *(unsigned*)(GQ + col * NTOK + row0) = q0 | (q1 << 8) | (q2 << 16) | (q3 << 24);
    }
  }
}

DI void task_mg(const Params& p, int l, int tile, char* lds) {
  const int mt = tile >> 3, nt = tile & 7;
  const int tid = threadIdx.x, lane = tid & 63, wave = tid >> 6;
  const int wm = wave >> 1, wn = wave & 1, g = lane >> 4, n = lane & 15;
  f32x4 mix[4][4];
  zero_acc<4>(mix);
  const unsigned char* GQ = (const unsigned char*)(p.ws + OFF_GQ);
#pragma unroll 1
  for (int br = 0; br < 3; br++) {
    f32x4 acc[4][4];
    zero_acc<4>(acc);
    gemm_tile<4, 0>((const u16*)(p.ws + OFF_Y) + (size_t)br * NTOK * 512 + (size_t)mt * 128 * 512, 512,
                 (const u16*)(p.ws + OFF_WBR) + (size_t)br * 1024 * 512 + (size_t)nt * 128 * 512, 512, 512, acc, lds);
#pragma unroll
    for (int ni = 0; ni < 4; ni++) {
      const size_t col = (size_t)(br * 1024 + nt * 128 + wn * 64 + ni * 16 + n);
#pragma unroll
      for (int mi = 0; mi < 4; mi++) {
        const int row0 = mt * 128 + wm * 64 + mi * 16 + 4 * g;
        const unsigned q = *(const unsigned*)(GQ + col * NTOK + row0);
        mix[mi][ni][0] += (float)(q & 255u) * (1.0f / 255.0f) * acc[mi][ni][0];
        mix[mi][ni][1] += (float)((q >> 8) & 255u) * (1.0f / 255.0f) * acc[mi][ni][1];
        mix[mi][ni][2] += (float)((q >> 16) & 255u) * (1.0f / 255.0f) * acc[mi][ni][2];
        mix[mi][ni][3] += (float)(q >> 24) * (1.0f / 255.0f) * acc[mi][ni][3];
      }
    }
  }
  u16* mx = (u16*)(p.ws + OFF_MIXED);
#pragma unroll
  for (int mi = 0; mi < 4; mi++)
#pragma unroll
    for (int ni = 0; ni < 4; ni++)
#pragma unroll
      for (int r = 0; r < 4; r++)
      {
        const int row = mt * 128 + wm * 64 + mi * 16 + 4 * g + r, col = nt * 128 + wn * 64 + ni * 16 + n;
        mx[((size_t)(col >> 5) * NTOK + row) * 32 + (col & 31)] = f2bf(mix[mi][ni][r]);
      }
}

DI void task_res_wide(const Params& p, int l, int tile, const u16* A, int lda, const u16* Wt, int K, int gate_idx, bool first, char* lds) {
  const int mt = tile >> 2, nt = tile & 3;
  const int tid = threadIdx.x, lane = tid & 63, wave = tid >> 6;
  const int wm = wave >> 1, wn = wave & 1, g = lane >> 4, n = lane & 15;
  f32x4 acc[4][8];
#pragma unroll
  for (int i = 0; i < 4; i++)
#pragma unroll
    for (int j = 0; j < 8; j++) acc[i][j] = f32x4{0.f, 0.f, 0.f, 0.f};
  gemm_wide(A + (size_t)mt * 128 * 32, NTOK, Wt + (size_t)nt * 256 * 32, D, K, acc, lds);
  const float* gt = modp(p, l, mt * 128) + gate_idx * D + nt * 256 + wn * 128 + n;
#pragma unroll
  for (int ni = 0; ni < 8; ni++) {
    const float gv = gt[ni * 16];
#pragma unroll
    for (int mi = 0; mi < 4; mi++)
#pragma unroll
      for (int r = 0; r < 4; r++) {
        int row = mt * 128 + wm * 64 + mi * 16 + 4 * g + r, col = nt * 256 + wn * 128 + ni * 16 + n;
        const float* xs = first ? xsrc(p, l, row) : (const float*)xdst(p, row);
        xdst(p, row)[col] = xs[col] + gv * acc[mi][ni][r];
      }
  }
}

DI void task_res_ctx(const Params& p, int l, int tile, const u16* A, int lda, const u16* Wt, int K, int gate_idx, bool first, char* lds) {
  const int mt = 128 + (tile >> 4), nt = tile & 15;
  const int tid = threadIdx.x, lane = tid & 63, wave = tid >> 6;
  const int wm = wave >> 1, wn = wave & 1, g = lane >> 4, n = lane & 15;
  f32x4 acc[4][2];
  zero_acc<2>(acc);
  gemm_tile<2, 1>(A + (size_t)mt * 128 * 32, NTOK, Wt + (size_t)nt * 64 * 32, D, K, acc, lds);
  const float* gt = modp(p, l, mt * 128) + gate_idx * D + nt * 64 + wn * 32 + n;
#pragma unroll
  for (int ni = 0; ni < 2; ni++) {
    const float gv = gt[ni * 16];
#pragma unroll
    for (int mi = 0; mi < 4; mi++)
#pragma unroll
      for (int r = 0; r < 4; r++) {
        int row = mt * 128 + wm * 64 + mi * 16 + 4 * g + r, col = nt * 64 + wn * 32 + ni * 16 + n;
        const float* xs = first ? xsrc(p, l, row) : (const float*)xdst(p, row);
        xdst(p, row)[col] = xs[col] + gv * acc[mi][ni][r];
      }
  }
}

DI void task_f1(const Params& p, int tile, char* lds) {
  const int mt = tile / 22, nt = tile % 22;
  const int tid = threadIdx.x, lane = tid & 63, wave = tid >> 6;
  const int wm = wave >> 1, wn = wave & 1, g = lane >> 4, n = lane & 15;
  f32x4 acc[4][8];
#pragma unroll
  for (int i = 0; i < 4; i++)
#pragma unroll
    for (int j = 0; j < 8; j++) acc[i][j] = f32x4{0.f, 0.f, 0.f, 0.f};
  gemm_wide((const u16*)(p.ws + OFF_HB) + (size_t)mt * 128 * 32, NTOK, (const u16*)(p.ws + OFF_WF1) + (size_t)nt * 256 * 32, 2 * FH, D, acc, lds);
  u16* act = (u16*)(p.ws + OFF_ACT);
#pragma unroll
  for (int mi = 0; mi < 4; mi++)
#pragma unroll
    for (int ni = 0; ni < 4; ni++)
#pragma unroll
      for (int r = 0; r < 4; r++) {
        int row = mt * 128 + wm * 64 + mi * 16 + 4 * g + r, col = nt * 128 + wn * 64 + ni * 16 + n;
        act[((size_t)(col >> 5) * NTOK + row) * 32 + (col & 31)] = f2bf(siluf_(acc[mi][ni][r]) * acc[mi][ni + 4][r]);
      }
}

#define XB_TMO      128
#define XB_XCNT(j)  (256  + 64 * (j))
#define XB_XSUB(j)  (1280 + 64 * (j))
#define XB_XGEN(j)  (2304 + 64 * (j))
#define XB_TOP      3328
#define XB_TOPGEN   3392
#define XCD_BAR_WORDS 3456
#define XB_SPIN_CAP (1u << 18)
#define LAS __attribute__((address_space(3)))

__device__ __forceinline__ unsigned xb_ld(unsigned* p)              { return __hip_atomic_load(p, __ATOMIC_RELAXED, __HIP_MEMORY_SCOPE_AGENT); }
__device__ __forceinline__ unsigned xb_add(unsigned* p, unsigned v) { return __hip_atomic_fetch_add(p, v, __ATOMIC_RELAXED, __HIP_MEMORY_SCOPE_AGENT); }
__device__ __forceinline__ unsigned xb_xcc_id() { return (unsigned)__builtin_amdgcn_s_getreg((3 << 11) | 20) & 0xFu; }
#define XB_SPIN(cond, bar) do { unsigned _sp = 0; while (cond) { __builtin_amdgcn_s_sleep(1); \
    if ((++_sp & 255u) == 0u) { if (xb_ld(&(bar)[XB_TMO])) break; if (_sp > XB_SPIN_CAP) { atomicAdd(&(bar)[XB_TMO], 1u); break; } } } } while (0)

struct XcdBarrier {
    unsigned* bar; unsigned x;
    volatile LAS unsigned* st;
};

__device__ __forceinline__ XcdBarrier xcd_barrier_post(unsigned* bar, volatile LAS unsigned* st) {
    XcdBarrier b; b.bar = bar; b.x = xb_xcc_id(); b.st = st;
    if (threadIdx.x == 0) (void)xb_add(&bar[XB_XCNT(b.x)], 1u);
    return b;
}
__device__ __forceinline__ void xcd_barrier_complete(unsigned* bar, unsigned x, unsigned& nloc, unsigned& nx) {
    const unsigned G = gridDim.x * gridDim.y * gridDim.z;
    unsigned sum, cnt, mine, sp = 0u;
    for (;;) {
        sum = 0u; cnt = 0u; mine = 0u;
#pragma unroll
        for (unsigned j = 0; j < 16; ++j) { const unsigned c = xb_ld(&bar[XB_XCNT(j)]); sum += c; cnt += (c > 0u) ? 1u : 0u; mine = (j == x) ? c : mine; }
        if (sum == G) break;
        __builtin_amdgcn_s_sleep(1);
        if ((++sp & 255u) == 0u) { if (xb_ld(&bar[XB_TMO])) break; if (sp > XB_SPIN_CAP) { atomicAdd(&bar[XB_TMO], 1u); break; } }
    }
    nloc = mine > 0u ? mine : 1u; nx = cnt > 0u ? cnt : 1u;
}

__device__ __forceinline__ void xcd_barrier(const XcdBarrier& b) {
    asm volatile("s_waitcnt vmcnt(0)" ::: "memory");
    __syncthreads();
    if (threadIdx.x == 0) {
        unsigned* bar = b.bar;
        __builtin_amdgcn_s_waitcnt(0);
        unsigned nloc = b.st[0], nx = b.st[1];
        if (nloc == 0u) { xcd_barrier_complete(bar, b.x, nloc, nx); b.st[0] = nloc; b.st[1] = nx; }
        const unsigned old = xb_add(&bar[XB_XSUB(b.x)], 1u);
        const unsigned gen = old / nloc;
        if (old + 1u == (gen + 1u) * nloc) {
            __builtin_amdgcn_fence(__ATOMIC_RELEASE, "agent");
            asm volatile("s_waitcnt vmcnt(0)" ::: "memory");
            const unsigned og = xb_add(&bar[XB_TOP], 1u);
            const unsigned tg = og / nx;
            if (og + 1u == (tg + 1u) * nx) xb_add(&bar[XB_TOPGEN], 1u);
            else XB_SPIN(xb_ld(&bar[XB_TOPGEN]) == tg, bar);
            __builtin_amdgcn_fence(__ATOMIC_ACQUIRE, "agent");
            xb_add(&bar[XB_XGEN(b.x)], 1u);
            asm volatile("s_waitcnt vmcnt(0)" ::: "memory");
        } else {
            XB_SPIN(xb_ld(&bar[XB_XGEN(b.x)]) == gen, bar);
            __builtin_amdgcn_fence(__ATOMIC_ACQUIRE, "agent");
            asm volatile("s_waitcnt vmcnt(0)" ::: "memory");
        }
    }
    __syncthreads();
}


DI int xcd_swizzle(int t, int nb, int ntiles) {
  const int r = t / nb;
  if ((nb & 7) || (r + 1) * nb > ntiles) return t;
  const int b = t - r * nb, per = nb >> 3;
  return r * nb + (b & 7) * per + (b >> 3);
}

constexpr int NPHASE = 26;
constexpr int SMEM_BYTES = 2 * GBUF;

DI void run_phase(const Params& p, int ph, char* lds) {
  const int bid = blockIdx.x, nb = gridDim.x, wave = threadIdx.x >> 6;
  if (ph == 0) {
    for (int t = bid; t < 192 + 512 + CONV1_TASKS; t += nb) {
      if (t < 192) task_mod(p, t, lds); else if (t < 704) task_rope(p, t - 192); else task_conv1(p, 0, t - 704, lds);
    }
    return;
  }
  if (ph == 25) { for (int t = bid; t < NLAT / 16; t += nb) task_final_norm(p, t); return; }
  const int l = (ph - 1) / 12; int sp = (ph - 1) % 12;
  const bool last = l == 1;
  const int mtiles = last ? 128 : 136;
  if (sp >= 7) sp = (sp == 7) ? 11 : sp - 1;
  switch (sp) {
    case 0: for (int t = bid; t < NTOK / 16; t += nb) task_norm(p, l, t, 0); break;
    case 1: {
      for (int t = bid; t < 136 * 15; t += nb) task_g1(p, l, xcd_swizzle(t, nb, 136 * 15), lds);
      for (int t = (bid + nb - ((136 * 15) % nb)) % nb; t < 136; t += nb) task_g1_tail(p, l, t, lds);
    } break;
    case 2: for (int t = bid; t < 1024; t += nb) task_gla<1>(p, l, xcd_swizzle(t, nb, 1024), lds); break;
    case 3: {
      for (int t = bid; t < 64; t += nb) task_gla_prefix(p, t);
      for (int t = bid; t < 512; t += nb) attn_a_latent(p, l, xcd_swizzle(t, nb, 512) * 4 + wave);
      if (!last) for (int t = bid; t < 32; t += nb) attn_ctx(p, l, (31 - t) * 4 + wave, 0);
    } break;
    case 4: for (int t = bid; t < 1088; t += nb) task_gla<2>(p, l, xcd_swizzle(t, nb, 1088), lds); break;
    case 5: {
      __syncthreads();
      for (int t = bid; t < 512; t += nb) attn_c_latent(p, l, xcd_swizzle(t, nb, 512) * 4 + wave, lds);
      if (!last) for (int t = bid; t < 32; t += nb) attn_ctx(p, l, t * 4 + wave, 1);
      for (int t = bid; t < (last ? NLAT : NTOK) / 16; t += nb) task_gla_out(p, l, t);
    } break;
    case 6: for (int t = bid; t < mtiles * 12; t += nb) task_gates(p, l, xcd_swizzle(t, nb, mtiles * 12), lds); break;
    case 11: for (int t = bid; t < mtiles * 8; t += nb) task_mg(p, l, xcd_swizzle(t, nb, mtiles * 8), lds); break;
    case 7: {
      for (int t = bid; t < 512; t += nb) task_res_wide(p, l, xcd_swizzle(t, nb, 512), (const u16*)(p.ws + OFF_MIXED), D, (const u16*)(p.ws + OFF_WOUT), D, 2, true, lds);
      if (!last) for (int t = bid; t < 128; t += nb) task_res_ctx(p, l, t, (const u16*)(p.ws + OFF_MIXED), D, (const u16*)(p.ws + OFF_WOUT), D, 2, true, lds);
      for (int t = (bid + nb - (last ? 0 : 128)) % nb; t < CONV2_TASKS; t += nb) task_conv2(p, l, t, lds);
    } break;
    case 8: for (int t = bid; t < (last ? NLAT : NTOK) / 16; t += nb) task_norm(p, l, t, 1); break;
    case 9: for (int t = bid; t < mtiles * 22; t += nb) task_f1(p, xcd_swizzle(t, nb, mtiles * 22), lds); break;
    case 10: {
      for (int t = bid; t < 512; t += nb) task_res_wide(p, l, xcd_swizzle(t, nb, 512), (const u16*)(p.ws + OFF_ACT), FH, (const u16*)(p.ws + OFF_WF2), FH, 5, false, lds);
      if (!last) {
        for (int t = bid; t < 128; t += nb) task_res_ctx(p, l, t, (const u16*)(p.ws + OFF_ACT), FH, (const u16*)(p.ws + OFF_WF2), FH, 5, false, lds);
        for (int t = (bid + nb - 128) % nb; t < CONV1_TASKS; t += nb) task_conv1(p, 1, t, lds);
      }
    } break;
  }
}

#if MULTI_LAUNCH
__global__ void __launch_bounds__(256, 2) k_phase(Params p, int ph) {
  __shared__ __attribute__((aligned(16))) char smem[SMEM_BYTES];
  run_phase(p, ph, smem);
}
#endif

#if !MULTI_LAUNCH
__global__ void __launch_bounds__(256, 2) k_mega(Params p) {
  extern __shared__ __attribute__((aligned(16))) char smem[];
  __shared__ uint4 xb_words;
  if (threadIdx.x == 0) xb_words = make_uint4(0u, 0u, 0u, 0u);
  __syncthreads();
  XcdBarrier xb = xcd_barrier_post((unsigned*)(p.ws + OFF_BAR), (volatile LAS unsigned*)&xb_words);
  if (p.ws == nullptr) cg::this_grid().sync();
#define PH(k) run_phase(p, k, smem); xcd_barrier(xb);
  PH(0) PH(1) PH(2) PH(3) PH(4) PH(5) PH(6) PH(7) PH(8) PH(9) PH(10) PH(11) PH(12) PH(13) PH(14) PH(15) PH(16) PH(17) PH(18) PH(19) PH(20) PH(21) PH(22) PH(23) PH(24)
  run_phase(p, 25, smem);
}
#endif

extern "C" void kernel_launch(void* const* d_in, const int* in_sizes, int n_in, void* d_out, int out_size, void* d_ws, size_t ws_size,
                              hipStream_t stream) {
  Params p{};
  const float** f = (const float**)&p;
  for (int i = 0; i < 25; i++) f[i] = (const float*)d_in[i];
  p.out = (float*)d_out;
  p.ws = (char*)d_ws;
#if MULTI_LAUNCH
  for (int ph = 0; ph < NPHASE; ph++) hipLaunchKernelGGL(k_phase, dim3(512), dim3(256), 0, stream, p, ph);
#else
  static int grid_blocks = 0;
  if (!grid_blocks) {
    int dev = 0, cus = 0, per_cu = 0;
    hipGetDevice(&dev);
    hipDeviceGetAttribute(&cus, hipDeviceAttributeMultiprocessorCount, dev);
    (void)hipFuncSetAttribute((const void*)k_mega, hipFuncAttributeMaxDynamicSharedMemorySize, SMEM_BYTES);
    (void)hipOccupancyMaxActiveBlocksPerMultiprocessor(&per_cu, k_mega, 256, SMEM_BYTES);
    if (per_cu > 2) per_cu = 2;
    if (per_cu < 1) per_cu = 1;
    grid_blocks = cus * per_cu;
  }
  hipMemsetAsync((char*)d_ws + OFF_BAR, 0, XCD_BAR_WORDS * 4, stream);
  void* args[] = {&p};
  hipError_t e = hipLaunchCooperativeKernel((void*)k_mega, dim3(grid_blocks), dim3(256), args, SMEM_BYTES, stream);
  if (e != hipSuccess) fprintf(stderr, "cooperative launch failed: %s (grid %d)\n", hipGetErrorString(e), grid_blocks);
#endif
}
```

```cpp
#include <hip/hip_runtime.h>
#include <hip/hip_cooperative_groups.h>
#include <cstdio>
namespace cg = cooperative_groups;

#ifndef MULTI_LAUNCH
#define MULTI_LAUNCH 0
#endif

typedef unsigned short u16;
using bf16x8 = __attribute__((ext_vector_type(8))) short;
using s16x4  = __attribute__((ext_vector_type(4))) short;
using f32x4  = __attribute__((ext_vector_type(4))) float;
#define DI __device__ __forceinline__
#define MFMA16(a, b, c) __builtin_amdgcn_mfma_f32_16x16x32_bf16((a), (b), (c), 0, 0, 0)

constexpr int D = 1024, NB = 4, SEQ = 4096, LC = 256, NLAT = NB * SEQ, NCTX = NB * LC, NTOK = NLAT + NCTX;
constexpr int INT = 3872, INTP = 3968, FH = 2816, PNLD = 2720, VTR = 1152;
constexpr float LOG2E = 1.4426950408889634f;

constexpr size_t OFF_WIN  = 0;
constexpr size_t OFF_WMG  = OFF_WIN + (size_t)INTP * D * 2;
constexpr size_t OFF_WBR  = OFF_WMG + (size_t)3072 * D * 2;
constexpr size_t OFF_WOUT = OFF_WBR + (size_t)3 * 1024 * 512 * 2;
constexpr size_t OFF_WF1  = OFF_WOUT + (size_t)D * D * 2;
constexpr size_t OFF_WF2  = OFF_WF1 + (size_t)2 * FH * D * 2;
constexpr size_t OFF_PAD  = OFF_WF2 + (size_t)D * FH * 2;
constexpr size_t OFF_MOD  = OFF_PAD + (1u << 20);
constexpr size_t OFF_ROPE = OFF_MOD + (size_t)2 * 5 * 6144 * 4;
constexpr size_t OFF_XC   = OFF_ROPE + (size_t)SEQ * 32 * 2 * 4;
constexpr size_t OFF_HB   = OFF_XC + (size_t)NCTX * D * 4;
constexpr size_t OFF_PN   = OFF_HB + (size_t)NTOK * D * 2;
constexpr size_t OFF_VT   = OFF_PN + (size_t)NTOK * PNLD * 2;
constexpr size_t OFF_VTC  = OFF_VT + (size_t)NB * VTR * SEQ * 2;
constexpr size_t OFF_Y    = OFF_VTC + (size_t)NB * VTR * LC * 2;
constexpr size_t WS_END   = OFF_Y + (size_t)3 * NTOK * 512 * 2;
static_assert(WS_END <= ((size_t)256 << 20), "workspace too large");
constexpr size_t OFF_OB    = OFF_WF1;
static_assert(OFF_OB + (size_t)NTOK * 512 * 2 <= OFF_MOD, "o_b alias");
constexpr size_t OFF_BAR   = OFF_PAD + (768u << 10);
constexpr size_t OFF_MIXED = OFF_PN;
constexpr size_t OFF_ACT   = OFF_PN + (size_t)NTOK * D * 2;
static_assert(OFF_ACT + (size_t)NTOK * FH * 2 <= OFF_Y, "act alias");

struct Params {
  const float *x, *c, *ctx, *c_ctx, *w_ada, *b_ada, *norm_mix, *w_in, *sink, *gw_f, *gb_f, *gw_b, *gb_b, *gla_norm, *rpb,
      *w_ba, *w_bb, *w_bc, *w_merge, *b_merge, *w_out, *norm_ffn, *w_ffn_in, *w_ffn_out, *final_norm;
  float* out;
  char* ws;
};

typedef __bf16 bf2_t __attribute__((ext_vector_type(2)));
DI u16 f2bf(float x) { __bf16 v = (__bf16)x; return __builtin_bit_cast(u16, v); }
DI float bf2f(u16 h) { return __uint_as_float(((unsigned)h) << 16); }
DI unsigned pack2(float a, float b) { bf2_t v = {(__bf16)a, (__bf16)b}; return __builtin_bit_cast(unsigned, v); }
DI float wave_sum(float v) { for (int o = 32; o; o >>= 1) v += __shfl_xor(v, o, 64); return v; }
DI float sigmoidf_(float x) { return __builtin_amdgcn_rcpf(1.0f + __expf(-x)); }
DI float siluf_(float x) { return x * __builtin_amdgcn_rcpf(1.0f + __expf(-x)); }

DI const float* xsrc(const Params& p, int l, int row) {
  if (row < NLAT) return (l == 0 ? p.x : p.out) + (size_t)row * D;
  return (l == 0 ? p.ctx : (const float*)(p.ws + OFF_XC)) + (size_t)(row - NLAT) * D;
}
DI float* xdst(const Params& p, int row) {
  if (row < NLAT) return p.out + (size_t)row * D;
  return (float*)(p.ws + OFF_XC) + (size_t)(row - NLAT) * D;
}
DI const float* modp(const Params& p, int l, int row) {
  int s = row < NLAT ? (row >> 12) : 4;
  return (const float*)(p.ws + OFF_MOD) + (size_t)(l * 5 + s) * 6144;
}

constexpr int LROW = 144;
constexpr int LDS_A = 0, LDS_B = 128 * LROW;

constexpr int GROW = 128;
constexpr int G_A = 0, G_B = 128 * GROW;
constexpr int GBUF = 2 * 128 * GROW;
template <int NI, int CH>
DI void gemm_tile(const u16* __restrict__ A, int lda, const u16* __restrict__ Bt, int ldb, int K,
                  f32x4 (&acc)[4][NI], char* lds) {
  const int tid = threadIdx.x, lane = tid & 63, wave = tid >> 6;
  const int wm = wave >> 1, wn = wave & 1, g = lane >> 4, n = lane & 15;
  const int lrow = tid >> 3, lkc = tid & 7;
  const u16* ap = CH ? A + (size_t)lrow * 32 + (size_t)(lkc >> 2) * lda * 32 + (lkc & 3) * 8 : A + (size_t)lrow * lda + lkc * 8;
  const u16* bp = CH ? Bt + (size_t)lrow * 32 + (size_t)(lkc >> 2) * ldb * 32 + (lkc & 3) * 8 : Bt + (size_t)lrow * ldb + lkc * 8;
  const size_t sa = CH ? (size_t)32 * 32 : (size_t)32 * lda, sb = CH ? (size_t)32 * 32 : (size_t)32 * ldb;
  const size_t ka = CH ? (size_t)lda : 1, kb = CH ? (size_t)ldb : 1;
  const int wsw = (lkc ^ ((lrow >> 1) & 7)) * 16;
  const int rsw0 = (g ^ ((n >> 1) & 7)) * 16, rsw1 = ((4 + g) ^ ((n >> 1) & 7)) * 16;
  uint4 ra0, ra1, ra2, ra3, rb0, rb1, rb2, rb3;
#define GLOADS(kk)                                                                                                   \
  {                                                                                                                  \
    ra0 = *(const uint4*)(ap + (kk) * ka); ra1 = *(const uint4*)(ap + sa + (kk) * ka);                               \
    ra2 = *(const uint4*)(ap + 2 * sa + (kk) * ka); ra3 = *(const uint4*)(ap + 3 * sa + (kk) * ka);                  \
    rb0 = *(const uint4*)(bp + (kk) * kb); rb1 = *(const uint4*)(bp + sb + (kk) * kb);                               \
    if (NI == 4) { rb2 = *(const uint4*)(bp + 2 * sb + (kk) * kb); rb3 = *(const uint4*)(bp + 3 * sb + (kk) * kb); } \
  }
#define LSTORES(buf)                                                                                                 \
  {                                                                                                                  \
    char* wa_ = lds + (buf) * GBUF + G_A + lrow * GROW + wsw;                                                        \
    char* wb_ = lds + (buf) * GBUF + G_B + lrow * GROW + wsw;                                                        \
    *(uint4*)(wa_) = ra0; *(uint4*)(wa_ + 32 * GROW) = ra1; *(uint4*)(wa_ + 64 * GROW) = ra2; *(uint4*)(wa_ + 96 * GROW) = ra3; \
    *(uint4*)(wb_) = rb0; *(uint4*)(wb_ + 32 * GROW) = rb1;                                                          \
    if (NI == 4) { *(uint4*)(wb_ + 64 * GROW) = rb2; *(uint4*)(wb_ + 96 * GROW) = rb3; }                             \
  }
  GLOADS(0);
  __syncthreads();
  LSTORES(0);
  GLOADS(64);
  __syncthreads();
  const int nk = K >> 6;
#pragma unroll 1
  for (int it = 0; it < nk; it++) {
    const int cur = it & 1;
    if (it + 1 < nk) LSTORES(cur ^ 1);
    if (it + 2 < nk) GLOADS((it + 2) * 64);
    const char* fa = lds + cur * GBUF + G_A + (wm * 64 + n) * GROW;
    const char* fb = lds + cur * GBUF + G_B + (wn * 16 * NI + n) * GROW;
#pragma unroll
    for (int ks = 0; ks < 2; ks++) {
      const int rsw = ks ? rsw1 : rsw0;
      bf16x8 af[4], bfr[NI];
#pragma unroll
      for (int i = 0; i < 4; i++) af[i] = *(const bf16x8*)(fa + i * 16 * GROW + rsw);
#pragma unroll
      for (int i = 0; i < NI; i++) bfr[i] = *(const bf16x8*)(fb + i * 16 * GROW + rsw);
#pragma unroll
      for (int mi = 0; mi < 4; mi++)
#pragma unroll
        for (int ni = 0; ni < NI; ni++) acc[mi][ni] = MFMA16(af[mi], bfr[ni], acc[mi][ni]);
    }
    __syncthreads();
  }
#undef GLOADS
#undef LSTORES
}

template <int NI>
DI void zero_acc(f32x4 (&acc)[4][NI]) {
#pragma unroll
  for (int i = 0; i < 4; i++)
#pragma unroll
    for (int j = 0; j < NI; j++) acc[i][j] = f32x4{0.f, 0.f, 0.f, 0.f};
}

constexpr int LROW2 = 64;
constexpr int W_A = 0, W_B = 128 * LROW2, WBUF = 384 * LROW2;
DI void gemm_wide(const u16* __restrict__ A, int lda, const u16* __restrict__ Bt, int ldb, int K, f32x4 (&acc)[4][8], char* lds) {
  const int tid = threadIdx.x, lane = tid & 63, wave = tid >> 6;
  const int wm = wave >> 1, wn = wave & 1, g = lane >> 4, n = lane & 15;
  const int lrow = tid >> 2, lkc = tid & 3;
  const u16* ap = A + (size_t)lrow * 32 + lkc * 8;
  const u16* bp = Bt + (size_t)lrow * 32 + lkc * 8;
  const size_t sa = (size_t)64 * 32, sb = (size_t)64 * 32;
  const size_t ka = (size_t)lda, kb = (size_t)ldb;
  uint4 ra0, ra1, rb0, rb1, rb2, rb3;
  const int wsw = (lkc ^ ((0 - (lrow >> 2)) & 3)) * 16;
  const int rsw = (g ^ ((0 - (n >> 2)) & 3)) * 16;
#define GLOADS(kk)                                                                           \
  {                                                                                          \
    ra0 = *(const uint4*)(ap + (kk) * ka); ra1 = *(const uint4*)(ap + sa + (kk) * ka);       \
    rb0 = *(const uint4*)(bp + (kk) * kb); rb1 = *(const uint4*)(bp + sb + (kk) * kb);       \
    rb2 = *(const uint4*)(bp + 2 * sb + (kk) * kb); rb3 = *(const uint4*)(bp + 3 * sb + (kk) * kb); \
  }
#define LSTORES(buf)                                                                         \
  {                                                                                          \
    char* wa_ = lds + (buf) * WBUF + W_A + lrow * LROW2 + wsw;                               \
    char* wb_ = lds + (buf) * WBUF + W_B + lrow * LROW2 + wsw;                               \
    *(uint4*)(wa_) = ra0; *(uint4*)(wa_ + 64 * LROW2) = ra1;                                 \
    *(uint4*)(wb_) = rb0; *(uint4*)(wb_ + 64 * LROW2) = rb1;                                 \
    *(uint4*)(wb_ + 128 * LROW2) = rb2; *(uint4*)(wb_ + 192 * LROW2) = rb3;                  \
  }
#define HALF(h)                                                                              \
  {                                                                                          \
    bf16x8 bfr[4];                                                                           \
    _Pragma("unroll") for (int i = 0; i < 4; i++) bfr[i] = *(const bf16x8*)(fb + ((h) * 4 + i) * 16 * LROW2); \
    _Pragma("unroll") for (int mi = 0; mi < 4; mi++)                                         \
      _Pragma("unroll") for (int ni = 0; ni < 4; ni++) acc[mi][(h) * 4 + ni] = MFMA16(af[mi], bfr[ni], acc[mi][(h) * 4 + ni]); \
  }
  GLOADS(0);
  __syncthreads();
  LSTORES(0);
  GLOADS(32);
  __syncthreads();
  const int nk = K >> 5;
#pragma unroll 1
  for (int it = 0; it < nk; it++) {
    const int cur = it & 1;
    const char* fa = lds + cur * WBUF + W_A + (wm * 64 + n) * LROW2 + rsw;
    const char* fb = lds + cur * WBUF + W_B + (wn * 128 + n) * LROW2 + rsw;
    bf16x8 af[4];
#pragma unroll
    for (int i = 0; i < 4; i++) af[i] = *(const bf16x8*)(fa + i * 16 * LROW2);
    HALF(0);
    if (it + 1 < nk) LSTORES(cur ^ 1);
    if (it + 2 < nk) GLOADS((it + 2) * 32);
    HALF(1);
    __syncthreads();
  }
#undef GLOADS
#undef LSTORES
#undef HALF
}

DI void task_mod(const Params& p, int task, char* lds) {
  const int tid = threadIdx.x, lane = tid & 63, wave = tid >> 6;
  const int l = task / 96, cb = task % 96;
  float* sc = (float*)lds;
  float* red = sc + 5 * 1024;
  __syncthreads();
  for (int i = tid; i < 5 * 1024; i += 256) {
    int s = i >> 10, k = i & 1023;
    float v = s < 4 ? p.c[s * 1024 + k] : p.c_ctx[k];
    sc[i] = siluf_(v);
  }
  __syncthreads();
  const int ncol = cb * 64 + lane;
  const float* w = p.w_ada + (size_t)l * 1024 * 6144 + ncol;
  float a0 = 0, a1 = 0, a2 = 0, a3 = 0, a4 = 0;
#pragma unroll 16
  for (int k = wave * 256; k < wave * 256 + 256; k++) {
    float wv = w[(size_t)k * 6144];
    a0 += sc[k] * wv; a1 += sc[1024 + k] * wv; a2 += sc[2048 + k] * wv; a3 += sc[3072 + k] * wv; a4 += sc[4096 + k] * wv;
  }
  red[(wave * 5 + 0) * 64 + lane] = a0; red[(wave * 5 + 1) * 64 + lane] = a1; red[(wave * 5 + 2) * 64 + lane] = a2;
  red[(wave * 5 + 3) * 64 + lane] = a3; red[(wave * 5 + 4) * 64 + lane] = a4;
  __syncthreads();
  float* mod = (float*)(p.ws + OFF_MOD);
  for (int i = tid; i < 320; i += 256) {
    int s = i >> 6, ln = i & 63;
    float v = red[(0 * 5 + s) * 64 + ln] + red[(1 * 5 + s) * 64 + ln] + red[(2 * 5 + s) * 64 + ln] + red[(3 * 5 + s) * 64 + ln];
    int nc = cb * 64 + ln;
    mod[(size_t)(l * 5 + s) * 6144 + nc] = v + p.b_ada[l * 6144 + nc];
  }
}

DI void task_rope(const Params& p, int task) {
  int e = task * 256 + threadIdx.x;
  int t = e >> 5, i = e & 31;
  float pos = (i < 16) ? (float)(t >> 6) : (float)(t & 63);
  float inv = exp2f(-(float)(i & 15) * (13.287712379549449f / 16.0f));
  float ang = pos * inv;
  float kq = rintf(ang * 0.15915494309189535f);
  float rr = fmaf(-kq, 6.28125f, ang);
  rr = fmaf(-kq, 0.0019353071795864769f, rr);
  float s = sinf(rr), c = cosf(rr);
  float* rc = (float*)(p.ws + OFF_ROPE);
  rc[e] = c; rc[SEQ * 32 + e] = s;
}

DI void conv_tile(const float* __restrict__ src, int K, int N, int kt, int nt, u16* __restrict__ dst, int mode, int R, char* lds) {
  float* tile = (float*)lds;
  const int tid = threadIdx.x;
  const int k0 = kt * 128, n0 = nt * 64;
  __syncthreads();
  {
    float4 v[8];
#pragma unroll
    for (int i = 0; i < 8; i++) {
      int idx = tid + 256 * i, kk = idx >> 4, n4 = (idx & 15) * 4;
      v[i] = float4{0.f, 0.f, 0.f, 0.f};
      if (n0 + n4 < N) v[i] = *(const float4*)(src + (size_t)(k0 + kk) * N + n0 + n4);
    }
#pragma unroll
    for (int i = 0; i < 8; i++) {
      int idx = tid + 256 * i, kk = idx >> 4, n4 = (idx & 15) * 4;
      float* t = tile + kk * 65 + n4;
      t[0] = v[i].x; t[1] = v[i].y; t[2] = v[i].z; t[3] = v[i].w;
    }
  }
  __syncthreads();
#pragma unroll
  for (int i = 0; i < 4; i++) {
    int cidx = tid + 256 * i, nn = cidx >> 4, kc = cidx & 15;
    int ncol = n0 + nn;
    if (ncol < N) {
      int drow = ncol;
      if (mode == 1) {
        int up = ncol >= FH, j = up ? ncol - FH : ncol;
        drow = (j >> 7) * 256 + ((j >> 6) & 1) * 128 + up * 64 + (j & 63);
      }
      uint4 o;
      o.x = pack2(tile[(kc * 8 + 0) * 65 + nn], tile[(kc * 8 + 1) * 65 + nn]);
      o.y = pack2(tile[(kc * 8 + 2) * 65 + nn], tile[(kc * 8 + 3) * 65 + nn]);
      o.z = pack2(tile[(kc * 8 + 4) * 65 + nn], tile[(kc * 8 + 5) * 65 + nn]);
      o.w = pack2(tile[(kc * 8 + 6) * 65 + nn], tile[(kc * 8 + 7) * 65 + nn]);
      const int kd = k0 + kc * 8;
      if (R > 0) *(uint4*)(dst + ((size_t)(kd >> 5) * R + drow) * 32 + (kd & 31)) = o;
      else *(uint4*)(dst + (size_t)drow * K + kd) = o;
    }
  }
}

constexpr int CONV1_TASKS = 488 + 384 + 192 + 128 + 1;
constexpr int CONV2_TASKS = 704 + 352;
DI void task_conv1(const Params& p, int l, int t, char* lds) {
  if (t < 488) { conv_tile(p.w_in + (size_t)l * D * INT, D, INT, t / 61, t % 61, (u16*)(p.ws + OFF_WIN), 0, INTP, lds); return; }
  t -= 488;
  if (t < 384) { conv_tile(p.w_merge + (size_t)l * D * 3072, D, 3072, t / 48, t % 48, (u16*)(p.ws + OFF_WMG), 0, 3072, lds); return; }
  t -= 384;
  if (t < 192) {
    int br = t / 64, tt = t % 64;
    const float* src = (br == 0 ? p.w_ba : br == 1 ? p.w_bb : p.w_bc) + (size_t)l * 512 * D;
    conv_tile(src, 512, D, tt / 16, tt % 16, (u16*)(p.ws + OFF_WBR) + (size_t)br * 1024 * 512, 0, 0, lds);
    return;
  }
  t -= 192;
  if (t < 128) { conv_tile(p.w_out + (size_t)l * D * D, D, D, t / 16, t % 16, (u16*)(p.ws + OFF_WOUT), 0, D, lds); return; }
  uint4 z = {0, 0, 0, 0};
  for (int i = threadIdx.x; i < 32 * (INTP - INT) * 4; i += 256) {
    const int ch = i / ((INTP - INT) * 4), off = i % ((INTP - INT) * 4);
    *(uint4*)((u16*)(p.ws + OFF_WIN) + ((size_t)ch * INTP + INT) * 32 + off * 8) = z;
  }
}
DI void task_conv2(const Params& p, int l, int t, char* lds) {
  if (t < 704) { conv_tile(p.w_ffn_in + (size_t)l * D * 2 * FH, D, 2 * FH, t / 88, t % 88, (u16*)(p.ws + OFF_WF1), 1, 2 * FH, lds); return; }
  t -= 704;
  conv_tile(p.w_ffn_out + (size_t)l * FH * D, FH, D, t / 16, t % 16, (u16*)(p.ws + OFF_WF2), 0, D, lds);
}

DI void task_norm(const Params& p, int l, int task, int which) {
  const int lane = threadIdx.x & 63, wave = threadIdx.x >> 6;
  const int row0 = task * 16 + wave * 4;
  const float* g = (which == 0 ? p.norm_mix : p.norm_ffn) + l * D;
  const float* md = modp(p, l, row0) + (which ? 3 * D : 0);
  float4 v[4][4];
#pragma unroll
  for (int r = 0; r < 4; r++) {
    const float* xr = which == 0 ? xsrc(p, l, row0 + r) : (const float*)xdst(p, row0 + r);
#pragma unroll
    for (int i = 0; i < 4; i++) v[r][i] = *(const float4*)(xr + i * 256 + lane * 4);
  }
  float rstd[4];
#pragma unroll
  for (int r = 0; r < 4; r++) {
    float ss = 0.f;
#pragma unroll
    for (int i = 0; i < 4; i++) ss += v[r][i].x * v[r][i].x + v[r][i].y * v[r][i].y + v[r][i].z * v[r][i].z + v[r][i].w * v[r][i].w;
    ss = wave_sum(ss);
    rstd[r] = rsqrtf(ss * (1.0f / 1024.0f) + 1e-6f);
  }
  u16* hb = (u16*)(p.ws + OFF_HB) + (size_t)row0 * 32;
#pragma unroll
  for (int i = 0; i < 4; i++) {
    const int cidx = i * 256 + lane * 4;
    const float4 gg = *(const float4*)(g + cidx), sh = *(const float4*)(md + cidx), sc = *(const float4*)(md + D + cidx);
    const float a0 = gg.x * (1.f + sc.x), a1 = gg.y * (1.f + sc.y), a2 = gg.z * (1.f + sc.z), a3 = gg.w * (1.f + sc.w);
#pragma unroll
    for (int r = 0; r < 4; r++) {
      uint2 o;
      o.x = pack2(v[r][i].x * rstd[r] * a0 + sh.x, v[r][i].y * rstd[r] * a1 + sh.y);
      o.y = pack2(v[r][i].z * rstd[r] * a2 + sh.z, v[r][i].w * rstd[r] * a3 + sh.w);
      *(uint2*)(hb + (size_t)(cidx >> 5) * NTOK * 32 + r * 32 + (cidx & 31)) = o;
    }
  }
}
DI void task_final_norm(const Params& p, int task) {
  const int lane = threadIdx.x & 63, wave = threadIdx.x >> 6;
  float* xr = p.out + (size_t)(task * 16 + wave * 4) * D;
  float4 v[4][4];
#pragma unroll
  for (int r = 0; r < 4; r++)
#pragma unroll
    for (int i = 0; i < 4; i++) v[r][i] = *(const float4*)(xr + (size_t)r * D + i * 256 + lane * 4);
  float rstd[4];
#pragma unroll
  for (int r = 0; r < 4; r++) {
    float ss = 0.f;
#pragma unroll
    for (int i = 0; i < 4; i++) ss += v[r][i].x * v[r][i].x + v[r][i].y * v[r][i].y + v[r][i].z * v[r][i].z + v[r][i].w * v[r][i].w;
    ss = wave_sum(ss);
    rstd[r] = rsqrtf(ss * (1.0f / 1024.0f) + 1e-6f);
  }
#pragma unroll
  for (int i = 0; i < 4; i++) {
    const int cidx = i * 256 + lane * 4;
    const float4 gg = *(const float4*)(p.final_norm + cidx);
#pragma unroll
    for (int r = 0; r < 4; r++) {
      float4 o = {v[r][i].x * rstd[r] * gg.x, v[r][i].y * rstd[r] * gg.y, v[r][i].z * rstd[r] * gg.z, v[r][i].w * rstd[r] * gg.w};
      *(float4*)(xr + (size_t)r * D + cidx) = o;
    }
  }
}

DI void task_g1(const Params& p, int l, int tile, char* lds) {
  const int mt = tile / 15, nt = tile % 15;
  const int tid = threadIdx.x, lane = tid & 63, wave = tid >> 6;
  const int wm = wave >> 1, wn = wave & 1, g = lane >> 4, n = lane & 15;
  f32x4 acc[4][8];
#pragma unroll
  for (int i = 0; i < 4; i++)
#pragma unroll
    for (int j = 0; j < 8; j++) acc[i][j] = f32x4{0.f, 0.f, 0.f, 0.f};
  gemm_wide((const u16*)(p.ws + OFF_HB) + (size_t)mt * 128 * 32, NTOK, (const u16*)(p.ws + OFF_WIN) + (size_t)nt * 256 * 32, INTP, D, acc, lds);
  const int cw = nt * 256 + wn * 128;
  const int rw = mt * 128 + wm * 64;
  if (mt < 128) {
    const float* rc = (const float*)(p.ws + OFF_ROPE);
    const float* rs = rc + SEQ * 32;
#pragma unroll
    for (int hh = 0; hh < 2; hh++) {
      if (cw + hh * 64 >= 640) continue;
#pragma unroll
      for (int mi = 0; mi < 4; mi++)
#pragma unroll
        for (int ni = 0; ni < 2; ni++)
#pragma unroll
          for (int r = 0; r < 4; r++) {
            int t = (rw + mi * 16 + 4 * g + r) & 4095;
            float c = rc[t * 32 + ni * 16 + n], sn = rs[t * 32 + ni * 16 + n];
            float x1 = acc[mi][hh * 4 + ni][r], x2 = acc[mi][hh * 4 + ni + 2][r];
            acc[mi][hh * 4 + ni][r] = x1 * c - x2 * sn;
            acc[mi][hh * 4 + ni + 2][r] = x1 * sn + x2 * c;
          }
    }
  }
  u16* PN = (u16*)(p.ws + OFF_PN);
  u16* VT = (u16*)(p.ws + OFF_VT);
  u16* VTc = (u16*)(p.ws + OFF_VTC);
#pragma unroll
  for (int ni = 0; ni < 8; ni++) {
    const int c16 = cw + ni * 16;
    if (c16 >= INT) continue;
    int tr = -1, nat = 0;
    if (c16 < 640) nat = c16;
    else if (c16 < 768) tr = c16 - 640;
    else if (c16 < 1280) nat = c16 - 128;
    else if (c16 < 1792) tr = 128 + c16 - 1280;
    else if (c16 < 3360) nat = c16 - 640;
    else tr = 640 + c16 - 3360;
#pragma unroll
    for (int mi = 0; mi < 4; mi++) {
      const int row0 = rw + mi * 16 + 4 * g;
      if (tr < 0) {
#pragma unroll
        for (int r = 0; r < 4; r++) PN[(size_t)(row0 + r) * PNLD + nat + n] = f2bf(acc[mi][ni][r]);
      } else {
        uint2 o; o.x = pack2(acc[mi][ni][0], acc[mi][ni][1]); o.y = pack2(acc[mi][ni][2], acc[mi][ni][3]);
        if (mt < 128) {
          int b = row0 >> 12, tok = row0 & 4095;
          *(uint2*)(VT + ((size_t)(b * VTR + tr + n)) * SEQ + tok) = o;
        } else {
          int rr = row0 - NLAT, b = rr >> 8, tok = rr & 255;
          *(uint2*)(VTc + ((size_t)(b * VTR + tr + n)) * LC + tok) = o;
        }
      }
    }
  }
}

DI void task_g1_tail(const Params& p, int l, int mt, char* lds) {
  const int tid = threadIdx.x, lane = tid & 63, wave = tid >> 6;
  const int wm = wave >> 1, wn = wave & 1, g = lane >> 4, n = lane & 15;
  f32x4 acc[4][2];
  zero_acc<2>(acc);
  gemm_tile<2, 1>((const u16*)(p.ws + OFF_HB) + (size_t)mt * 128 * 32, NTOK, (const u16*)(p.ws + OFF_WIN) + (size_t)3840 * 32, INTP, D, acc, lds);
  if (wn != 0) return;
  u16* VT = (u16*)(p.ws + OFF_VT);
  u16* VTc = (u16*)(p.ws + OFF_VTC);
#pragma unroll
  for (int ni = 0; ni < 2; ni++) {
    const int tr = 640 + (3840 - 3360) + ni * 16;
#pragma unroll
    for (int mi = 0; mi < 4; mi++) {
      const int row0 = mt * 128 + wm * 64 + mi * 16 + 4 * g;
      uint2 o; o.x = pack2(acc[mi][ni][0], acc[mi][ni][1]); o.y = pack2(acc[mi][ni][2], acc[mi][ni][3]);
      if (mt < 128) {
        int b = row0 >> 12, tok = row0 & 4095;
        *(uint2*)(VT + ((size_t)(b * VTR + tr + n)) * SEQ + tok) = o;
      } else {
        int rr = row0 - NLAT, b = rr >> 8, tok = rr & 255;
        *(uint2*)(VTc + ((size_t)(b * VTR + tr + n)) * LC + tok) = o;
      }
    }
  }
}

constexpr float QSC = 0.125f * LOG2E;

template <class QF, class OF, class M0F, class TileFn, class ScoreFn, class SkipFn>
DI void attn_core4(QF qptr, OF optr, M0F m0f, float l0, int ntiles, TileFn tilefn, ScoreFn scorefn, SkipFn skipfn) {
  const int lane = threadIdx.x & 63, g = lane >> 4, n = lane & 15;
  bf16x8 qf[4][2];
  f32x4 o[4][4];
  float m[4], ls[4];
#pragma unroll
  for (int gi = 0; gi < 4; gi++) {
    const u16* q = qptr(gi);
    qf[gi][0] = *(const bf16x8*)(q + (size_t)n * PNLD + g * 8);
    qf[gi][1] = *(const bf16x8*)(q + (size_t)n * PNLD + 32 + g * 8);
#pragma unroll
    for (int i = 0; i < 4; i++) o[gi][i] = f32x4{0.f, 0.f, 0.f, 0.f};
    m[gi] = m0f(gi);
    ls[gi] = (g == 0) ? l0 : 0.f;
  }
  const u16* kp; const u16* vp; int vld, aux;
  tilefn(0, kp, vp, vld, aux);
  bf16x8 kn0, kn1, kn2, kn3;
  s16x4 vn0, vn1, vn2, vn3, vn4, vn5, vn6, vn7;
#define LOADK()                                                                     \
  {                                                                                 \
    const u16* kr = kp + (size_t)n * PNLD + g * 8;                                  \
    kn0 = *(const bf16x8*)(kr); kn1 = *(const bf16x8*)(kr + (size_t)16 * PNLD);     \
    kn2 = *(const bf16x8*)(kr + 32); kn3 = *(const bf16x8*)(kr + (size_t)16 * PNLD + 32); \
  }
#define LOADV()                                                                     \
  {                                                                                 \
    const u16* vr = vp + (size_t)n * vld + 4 * g;                                   \
    vn0 = *(const s16x4*)(vr); vn1 = *(const s16x4*)(vr + 16);                      \
    vn2 = *(const s16x4*)(vr + (size_t)16 * vld); vn3 = *(const s16x4*)(vr + (size_t)16 * vld + 16); \
    vn4 = *(const s16x4*)(vr + (size_t)32 * vld); vn5 = *(const s16x4*)(vr + (size_t)32 * vld + 16); \
    vn6 = *(const s16x4*)(vr + (size_t)48 * vld); vn7 = *(const s16x4*)(vr + (size_t)48 * vld + 16); \
  }
  LOADK();
  LOADV();
#pragma unroll 1
  for (int t = 0; t < ntiles; t++) {
    const int auxc = aux;
    const bool more = t + 1 < ntiles;
    bf16x8 vf[4];
    vf[0] = __builtin_shufflevector(vn0, vn1, 0, 1, 2, 3, 4, 5, 6, 7);
    vf[1] = __builtin_shufflevector(vn2, vn3, 0, 1, 2, 3, 4, 5, 6, 7);
    vf[2] = __builtin_shufflevector(vn4, vn5, 0, 1, 2, 3, 4, 5, 6, 7);
    vf[3] = __builtin_shufflevector(vn6, vn7, 0, 1, 2, 3, 4, 5, 6, 7);
#pragma unroll
    for (int hf = 0; hf < 2; hf++) {
      f32x4 s0[2], s1[2];
#pragma unroll
      for (int gg = 0; gg < 2; gg++) {
        const int gi = hf * 2 + gg;
        s0[gg] = f32x4{0.f, 0.f, 0.f, 0.f}; s1[gg] = f32x4{0.f, 0.f, 0.f, 0.f};
        if (skipfn(gi, auxc)) continue;
        s0[gg] = MFMA16(kn0, qf[gi][0], s0[gg]); s1[gg] = MFMA16(kn1, qf[gi][0], s1[gg]);
        s0[gg] = MFMA16(kn2, qf[gi][1], s0[gg]); s1[gg] = MFMA16(kn3, qf[gi][1], s1[gg]);
      }
      if (hf == 1 && more) { tilefn(t + 1, kp, vp, vld, aux); LOADK(); }
#pragma unroll
      for (int gg = 0; gg < 2; gg++) {
        const int gi = hf * 2 + gg;
        if (skipfn(gi, auxc)) continue;
        float sc[8];
#pragma unroll
        for (int r = 0; r < 4; r++) {
          sc[r] = scorefn(gi, auxc, 4 * g + r, n, s0[gg][r]);
          sc[4 + r] = scorefn(gi, auxc, 16 + 4 * g + r, n, s1[gg][r]);
        }
        float mx = fmaxf(fmaxf(fmaxf(sc[0], sc[1]), fmaxf(sc[2], sc[3])), fmaxf(fmaxf(sc[4], sc[5]), fmaxf(sc[6], sc[7])));
        mx = fmaxf(mx, __shfl_xor(mx, 16, 64));
        mx = fmaxf(mx, __shfl_xor(mx, 32, 64));
        const float mn = fmaxf(m[gi], mx);
        const float alpha = __builtin_amdgcn_exp2f(m[gi] - mn);
        float pv[8], ps = 0.f;
#pragma unroll
        for (int r = 0; r < 8; r++) { pv[r] = __builtin_amdgcn_exp2f(sc[r] - mn); ps += pv[r]; }
        ls[gi] = ls[gi] * alpha + ps;
        m[gi] = mn;
        union { bf16x8 v; unsigned u[4]; } pf;
        pf.u[0] = pack2(pv[0], pv[1]); pf.u[1] = pack2(pv[2], pv[3]); pf.u[2] = pack2(pv[4], pv[5]); pf.u[3] = pack2(pv[6], pv[7]);
#pragma unroll
        for (int d4 = 0; d4 < 4; d4++) {
          o[gi][d4] *= alpha;
          o[gi][d4] = MFMA16(vf[d4], pf.v, o[gi][d4]);
        }
      }
    }
    if (more) LOADV();
  }
#undef LOADK
#undef LOADV
#pragma unroll
  for (int gi = 0; gi < 4; gi++) {
    float lsum = ls[gi];
    lsum += __shfl_xor(lsum, 16, 64);
    lsum += __shfl_xor(lsum, 32, 64);
    const float inv = 1.0f / lsum;
    u16* ob = optr(gi);
#pragma unroll
    for (int d4 = 0; d4 < 4; d4++) {
      uint2 w; w.x = pack2(o[gi][d4][0] * inv, o[gi][d4][1] * inv); w.y = pack2(o[gi][d4][2] * inv, o[gi][d4][3] * inv);
      *(uint2*)(ob + (size_t)n * 512 + d4 * 16 + 4 * g) = w;
    }
  }
}

DI void attn_a_latent(const Params& p, int l, int wt) {
  wt = __builtin_amdgcn_readfirstlane(wt);
  const int kvh = wt & 1, qt = (wt >> 1) & 255, b = wt >> 9, q0 = qt * 16;
  const u16* PN = (const u16*)(p.ws + OFF_PN);
  const u16* VT = (const u16*)(p.ws + OFF_VT);
  const u16* VTc = (const u16*)(p.ws + OFF_VTC);
  int jlo = (q0 - 128) & ~31; if (jlo < 0) jlo = 0;
  int jhi = (q0 + 144 + 31) & ~31; if (jhi > SEQ) jhi = SEQ;
  const int ntiles = 8 + (jhi - jlo) / 32;
  const u16* kc = PN + (size_t)(NLAT + b * LC) * PNLD + 512 + kvh * 64;
  const u16* kl = PN + (size_t)(b * SEQ) * PNLD + 512 + kvh * 64;
  const u16* vc = VTc + (size_t)(b * VTR + kvh * 64) * LC;
  const u16* vl = VT + (size_t)(b * VTR + kvh * 64) * SEQ;
  const u16* qb = PN + (size_t)(b * SEQ + q0) * PNLD + kvh * 256;
  u16* ob = (u16*)(p.ws + OFF_Y) + (size_t)(b * SEQ + q0) * 512 + kvh * 256;
  const float* sk = p.sink + l * 8 + kvh * 4;
  auto tilefn = [&](int t, const u16*& kp, const u16*& vp, int& vld, int& aux) {
    if (t < 8) { kp = kc + (size_t)(t * 32) * PNLD; vp = vc + t * 32; vld = LC; aux = -1; }
    else { int j0 = jlo + (t - 8) * 32; kp = kl + (size_t)j0 * PNLD; vp = vl + j0; vld = SEQ; aux = j0; }
  };
  auto scorefn = [&](int gi, int aux, int kidx, int n, float dot) -> float {
    float s = dot * QSC;
    if (aux >= 0) { int dj = aux + kidx - (q0 + n); if (dj > 128 || dj < -128) s = -INFINITY; }
    return s;
  };
  attn_core4([&](int gi) { return qb + gi * 64; }, [&](int gi) { return ob + gi * 64; }, [&](int gi) { return sk[gi] * LOG2E; }, 1.0f,
             ntiles, tilefn, scorefn, [&](int gi, int aux) { return false; });
}

DI void attn_c_latent(const Params& p, int l, int wt, char* lds) {
  wt = __builtin_amdgcn_readfirstlane(wt);
  const int head = wt & 7, r = (wt >> 3) & 63, b = wt >> 9;
  const u16* PN = (const u16*)(p.ws + OFF_PN);
  const u16* VT = (const u16*)(p.ws + OFF_VT);
  const u16* VTc = (const u16*)(p.ws + OFF_VTC);
  int rs = r - 4; rs = rs < 0 ? 0 : (rs > 56 ? 56 : rs);
  const int tok0 = b * SEQ + r * 64;
  const u16* kc = PN + (size_t)(NLAT + b * LC) * PNLD + 2208 + head * 64;
  const u16* kl = PN + (size_t)(b * SEQ) * PNLD + 2208 + head * 64;
  const u16* vc = VTc + (size_t)(b * VTR + 640 + head * 64) * LC;
  const u16* vl = VT + (size_t)(b * VTR + 640 + head * 64) * SEQ;
  float* rpb = (float*)(lds + (threadIdx.x >> 6) * 2048);
  {
    const float* src = p.rpb + (size_t)(l * 8 + head) * 15 * 31;
    const int lane_ = threadIdx.x & 63;
    for (int i = lane_; i < 465; i += 64) rpb[i] = src[i] * LOG2E;
  }
  const u16* qb = PN + (size_t)tok0 * PNLD + 1696 + head * 64;
  u16* ob = (u16*)(p.ws + OFF_Y) + (size_t)2 * NTOK * 512 + (size_t)tok0 * 512 + head * 64;
  auto tilefn = [&](int t, const u16*& kp, const u16*& vp, int& vld, int& aux) {
    if (t < 8) { kp = kc + (size_t)(t * 32) * PNLD; vp = vc + t * 32; vld = LC; aux = -1; }
    else { int a = t - 8; int tk = (rs + (a >> 1)) * 64 + (a & 1) * 32; kp = kl + (size_t)tk * PNLD; vp = vl + tk; vld = SEQ; aux = a; }
  };
  auto scorefn = [&](int gi, int aux, int kidx, int n, float dot) -> float {
    float s = dot * QSC;
    if (aux >= 0) {
      int kcol = (aux & 1) * 32 + kidx, qcol = gi * 16 + n;
      int wsx = qcol - 8; wsx = wsx < 0 ? 0 : (wsx > 48 ? 48 : wsx);
      int drow = rs + (aux >> 1) - r + 7;
      int dc = kcol - qcol; dc = dc < -15 ? -15 : (dc > 15 ? 15 : dc);
      float bias = rpb[drow * 31 + dc + 15];
      s = (kcol >= wsx && kcol < wsx + 16) ? s + bias : -INFINITY;
    }
    return s;
  };
  attn_core4([&](int gi) { return qb + (size_t)gi * 16 * PNLD; }, [&](int gi) { return ob + (size_t)gi * 16 * 512; },
             [&](int gi) { return -INFINITY; }, 0.0f, 24, tilefn, scorefn,
             [&](int gi, int aux) { return aux >= 0 && ((gi == 0 && (aux & 1)) || (gi == 3 && !(aux & 1))); });
}

DI void attn_ctx(const Params& p, int l, int wt, int which) {
  wt = __builtin_amdgcn_readfirstlane(wt);
  const u16* PN = (const u16*)(p.ws + OFF_PN);
  const u16* VTc = (const u16*)(p.ws + OFF_VTC);
  if (which == 0) {
    const int kvh = wt & 1, qt = (wt >> 1) & 15, b = wt >> 5;
    const int row0 = NLAT + b * LC + qt * 16;
    const u16* kc = PN + (size_t)(NLAT + b * LC) * PNLD + 512 + kvh * 64;
    const u16* vc = VTc + (size_t)(b * VTR + kvh * 64) * LC;
    const u16* qb = PN + (size_t)row0 * PNLD + kvh * 256;
    u16* ob = (u16*)(p.ws + OFF_Y) + (size_t)row0 * 512 + kvh * 256;
    const float* sk = p.sink + l * 8 + kvh * 4;
    attn_core4([&](int gi) { return qb + gi * 64; }, [&](int gi) { return ob + gi * 64; }, [&](int gi) { return sk[gi] * LOG2E; }, 1.0f, 8,
               [&](int t, const u16*& kp, const u16*& vp, int& vld, int& aux) { kp = kc + (size_t)(t * 32) * PNLD; vp = vc + t * 32; vld = LC; aux = -1; },
               [&](int gi, int aux, int kidx, int n, float dot) -> float { return dot * QSC; }, [&](int gi, int aux) { return false; });
  } else {
    const int head = wt & 7, q4 = (wt >> 3) & 3, b = wt >> 5;
    const int row0 = NLAT + b * LC + q4 * 64;
    const u16* kc = PN + (size_t)(NLAT + b * LC) * PNLD + 2208 + head * 64;
    const u16* vc = VTc + (size_t)(b * VTR + 640 + head * 64) * LC;
    const u16* qb = PN + (size_t)row0 * PNLD + 1696 + head * 64;
    u16* ob = (u16*)(p.ws + OFF_Y) + (size_t)2 * NTOK * 512 + (size_t)row0 * 512 + head * 64;
    attn_core4([&](int gi) { return qb + (size_t)gi * 16 * PNLD; }, [&](int gi) { return ob + (size_t)gi * 16 * 512; },
               [&](int gi) { return -INFINITY; }, 0.0f, 8,
               [&](int t, const u16*& kp, const u16*& vp, int& vld, int& aux) { kp = kc + (size_t)(t * 32) * PNLD; vp = vc + t * 32; vld = LC; aux = -1; },
               [&](int gi, int aux, int kidx, int n, float dot) -> float { return dot * QSC; }, [&](int gi, int aux) { return false; });
  }
}

constexpr int G_QS = 0, G_KS = 9216, G_KT = 18432, G_VT = 27648, G_ZL = 36864, G_TOT = 40960, G_DEC = 41984, G_END = 42240;
constexpr int NE = 4;
constexpr size_t OFF_SL = OFF_Y + (size_t)2 * NTOK * 512 * 2;
constexpr size_t OFF_DS = OFF_PAD + (524288u);

template <int PASS>
DI void task_gla(const Params& p, int l, int id, char* lds) {
  int seg, rest;
  if (PASS == 1) { seg = id & 15; rest = id >> 4; } else { seg = 16 - (id % 17); rest = id / 17; }
  const int sl = rest & 1, dir = (rest >> 1) & 1, h = (rest >> 2) & 3, b = rest >> 4, combo = rest >> 1;
  const int tid = threadIdx.x, lane = tid & 63, wave = tid >> 6, g = lane >> 4, n = lane & 15;
  const u16* PN = (const u16*)(p.ws + OFF_PN);
  u16* odst = dir ? (u16*)(p.ws + OFF_OB) : (u16*)(p.ws + OFF_Y) + (size_t)NTOK * 512;
  float* SL = (float*)(p.ws + OFF_SL);
  float* DS = (float*)(p.ws + OFF_DS);
  const float* gwp = (dir ? p.gw_b : p.gw_f) + (size_t)l * 16 * 256 + h * 64 + lane;
  const float* gbp = (dir ? p.gb_b : p.gb_f) + l * 256 + h * 64 + lane;
  f32x4 S[4][NE];
#pragma unroll
  for (int i = 0; i < 4; i++)
#pragma unroll
    for (int j = 0; j < NE; j++) S[i][j] = f32x4{0.f, 0.f, 0.f, 0.f};
  if (PASS == 2) {
    const float* sl_src = SL + ((size_t)(rest * 17 + seg)) * (1024 * NE) + lane * 4;
#pragma unroll
    for (int dt = 0; dt < 4; dt++)
#pragma unroll
      for (int et = 0; et < NE; et++) S[dt][et] = *(const f32x4*)(sl_src + (dt * NE + et) * 256);
  }
  float* ZL = (float*)(lds + G_ZL);
  float* TOT = (float*)(lds + G_TOT);
  float* DEC = (float*)(lds + G_DEC);
  float totsum = 0.f;

  int tb = 0, rowbase = 0;
  uint4 rq0, rq1, rk0, rk1, rz, rv, rv2;
  rq0 = rq1 = rz = uint4{0, 0, 0, 0};
  auto gload = [&](int ch) {
    int vld; const u16* vsrc;
    if (ch < 4) {
      tb = dir ? 192 - 64 * ch : 64 * ch; rowbase = NLAT + b * LC; vld = LC;
      vsrc = (const u16*)(p.ws + OFF_VTC) + (size_t)(b * VTR + 128 + h * 128 + sl * 64) * LC;
    } else {
      tb = dir ? SEQ - 64 * (ch - 3) : 64 * (ch - 4); rowbase = b * SEQ; vld = SEQ;
      vsrc = (const u16*)(p.ws + OFF_VT) + (size_t)(b * VTR + 128 + h * 128 + sl * 64) * SEQ;
    }
    {
      int row = tid >> 3, kc = tid & 7;
      int tok0 = dir ? tb + 63 - row : tb + row, tok1 = dir ? tb + 31 - row : tb + 32 + row;
      const u16* s0 = PN + (size_t)(rowbase + tok0) * PNLD + h * 64 + kc * 8;
      const u16* s1 = PN + (size_t)(rowbase + tok1) * PNLD + h * 64 + kc * 8;
      if (PASS == 2) { rq0 = *(const uint4*)(s0 + 640); rq1 = *(const uint4*)(s1 + 640); }
      rk0 = *(const uint4*)(s0 + 896); rk1 = *(const uint4*)(s1 + 896);
    }
    if (tid < 128) {
      int row = tid >> 1, hc = tid & 1;
      int tok = dir ? tb + 63 - row : tb + row;
      rz = *(const uint4*)(PN + (size_t)(rowbase + tok) * PNLD + 1664 + dir * 16 + hc * 8);
    }
    rv = *(const uint4*)(vsrc + (size_t)(tid >> 3) * vld + tb + (tid & 7) * 8);
    rv2 = *(const uint4*)(vsrc + (size_t)(32 + (tid >> 3)) * vld + tb + (tid & 7) * 8);
  };
  gload(seg * 4);

  for (int ci = 0; ci < 4; ci++) {
    const int ctb = tb, crowbase = rowbase;
    float gw[16];
#pragma unroll
    for (int r = 0; r < 16; r++) gw[r] = gwp[r * 256];
    const float gbias = gbp[0];
    __syncthreads();
    {
      int row = tid >> 3, kc = tid & 7;
      if (PASS == 2) {
        *(uint4*)(lds + G_QS + row * LROW + kc * 16) = rq0;
        *(uint4*)(lds + G_QS + (row + 32) * LROW + kc * 16) = rq1;
      }
      *(uint4*)(lds + G_KS + row * LROW + kc * 16) = rk0;
      *(uint4*)(lds + G_KS + (row + 32) * LROW + kc * 16) = rk1;
    }
    if (tid < 128) {
      int row = tid >> 1, hc = tid & 1;
      float* zd = ZL + row * 16 + hc * 8;
      zd[0] = __uint_as_float(rz.x << 16); zd[1] = __uint_as_float(rz.x & 0xffff0000u);
      zd[2] = __uint_as_float(rz.y << 16); zd[3] = __uint_as_float(rz.y & 0xffff0000u);
      zd[4] = __uint_as_float(rz.z << 16); zd[5] = __uint_as_float(rz.z & 0xffff0000u);
      zd[6] = __uint_as_float(rz.w << 16); zd[7] = __uint_as_float(rz.w & 0xffff0000u);
    }
    {
      int e = tid >> 3, kc = tid & 7;
      if (dir) {
        uint4 rr;
        rr.x = (rv.w >> 16) | (rv.w << 16); rr.y = (rv.z >> 16) | (rv.z << 16);
        rr.z = (rv.y >> 16) | (rv.y << 16); rr.w = (rv.x >> 16) | (rv.x << 16);
        *(uint4*)(lds + G_VT + e * LROW + (7 - kc) * 16) = rr;
        rr.x = (rv2.w >> 16) | (rv2.w << 16); rr.y = (rv2.z >> 16) | (rv2.z << 16);
        rr.z = (rv2.y >> 16) | (rv2.y << 16); rr.w = (rv2.x >> 16) | (rv2.x << 16);
        *(uint4*)(lds + G_VT + (32 + e) * LROW + (7 - kc) * 16) = rr;
      } else {
        *(uint4*)(lds + G_VT + e * LROW + kc * 16) = rv;
        *(uint4*)(lds + G_VT + (32 + e) * LROW + kc * 16) = rv2;
      }
    }
    __syncthreads();
    float bv[16];
    {
      float run = 0.f;
#pragma unroll
      for (int tt = 0; tt < 16; tt++) {
        const float4* zr = (const float4*)(ZL + (wave * 16 + tt) * 16);
        float z = gbias;
#pragma unroll
        for (int q = 0; q < 4; q++) {
          float4 zz = zr[q];
          z += zz.x * gw[q * 4 + 0] + zz.y * gw[q * 4 + 1] + zz.z * gw[q * 4 + 2] + zz.w * gw[q * 4 + 3];
        }
        float lsg = fminf(z, 0.f) - __logf(1.0f + __expf(-fabsf(z)));
        run += lsg * (1.0f / 16.0f);
        bv[tt] = run;
      }
      TOT[wave * 64 + lane] = run;
    }
    __syncthreads();
    {
      float off = 0.f, tot = 0.f;
#pragma unroll
      for (int s = 0; s < 4; s++) { float tv = TOT[s * 64 + lane]; if (s < wave) off += tv; tot += tv; }
      totsum += tot;
      const float dtot = __expf(tot);
      if (wave == 0) DEC[lane] = dtot;
      unsigned ktp[8];
#pragma unroll
      for (int tt = 0; tt < 16; tt++) {
        const int t = wave * 16 + tt;
        const float bq = bv[tt] + off;
        u16* ka = (u16*)(lds + G_KS + t * LROW) + lane;
        const float kv = bf2f(*ka);
        const float e1 = __expf(bq), e2 = __builtin_amdgcn_rcpf(e1);
        if (PASS == 2) {
          u16* qa = (u16*)(lds + G_QS + t * LROW) + lane;
          const float qv = bf2f(*qa);
          *qa = f2bf(qv * 0.125f * e1);
          *ka = f2bf(kv * e2);
        }
        const unsigned kt = f2bf(kv * (dtot * e2));
        if (tt & 1) ktp[tt >> 1] |= kt << 16; else ktp[tt >> 1] = kt;
      }
      uint4* kd = (uint4*)(lds + G_KT + lane * LROW + wave * 32);
      kd[0] = uint4{ktp[0], ktp[1], ktp[2], ktp[3]};
      kd[1] = uint4{ktp[4], ktp[5], ktp[6], ktp[7]};
    }
    __syncthreads();
    if (ci < 3) gload(seg * 4 + ci + 1);
    if (PASS == 2) {
      bf16x8 qf[2];
      qf[0] = *(const bf16x8*)(lds + G_QS + (wave * 16 + n) * LROW + g * 16);
      qf[1] = *(const bf16x8*)(lds + G_QS + (wave * 16 + n) * LROW + 64 + g * 16);
      f32x4 X[4];
#pragma unroll
      for (int jt = 0; jt < 4; jt++) {
        X[jt] = f32x4{0.f, 0.f, 0.f, 0.f};
#pragma unroll
        for (int s = 0; s < 2; s++) {
          bf16x8 kf = *(const bf16x8*)(lds + G_KS + (jt * 16 + n) * LROW + s * 64 + g * 16);
          X[jt] = MFMA16(kf, qf[s], X[jt]);
        }
#pragma unroll
        for (int r = 0; r < 4; r++) if (jt * 16 + 4 * g + r > wave * 16 + n) X[jt][r] = 0.f;
      }
      f32x4 o[NE];
#pragma unroll
      for (int et = 0; et < NE; et++) o[et] = f32x4{0.f, 0.f, 0.f, 0.f};
#pragma unroll
      for (int kk = 0; kk < 2; kk++) {
        union { bf16x8 v; unsigned u[4]; } pa;
        pa.u[0] = pack2(X[2 * kk][0], X[2 * kk][1]); pa.u[1] = pack2(X[2 * kk][2], X[2 * kk][3]);
        pa.u[2] = pack2(X[2 * kk + 1][0], X[2 * kk + 1][1]); pa.u[3] = pack2(X[2 * kk + 1][2], X[2 * kk + 1][3]);
        const char* qr = lds + G_QS + (wave * 16 + n) * LROW + kk * 64 + g * 8;
        s16x4 qa = *(const s16x4*)(qr), qb = *(const s16x4*)(qr + 32);
        bf16x8 qp = __builtin_shufflevector(qa, qb, 0, 1, 2, 3, 4, 5, 6, 7);
#pragma unroll
        for (int et = 0; et < NE; et++) {
          const char* vr = lds + G_VT + (et * 16 + n) * LROW + kk * 64 + g * 8;
          s16x4 va = *(const s16x4*)(vr), vb = *(const s16x4*)(vr + 32);
          bf16x8 vf = __builtin_shufflevector(va, vb, 0, 1, 2, 3, 4, 5, 6, 7);
          o[et] = MFMA16(pa.v, vf, o[et]);
          union { bf16x8 v; unsigned u[4]; } sb;
          sb.u[0] = pack2(S[2 * kk][et][0], S[2 * kk][et][1]); sb.u[1] = pack2(S[2 * kk][et][2], S[2 * kk][et][3]);
          sb.u[2] = pack2(S[2 * kk + 1][et][0], S[2 * kk + 1][et][1]); sb.u[3] = pack2(S[2 * kk + 1][et][2], S[2 * kk + 1][et][3]);
          o[et] = MFMA16(qp, sb.v, o[et]);
        }
      }
#pragma unroll
      for (int r = 0; r < 4; r++) {
        int i = wave * 16 + 4 * g + r;
        int tok = dir ? ctb + 63 - i : ctb + i;
        u16* orow = odst + (size_t)(crowbase + tok) * 512 + h * 128 + sl * 64 + n;
#pragma unroll
        for (int et = 0; et < NE; et++) orow[et * 16] = f2bf(o[et][r]);
      }
    }
    if (PASS == 1 || ci < 3) {
      bf16x8 vfr[NE][2];
#pragma unroll
      for (int et = 0; et < NE; et++)
#pragma unroll
        for (int s = 0; s < 2; s++) vfr[et][s] = *(const bf16x8*)(lds + G_VT + (et * 16 + n) * LROW + s * 64 + g * 16);
#pragma unroll
      for (int dt = 0; dt < 4; dt++) {
        bf16x8 kf0 = *(const bf16x8*)(lds + G_KT + (dt * 16 + n) * LROW + g * 16);
        bf16x8 kf1 = *(const bf16x8*)(lds + G_KT + (dt * 16 + n) * LROW + 64 + g * 16);
        const f32x4 dc = *(const f32x4*)(DEC + dt * 16 + 4 * g);
#pragma unroll
        for (int et = 0; et < NE; et++) {
          f32x4 u = {0.f, 0.f, 0.f, 0.f};
          u = MFMA16(kf0, vfr[et][0], u);
          u = MFMA16(kf1, vfr[et][1], u);
          S[dt][et] = S[dt][et] * dc + u;
        }
      }
    }
  }
  if (PASS == 1 && wave == 0) {
    float* dst = SL + ((size_t)(rest * 17 + seg)) * (1024 * NE) + lane * 4;
#pragma unroll
    for (int dt = 0; dt < 4; dt++)
#pragma unroll
      for (int et = 0; et < NE; et++) *(f32x4*)(dst + (dt * NE + et) * 256) = S[dt][et];
    if (sl == 0) DS[(size_t)(combo * 17 + seg) * 64 + lane] = totsum;
  }
}

DI void task_gla_prefix(const Params& p, int rest) {
  const int tid = threadIdx.x, combo = rest >> 1;
  constexpr int SSZ = 1024 * NE;
  float* SL = (float*)(p.ws + OFF_SL) + (size_t)rest * 17 * SSZ + tid * 16;
  const int tile = tid >> 4, g4 = (tid & 15) >> 2;
  const float* DS = (const float*)(p.ws + OFF_DS) + (size_t)combo * 17 * 64 + (tile / NE) * 16 + 4 * g4;
  f32x4 s0 = {0.f, 0.f, 0.f, 0.f}, s1 = s0, s2 = s0, s3 = s0;
#pragma unroll 2
  for (int seg = 0; seg < 16; seg++) {
    float* q = SL + (size_t)seg * SSZ;
    const f32x4 c0 = *(const f32x4*)(q), c1 = *(const f32x4*)(q + 4), c2 = *(const f32x4*)(q + 8), c3 = *(const f32x4*)(q + 12);
    const f32x4 dl = *(const f32x4*)(DS + seg * 64);
    *(f32x4*)(q) = s0; *(f32x4*)(q + 4) = s1; *(f32x4*)(q + 8) = s2; *(f32x4*)(q + 12) = s3;
    const f32x4 dc = {__expf(dl[0]), __expf(dl[1]), __expf(dl[2]), __expf(dl[3])};
    s0 = s0 * dc + c0; s1 = s1 * dc + c1; s2 = s2 * dc + c2; s3 = s3 * dc + c3;
  }
  float* q = SL + (size_t)16 * SSZ;
  *(f32x4*)(q) = s0; *(f32x4*)(q + 4) = s1; *(f32x4*)(q + 8) = s2; *(f32x4*)(q + 12) = s3;
}

DI void task_gla_out(const Params& p, int l, int task) {
  const int lane = threadIdx.x & 63, wave = threadIdx.x >> 6;
  const int row0 = task * 16 + wave * 4;
  u16* of = (u16*)(p.ws + OFF_Y) + (size_t)NTOK * 512 + (size_t)row0 * 512 + lane * 8;
  const u16* ob = (const u16*)(p.ws + OFF_OB) + (size_t)row0 * 512 + lane * 8;
  const u16* gr = (const u16*)(p.ws + OFF_PN) + (size_t)row0 * PNLD + 1152 + lane * 8;
  uint4 a[4], bb[4], rr[4];
#pragma unroll
  for (int q = 0; q < 4; q++) { a[q] = *(const uint4*)(of + q * 512); bb[q] = *(const uint4*)(ob + q * 512); rr[q] = *(const uint4*)(gr + (size_t)q * PNLD); }
  const float* gn = p.gla_norm + l * 128 + (lane & 15) * 8;
  float gnv[8];
#pragma unroll
  for (int i = 0; i < 8; i++) gnv[i] = gn[i];
#pragma unroll
  for (int q = 0; q < 4; q++) {
    const unsigned au[4] = {a[q].x, a[q].y, a[q].z, a[q].w}, bu[4] = {bb[q].x, bb[q].y, bb[q].z, bb[q].w}, ru[4] = {rr[q].x, rr[q].y, rr[q].z, rr[q].w};
    float v[8], rv[8], ss = 0.f;
#pragma unroll
    for (int i = 0; i < 4; i++) {
      v[2 * i] = __uint_as_float(au[i] << 16) + __uint_as_float(bu[i] << 16);
      v[2 * i + 1] = __uint_as_float(au[i] & 0xffff0000u) + __uint_as_float(bu[i] & 0xffff0000u);
      rv[2 * i] = __uint_as_float(ru[i] << 16);
      rv[2 * i + 1] = __uint_as_float(ru[i] & 0xffff0000u);
      ss += v[2 * i] * v[2 * i] + v[2 * i + 1] * v[2 * i + 1];
    }
    ss += __shfl_xor(ss, 1, 64); ss += __shfl_xor(ss, 2, 64); ss += __shfl_xor(ss, 4, 64); ss += __shfl_xor(ss, 8, 64);
    const float rstd = rsqrtf(ss * (1.0f / 128.0f) + 1e-6f);
    float o[8];
#pragma unroll
    for (int i = 0; i < 8; i++) o[i] = v[i] * rstd * gnv[i] * siluf_(rv[i]);
    uint4 w; w.x = pack2(o[0], o[1]); w.y = pack2(o[2], o[3]); w.z = pack2(o[4], o[5]); w.w = pack2(o[6], o[7]);
    *(uint4*)(of + q * 512) = w;
  }
}

constexpr size_t OFF_GQ = OFF_ACT;
static_assert(OFF_GQ + (size_t)3072 * NTOK <= OFF_Y, "gate alias");

DI void task_gates(const Params& p, int l, int tile, char* lds) {
  const int mt = tile / 12, nt = tile % 12;
  const int tid = threadIdx.x, lane = tid & 63, wave = tid >> 6;
  const int wm = wave >> 1, wn = wave & 1, g = lane >> 4, n = lane & 15;
  f32x4 acc[4][8];
#pragma unroll
  for (int i = 0; i < 4; i++)
#pragma unroll
    for (int j = 0; j < 8; j++) acc[i][j] = f32x4{0.f, 0.f, 0.f, 0.f};
  gemm_wide((const u16*)(p.ws + OFF_HB) + (size_t)mt * 128 * 32, NTOK, (const u16*)(p.ws + OFF_WMG) + (size_t)nt * 256 * 32, 3072, D, acc, lds);
  unsigned char* GQ = (unsigned char*)(p.ws + OFF_GQ);
  const float* bm = p.b_merge + l * 3072 + nt * 256 + wn * 128 + n;
#pragma unroll
  for (int ni = 0; ni < 8; ni++) {
    const float bias = bm[ni * 16];
    const size_t col = (size_t)(nt * 256 + wn * 128 + ni * 16 + n);
#pragma unroll
    for (int mi = 0; mi < 4; mi++) {
      const int row0 = mt * 128 + wm * 64 + mi * 16 + 4 * g;
      unsigned q0 = (unsigned)(sigmoidf_(acc[mi][ni][0] + bias) * 255.0f + 0.5f);
      unsigned q1 = (unsigned)(sigmoidf_(acc[mi][ni][1] + bias) * 255.0f + 0.5f);
      unsigned q2 = (unsigned)(sigmoidf_(acc[mi][ni][2] + bias) * 255.0f + 0.5f);
      unsigned q3 = (unsigned)(sigmoidf_(acc[mi][ni][3] + bias) * 255.0f + 0.5f);
      *(unsigned*)(GQ + ((col >> 4) * (size_t)(NTOK / 16) + (row0 >> 4)) * 256 + (col & 15) * 16 + (row0 & 15)) = q0 | (q1 << 8) | (q2 << 16) | (q3 << 24);
    }
  }
}

DI void task_mg(const Params& p, int l, int tile, char* lds) {
  const int mt = tile >> 3, nt = tile & 7;
  const int tid = threadIdx.x, lane = tid & 63, wave = tid >> 6;
  const int wm = wave >> 1, wn = wave & 1, g = lane >> 4, n = lane & 15;
  f32x4 mix[4][4];
  zero_acc<4>(mix);
  const unsigned char* GQ = (const unsigned char*)(p.ws + OFF_GQ);
#pragma unroll 1
  for (int br = 0; br < 3; br++) {
    f32x4 acc[4][4];
    zero_acc<4>(acc);
    gemm_tile<4, 0>((const u16*)(p.ws + OFF_Y) + (size_t)br * NTOK * 512 + (size_t)mt * 128 * 512, 512,
                 (const u16*)(p.ws + OFF_WBR) + (size_t)br * 1024 * 512 + (size_t)nt * 128 * 512, 512, 512, acc, lds);
#pragma unroll
    for (int ni = 0; ni < 4; ni++) {
      const size_t col = (size_t)(br * 1024 + nt * 128 + wn * 64 + ni * 16 + n);
#pragma unroll
      for (int mi = 0; mi < 4; mi++) {
        const int row0 = mt * 128 + wm * 64 + mi * 16 + 4 * g;
        const unsigned q = *(const unsigned*)(GQ + ((col >> 4) * (size_t)(NTOK / 16) + (row0 >> 4)) * 256 + (col & 15) * 16 + (row0 & 15));
        mix[mi][ni][0] += (float)(q & 255u) * (1.0f / 255.0f) * acc[mi][ni][0];
        mix[mi][ni][1] += (float)((q >> 8) & 255u) * (1.0f / 255.0f) * acc[mi][ni][1];
        mix[mi][ni][2] += (float)((q >> 16) & 255u) * (1.0f / 255.0f) * acc[mi][ni][2];
        mix[mi][ni][3] += (float)(q >> 24) * (1.0f / 255.0f) * acc[mi][ni][3];
      }
    }
  }
  u16* mx = (u16*)(p.ws + OFF_MIXED);
#pragma unroll
  for (int mi = 0; mi < 4; mi++)
#pragma unroll
    for (int ni = 0; ni < 4; ni++)
#pragma unroll
      for (int r = 0; r < 4; r++)
      {
        const int row = mt * 128 + wm * 64 + mi * 16 + 4 * g + r, col = nt * 128 + wn * 64 + ni * 16 + n;
        mx[((size_t)(col >> 5) * NTOK + row) * 32 + (col & 31)] = f2bf(mix[mi][ni][r]);
      }
}

DI void task_res_wide(const Params& p, int l, int tile, const u16* A, int lda, const u16* Wt, int K, int gate_idx, bool first, char* lds) {
  const int mt = tile >> 2, nt = tile & 3;
  const int tid = threadIdx.x, lane = tid & 63, wave = tid >> 6;
  const int wm = wave >> 1, wn = wave & 1, g = lane >> 4, n = lane & 15;
  f32x4 acc[4][8];
#pragma unroll
  for (int i = 0; i < 4; i++)
#pragma unroll
    for (int j = 0; j < 8; j++) acc[i][j] = f32x4{0.f, 0.f, 0.f, 0.f};
  gemm_wide(A + (size_t)mt * 128 * 32, NTOK, Wt + (size_t)nt * 256 * 32, D, K, acc, lds);
  const float* gt = modp(p, l, mt * 128) + gate_idx * D + nt * 256 + wn * 128 + n;
#pragma unroll
  for (int ni = 0; ni < 8; ni++) {
    const float gv = gt[ni * 16];
#pragma unroll
    for (int mi = 0; mi < 4; mi++)
#pragma unroll
      for (int r = 0; r < 4; r++) {
        int row = mt * 128 + wm * 64 + mi * 16 + 4 * g + r, col = nt * 256 + wn * 128 + ni * 16 + n;
        const float* xs = first ? xsrc(p, l, row) : (const float*)xdst(p, row);
        xdst(p, row)[col] = xs[col] + gv * acc[mi][ni][r];
      }
  }
}

DI void task_res_ctx(const Params& p, int l, int tile, const u16* A, int lda, const u16* Wt, int K, int gate_idx, bool first, char* lds) {
  const int mt = 128 + (tile >> 4), nt = tile & 15;
  const int tid = threadIdx.x, lane = tid & 63, wave = tid >> 6;
  const int wm = wave >> 1, wn = wave & 1, g = lane >> 4, n = lane & 15;
  f32x4 acc[4][2];
  zero_acc<2>(acc);
  gemm_tile<2, 1>(A + (size_t)mt * 128 * 32, NTOK, Wt + (size_t)nt * 64 * 32, D, K, acc, lds);
  const float* gt = modp(p, l, mt * 128) + gate_idx * D + nt * 64 + wn * 32 + n;
#pragma unroll
  for (int ni = 0; ni < 2; ni++) {
    const float gv = gt[ni * 16];
#pragma unroll
    for (int mi = 0; mi < 4; mi++)
#pragma unroll
      for (int r = 0; r < 4; r++) {
        int row = mt * 128 + wm * 64 + mi * 16 + 4 * g + r, col = nt * 64 + wn * 32 + ni * 16 + n;
        const float* xs = first ? xsrc(p, l, row) : (const float*)xdst(p, row);
        xdst(p, row)[col] = xs[col] + gv * acc[mi][ni][r];
      }
  }
}

DI void task_f1(const Params& p, int tile, char* lds) {
  const int mt = tile / 22, nt = tile % 22;
  const int tid = threadIdx.x, lane = tid & 63, wave = tid >> 6;
  const int wm = wave >> 1, wn = wave & 1, g = lane >> 4, n = lane & 15;
  f32x4 acc[4][8];
#pragma unroll
  for (int i = 0; i < 4; i++)
#pragma unroll
    for (int j = 0; j < 8; j++) acc[i][j] = f32x4{0.f, 0.f, 0.f, 0.f};
  gemm_wide((const u16*)(p.ws + OFF_HB) + (size_t)mt * 128 * 32, NTOK, (const u16*)(p.ws + OFF_WF1) + (size_t)nt * 256 * 32, 2 * FH, D, acc, lds);
  u16* act = (u16*)(p.ws + OFF_ACT);
#pragma unroll
  for (int mi = 0; mi < 4; mi++)
#pragma unroll
    for (int ni = 0; ni < 4; ni++)
#pragma unroll
      for (int r = 0; r < 4; r++) {
        int row = mt * 128 + wm * 64 + mi * 16 + 4 * g + r, col = nt * 128 + wn * 64 + ni * 16 + n;
        act[((size_t)(col >> 5) * NTOK + row) * 32 + (col & 31)] = f2bf(siluf_(acc[mi][ni][r]) * acc[mi][ni + 4][r]);
      }
}

#define XB_TMO      128
#define XB_XCNT(j)  (256  + 64 * (j))
#define XB_XSUB(j)  (1280 + 64 * (j))
#define XB_XGEN(j)  (2304 + 64 * (j))
#define XB_TOP      3328
#define XB_TOPGEN   3392
#define XCD_BAR_WORDS 3456
#define XB_SPIN_CAP (1u << 18)
#define LAS __attribute__((address_space(3)))

__device__ __forceinline__ unsigned xb_ld(unsigned* p)              { return __hip_atomic_load(p, __ATOMIC_RELAXED, __HIP_MEMORY_SCOPE_AGENT); }
__device__ __forceinline__ unsigned xb_add(unsigned* p, unsigned v) { return __hip_atomic_fetch_add(p, v, __ATOMIC_RELAXED, __HIP_MEMORY_SCOPE_AGENT); }
__device__ __forceinline__ unsigned xb_xcc_id() { return (unsigned)__builtin_amdgcn_s_getreg((3 << 11) | 20) & 0xFu; }
#define XB_SPIN(cond, bar) do { unsigned _sp = 0; while (cond) { __builtin_amdgcn_s_sleep(1); \
    if ((++_sp & 255u) == 0u) { if (xb_ld(&(bar)[XB_TMO])) break; if (_sp > XB_SPIN_CAP) { atomicAdd(&(bar)[XB_TMO], 1u); break; } } } } while (0)

struct XcdBarrier {
    unsigned* bar; unsigned x;
    volatile LAS unsigned* st;
};

__device__ __forceinline__ XcdBarrier xcd_barrier_post(unsigned* bar, volatile LAS unsigned* st) {
    XcdBarrier b; b.bar = bar; b.x = xb_xcc_id(); b.st = st;
    if (threadIdx.x == 0) (void)xb_add(&bar[XB_XCNT(b.x)], 1u);
    return b;
}
__device__ __forceinline__ void xcd_barrier_complete(unsigned* bar, unsigned x, unsigned& nloc, unsigned& nx) {
    const unsigned G = gridDim.x * gridDim.y * gridDim.z;
    unsigned sum, cnt, mine, sp = 0u;
    for (;;) {
        sum = 0u; cnt = 0u; mine = 0u;
#pragma unroll
        for (unsigned j = 0; j < 16; ++j) { const unsigned c = xb_ld(&bar[XB_XCNT(j)]); sum += c; cnt += (c > 0u) ? 1u : 0u; mine = (j == x) ? c : mine; }
        if (sum == G) break;
        __builtin_amdgcn_s_sleep(1);
        if ((++sp & 255u) == 0u) { if (xb_ld(&bar[XB_TMO])) break; if (sp > XB_SPIN_CAP) { atomicAdd(&bar[XB_TMO], 1u); break; } }
    }
    nloc = mine > 0u ? mine : 1u; nx = cnt > 0u ? cnt : 1u;
}

__device__ __forceinline__ void xcd_barrier(const XcdBarrier& b) {
    asm volatile("s_waitcnt vmcnt(0)" ::: "memory");
    __syncthreads();
    if (threadIdx.x == 0) {
        unsigned* bar = b.bar;
        __builtin_amdgcn_s_waitcnt(0);
        unsigned nloc = b.st[0], nx = b.st[1];
        if (nloc == 0u) { xcd_barrier_complete(bar, b.x, nloc, nx); b.st[0] = nloc; b.st[1] = nx; }
        const unsigned old = xb_add(&bar[XB_XSUB(b.x)], 1u);
        const unsigned gen = old / nloc;
        if (old + 1u == (gen + 1u) * nloc) {
            __builtin_amdgcn_fence(__ATOMIC_RELEASE, "agent");
            asm volatile("s_waitcnt vmcnt(0)" ::: "memory");
            const unsigned og = xb_add(&bar[XB_TOP], 1u);
            const unsigned tg = og / nx;
            if (og + 1u == (tg + 1u) * nx) xb_add(&bar[XB_TOPGEN], 1u);
            else XB_SPIN(xb_ld(&bar[XB_TOPGEN]) == tg, bar);
            __builtin_amdgcn_fence(__ATOMIC_ACQUIRE, "agent");
            xb_add(&bar[XB_XGEN(b.x)], 1u);
            asm volatile("s_waitcnt vmcnt(0)" ::: "memory");
        } else {
            XB_SPIN(xb_ld(&bar[XB_XGEN(b.x)]) == gen, bar);
            __builtin_amdgcn_fence(__ATOMIC_ACQUIRE, "agent");
            asm volatile("s_waitcnt vmcnt(0)" ::: "memory");
        }
    }
    __syncthreads();
}


DI int xcd_swizzle(int t, int nb, int ntiles) {
  const int r = t / nb;
  if ((nb & 7) || (r + 1) * nb > ntiles) return t;
  const int b = t - r * nb, per = nb >> 3;
  return r * nb + (b & 7) * per + (b >> 3);
}

constexpr int NPHASE = 26;
constexpr int SMEM_BYTES = 2 * GBUF;

DI void run_phase(const Params& p, int ph, char* lds) {
  const int bid = blockIdx.x, nb = gridDim.x, wave = threadIdx.x >> 6;
  if (ph == 0) {
    for (int t = bid; t < 192 + 512 + CONV1_TASKS; t += nb) {
      if (t < 192) task_mod(p, t, lds); else if (t < 704) task_rope(p, t - 192); else task_conv1(p, 0, t - 704, lds);
    }
    return;
  }
  if (ph == 25) { for (int t = bid; t < NLAT / 16; t += nb) task_final_norm(p, t); return; }
  const int l = (ph - 1) / 12; int sp = (ph - 1) % 12;
  const bool last = l == 1;
  const int mtiles = last ? 128 : 136;
  if (sp >= 7) sp = (sp == 7) ? 11 : sp - 1;
  switch (sp) {
    case 0: for (int t = bid; t < NTOK / 16; t += nb) task_norm(p, l, t, 0); break;
    case 1: {
      for (int t = bid; t < 136 * 15; t += nb) task_g1(p, l, xcd_swizzle(t, nb, 136 * 15), lds);
      for (int t = (bid + nb - ((136 * 15) % nb)) % nb; t < 136; t += nb) task_g1_tail(p, l, t, lds);
    } break;
    case 2: for (int t = bid; t < 1024; t += nb) task_gla<1>(p, l, xcd_swizzle(t, nb, 1024), lds); break;
    case 3: {
      for (int t = bid; t < 64; t += nb) task_gla_prefix(p, t);
      for (int t = bid; t < 512; t += nb) attn_a_latent(p, l, xcd_swizzle(t, nb, 512) * 4 + wave);
      if (!last) for (int t = bid; t < 32; t += nb) attn_ctx(p, l, (31 - t) * 4 + wave, 0);
    } break;
    case 4: for (int t = bid; t < 1088; t += nb) task_gla<2>(p, l, xcd_swizzle(t, nb, 1088), lds); break;
    case 5: {
      __syncthreads();
      for (int t = bid; t < 512; t += nb) attn_c_latent(p, l, xcd_swizzle(t, nb, 512) * 4 + wave, lds);
      if (!last) for (int t = bid; t < 32; t += nb) attn_ctx(p, l, t * 4 + wave, 1);
      for (int t = bid; t < (last ? NLAT : NTOK) / 16; t += nb) task_gla_out(p, l, t);
    } break;
    case 6: for (int t = bid; t < mtiles * 12; t += nb) task_gates(p, l, xcd_swizzle(t, nb, mtiles * 12), lds); break;
    case 11: for (int t = bid; t < mtiles * 8; t += nb) task_mg(p, l, xcd_swizzle(t, nb, mtiles * 8), lds); break;
    case 7: {
      for (int t = bid; t < 512; t += nb) task_res_wide(p, l, xcd_swizzle(t, nb, 512), (const u16*)(p.ws + OFF_MIXED), D, (const u16*)(p.ws + OFF_WOUT), D, 2, true, lds);
      if (!last) for (int t = bid; t < 128; t += nb) task_res_ctx(p, l, t, (const u16*)(p.ws + OFF_MIXED), D, (const u16*)(p.ws + OFF_WOUT), D, 2, true, lds);
      for (int t = (bid + nb - (last ? 0 : 128)) % nb; t < CONV2_TASKS; t += nb) task_conv2(p, l, t, lds);
    } break;
    case 8: for (int t = bid; t < (last ? NLAT : NTOK) / 16; t += nb) task_norm(p, l, t, 1); break;
    case 9: for (int t = bid; t < mtiles * 22; t += nb) task_f1(p, xcd_swizzle(t, nb, mtiles * 22), lds); break;
    case 10: {
      for (int t = bid; t < 512; t += nb) task_res_wide(p, l, xcd_swizzle(t, nb, 512), (const u16*)(p.ws + OFF_ACT), FH, (const u16*)(p.ws + OFF_WF2), FH, 5, false, lds);
      if (!last) {
        for (int t = bid; t < 128; t += nb) task_res_ctx(p, l, t, (const u16*)(p.ws + OFF_ACT), FH, (const u16*)(p.ws + OFF_WF2), FH, 5, false, lds);
        for (int t = (bid + nb - 128) % nb; t < CONV1_TASKS; t += nb) task_conv1(p, 1, t, lds);
      }
    } break;
  }
}

#if MULTI_LAUNCH
__global__ void __launch_bounds__(256, 2) k_phase(Params p, int ph) {
  __shared__ __attribute__((aligned(16))) char smem[SMEM_BYTES];
  run_phase(p, ph, smem);
}
#endif

#if !MULTI_LAUNCH
__global__ void __launch_bounds__(256, 2) k_mega(Params p) {
  extern __shared__ __attribute__((aligned(16))) char smem[];
  __shared__ uint4 xb_words;
  if (threadIdx.x == 0) xb_words = make_uint4(0u, 0u, 0u, 0u);
  __syncthreads();
  XcdBarrier xb = xcd_barrier_post((unsigned*)(p.ws + OFF_BAR), (volatile LAS unsigned*)&xb_words);
  if (p.ws == nullptr) cg::this_grid().sync();
#define PH(k) run_phase(p, k, smem); xcd_barrier(xb);
  PH(0) PH(1) PH(2) PH(3) PH(4) PH(5) PH(6) PH(7) PH(8) PH(9) PH(10) PH(11) PH(12) PH(13) PH(14) PH(15) PH(16) PH(17) PH(18) PH(19) PH(20) PH(21) PH(22) PH(23) PH(24)
  run_phase(p, 25, smem);
}
#endif

extern "C" void kernel_launch(void* const* d_in, const int* in_sizes, int n_in, void* d_out, int out_size, void* d_ws, size_t ws_size,
                              hipStream_t stream) {
  Params p{};
  const float** f = (const float**)&p;
  for (int i = 0; i < 25; i++) f[i] = (const float*)d_in[i];
  p.out = (float*)d_out;
  p.ws = (char*)d_ws;
#if MULTI_LAUNCH
  for (int ph = 0; ph < NPHASE; ph++) hipLaunchKernelGGL(k_phase, dim3(512), dim3(256), 0, stream, p, ph);
#else
  static int grid_blocks = 0;
  if (!grid_blocks) {
    int dev = 0, cus = 0, per_cu = 0;
    hipGetDevice(&dev);
    hipDeviceGetAttribute(&cus, hipDeviceAttributeMultiprocessorCount, dev);
    (void)hipFuncSetAttribute((const void*)k_mega, hipFuncAttributeMaxDynamicSharedMemorySize, SMEM_BYTES);
    (void)hipOccupancyMaxActiveBlocksPerMultiprocessor(&per_cu, k_mega, 256, SMEM_BYTES);
    if (per_cu > 2) per_cu = 2;
    if (per_cu < 1) per_cu = 1;
    grid_blocks = cus * per_cu;
  }
  hipMemsetAsync((char*)d_ws + OFF_BAR, 0, XCD_BAR_WORDS * 4, stream);
  void* args[] = {&p};
  hipError_t e = hipLaunchCooperativeKernel((void*)k_mega, dim3(grid_blocks), dim3(256), args, SMEM_BYTES, stream);
  if (e != hipSuccess) fprintf(stderr, "cooperative launch failed: %s (grid %d)\n", hipGetErrorString(e), grid_blocks);
#endif
}
```

```cpp
#include <hip/hip_runtime.h>
#include <hip/hip_cooperative_groups.h>
#include <cstdio>
namespace cg = cooperative_groups;

#ifndef MULTI_LAUNCH
#define MULTI_LAUNCH 0
#endif

typedef unsigned short u16;
using bf16x8 = __attribute__((ext_vector_type(8))) short;
using s16x4  = __attribute__((ext_vector_type(4))) short;
using f32x4  = __attribute__((ext_vector_type(4))) float;
#define DI __device__ __forceinline__
#define MFMA16(a, b, c) __builtin_amdgcn_mfma_f32_16x16x32_bf16((a), (b), (c), 0, 0, 0)

constexpr int D = 1024, NB = 4, SEQ = 4096, LC = 256, NLAT = NB * SEQ, NCTX = NB * LC, NTOK = NLAT + NCTX;
constexpr int INT = 3872, INTP = 3968, FH = 2816, PNLD = 2720, VTR = 1152;
constexpr float LOG2E = 1.4426950408889634f;

constexpr size_t OFF_WIN  = 0;
constexpr size_t OFF_WMG  = OFF_WIN + (size_t)INTP * D * 2;
constexpr size_t OFF_WBR  = OFF_WMG + (size_t)3072 * D * 2;
constexpr size_t OFF_WOUT = OFF_WBR + (size_t)3 * 1024 * 512 * 2;
constexpr size_t OFF_WF1  = OFF_WOUT + (size_t)D * D * 2;
constexpr size_t OFF_WF2  = OFF_WF1 + (size_t)2 * FH * D * 2;
constexpr size_t OFF_PAD  = OFF_WF2 + (size_t)D * FH * 2;
constexpr size_t OFF_MOD  = OFF_PAD + (1u << 20);
constexpr size_t OFF_ROPE = OFF_MOD + (size_t)2 * 5 * 6144 * 4;
constexpr size_t OFF_XC   = OFF_ROPE + (size_t)SEQ * 32 * 2 * 4;
constexpr size_t OFF_HB   = OFF_XC + (size_t)NCTX * D * 4;
constexpr size_t OFF_PN   = OFF_HB + (size_t)NTOK * D * 2;
constexpr size_t OFF_VT   = OFF_PN + (size_t)NTOK * PNLD * 2;
constexpr size_t OFF_VTC  = OFF_VT + (size_t)NB * VTR * SEQ * 2;
constexpr size_t OFF_Y    = OFF_VTC + (size_t)NB * VTR * LC * 2;
constexpr size_t WS_END   = OFF_Y + (size_t)3 * NTOK * 512 * 2;
static_assert(WS_END <= ((size_t)256 << 20), "workspace too large");
constexpr size_t OFF_OB    = OFF_WF1;
static_assert(OFF_OB + (size_t)NTOK * 512 * 2 <= OFF_MOD, "o_b alias");
constexpr size_t OFF_BAR   = OFF_PAD + (768u << 10);
constexpr size_t OFF_MIXED = OFF_PN;
constexpr size_t OFF_ACT   = OFF_PN + (size_t)NTOK * D * 2;
static_assert(OFF_ACT + (size_t)NTOK * FH * 2 <= OFF_Y, "act alias");

struct Params {
  const float *x, *c, *ctx, *c_ctx, *w_ada, *b_ada, *norm_mix, *w_in, *sink, *gw_f, *gb_f, *gw_b, *gb_b, *gla_norm, *rpb,
      *w_ba, *w_bb, *w_bc, *w_merge, *b_merge, *w_out, *norm_ffn, *w_ffn_in, *w_ffn_out, *final_norm;
  float* out;
  char* ws;
};

typedef __bf16 bf2_t __attribute__((ext_vector_type(2)));
DI u16 f2bf(float x) { __bf16 v = (__bf16)x; return __builtin_bit_cast(u16, v); }
DI float bf2f(u16 h) { return __uint_as_float(((unsigned)h) << 16); }
DI unsigned pack2(float a, float b) { bf2_t v = {(__bf16)a, (__bf16)b}; return __builtin_bit_cast(unsigned, v); }
DI float wave_sum(float v) { for (int o = 32; o; o >>= 1) v += __shfl_xor(v, o, 64); return v; }
DI float sigmoidf_(float x) { return __builtin_amdgcn_rcpf(1.0f + __expf(-x)); }
DI float siluf_(float x) { return x * __builtin_amdgcn_rcpf(1.0f + __expf(-x)); }

DI const float* xsrc(const Params& p, int l, int row) {
  if (row < NLAT) return (l == 0 ? p.x : p.out) + (size_t)row * D;
  return (l == 0 ? p.ctx : (const float*)(p.ws + OFF_XC)) + (size_t)(row - NLAT) * D;
}
DI float* xdst(const Params& p, int row) {
  if (row < NLAT) return p.out + (size_t)row * D;
  return (float*)(p.ws + OFF_XC) + (size_t)(row - NLAT) * D;
}
DI const float* modp(const Params& p, int l, int row) {
  int s = row < NLAT ? (row >> 12) : 4;
  return (const float*)(p.ws + OFF_MOD) + (size_t)(l * 5 + s) * 6144;
}

constexpr int LROW = 144;
constexpr int LDS_A = 0, LDS_B = 128 * LROW;

constexpr int GROW = 128;
constexpr int G_A = 0, G_B = 128 * GROW;
constexpr int GBUF = 2 * 128 * GROW;
template <int NI, int CH>
DI void gemm_tile(const u16* __restrict__ A, int lda, const u16* __restrict__ Bt, int ldb, int K,
                  f32x4 (&acc)[4][NI], char* lds) {
  const int tid = threadIdx.x, lane = tid & 63, wave = tid >> 6;
  const int wm = wave >> 1, wn = wave & 1, g = lane >> 4, n = lane & 15;
  const int lrow = tid >> 3, lkc = tid & 7;
  const u16* ap = CH ? A + (size_t)lrow * 32 + (size_t)(lkc >> 2) * lda * 32 + (lkc & 3) * 8 : A + (size_t)lrow * lda + lkc * 8;
  const u16* bp = CH ? Bt + (size_t)lrow * 32 + (size_t)(lkc >> 2) * ldb * 32 + (lkc & 3) * 8 : Bt + (size_t)lrow * ldb + lkc * 8;
  const size_t sa = CH ? (size_t)32 * 32 : (size_t)32 * lda, sb = CH ? (size_t)32 * 32 : (size_t)32 * ldb;
  const size_t ka = CH ? (size_t)lda : 1, kb = CH ? (size_t)ldb : 1;
  const int wsw = (lkc ^ ((lrow >> 1) & 7)) * 16;
  const int rsw0 = (g ^ ((n >> 1) & 7)) * 16, rsw1 = ((4 + g) ^ ((n >> 1) & 7)) * 16;
  uint4 ra0, ra1, ra2, ra3, rb0, rb1, rb2, rb3;
#define GLOADS(kk)                                                                                                   \
  {                                                                                                                  \
    ra0 = *(const uint4*)(ap + (kk) * ka); ra1 = *(const uint4*)(ap + sa + (kk) * ka);                               \
    ra2 = *(const uint4*)(ap + 2 * sa + (kk) * ka); ra3 = *(const uint4*)(ap + 3 * sa + (kk) * ka);                  \
    rb0 = *(const uint4*)(bp + (kk) * kb); rb1 = *(const uint4*)(bp + sb + (kk) * kb);                               \
    if (NI == 4) { rb2 = *(const uint4*)(bp + 2 * sb + (kk) * kb); rb3 = *(const uint4*)(bp + 3 * sb + (kk) * kb); } \
  }
#define LSTORES(buf)                                                                                                 \
  {                                                                                                                  \
    char* wa_ = lds + (buf) * GBUF + G_A + lrow * GROW + wsw;                                                        \
    char* wb_ = lds + (buf) * GBUF + G_B + lrow * GROW + wsw;                                                        \
    *(uint4*)(wa_) = ra0; *(uint4*)(wa_ + 32 * GROW) = ra1; *(uint4*)(wa_ + 64 * GROW) = ra2; *(uint4*)(wa_ + 96 * GROW) = ra3; \
    *(uint4*)(wb_) = rb0; *(uint4*)(wb_ + 32 * GROW) = rb1;                                                          \
    if (NI == 4) { *(uint4*)(wb_ + 64 * GROW) = rb2; *(uint4*)(wb_ + 96 * GROW) = rb3; }                             \
  }
  GLOADS(0);
  __syncthreads();
  LSTORES(0);
  GLOADS(64);
  __syncthreads();
  const int nk = K >> 6;
#pragma unroll 1
  for (int it = 0; it < nk; it++) {
    const int cur = it & 1;
    if (it + 1 < nk) LSTORES(cur ^ 1);
    if (it + 2 < nk) GLOADS((it + 2) * 64);
    const char* fa = lds + cur * GBUF + G_A + (wm * 64 + n) * GROW;
    const char* fb = lds + cur * GBUF + G_B + (wn * 16 * NI + n) * GROW;
#pragma unroll
    for (int ks = 0; ks < 2; ks++) {
      const int rsw = ks ? rsw1 : rsw0;
      bf16x8 af[4], bfr[NI];
#pragma unroll
      for (int i = 0; i < 4; i++) af[i] = *(const bf16x8*)(fa + i * 16 * GROW + rsw);
#pragma unroll
      for (int i = 0; i < NI; i++) bfr[i] = *(const bf16x8*)(fb + i * 16 * GROW + rsw);
#pragma unroll
      for (int mi = 0; mi < 4; mi++)
#pragma unroll
        for (int ni = 0; ni < NI; ni++) acc[mi][ni] = MFMA16(af[mi], bfr[ni], acc[mi][ni]);
    }
    __syncthreads();
  }
#undef GLOADS
#undef LSTORES
}

template <int NI>
DI void zero_acc(f32x4 (&acc)[4][NI]) {
#pragma unroll
  for (int i = 0; i < 4; i++)
#pragma unroll
    for (int j = 0; j < NI; j++) acc[i][j] = f32x4{0.f, 0.f, 0.f, 0.f};
}

constexpr int LROW2 = 64;
constexpr int W_A = 0, W_B = 128 * LROW2, WBUF = 384 * LROW2;
DI void gemm_wide(const u16* __restrict__ A, int lda, const u16* __restrict__ Bt, int ldb, int K, f32x4 (&acc)[4][8], char* lds) {
  const int tid = threadIdx.x, lane = tid & 63, wave = tid >> 6;
  const int wm = wave >> 1, wn = wave & 1, g = lane >> 4, n = lane & 15;
  const int lrow = tid >> 2, lkc = tid & 3;
  const u16* ap = A + (size_t)lrow * 32 + lkc * 8;
  const u16* bp = Bt + (size_t)lrow * 32 + lkc * 8;
  const size_t sa = (size_t)64 * 32, sb = (size_t)64 * 32;
  const size_t ka = (size_t)lda, kb = (size_t)ldb;
  uint4 ra0, ra1, rb0, rb1, rb2, rb3;
  const int wsw = (lkc ^ ((0 - (lrow >> 2)) & 3)) * 16;
  const int rsw = (g ^ ((0 - (n >> 2)) & 3)) * 16;
#define GLOADS(kk)                                                                           \
  {                                                                                          \
    ra0 = *(const uint4*)(ap + (kk) * ka); ra1 = *(const uint4*)(ap + sa + (kk) * ka);       \
    rb0 = *(const uint4*)(bp + (kk) * kb); rb1 = *(const uint4*)(bp + sb + (kk) * kb);       \
    rb2 = *(const uint4*)(bp + 2 * sb + (kk) * kb); rb3 = *(const uint4*)(bp + 3 * sb + (kk) * kb); \
  }
#define LSTORES(buf)                                                                         \
  {                                                                                          \
    char* wa_ = lds + (buf) * WBUF + W_A + lrow * LROW2 + wsw;                               \
    char* wb_ = lds + (buf) * WBUF + W_B + lrow * LROW2 + wsw;                               \
    *(uint4*)(wa_) = ra0; *(uint4*)(wa_ + 64 * LROW2) = ra1;                                 \
    *(uint4*)(wb_) = rb0; *(uint4*)(wb_ + 64 * LROW2) = rb1;                                 \
    *(uint4*)(wb_ + 128 * LROW2) = rb2; *(uint4*)(wb_ + 192 * LROW2) = rb3;                  \
  }
#define HALF(h)                                                                              \
  {                                                                                          \
    bf16x8 bfr[4];                                                                           \
    _Pragma("unroll") for (int i = 0; i < 4; i++) bfr[i] = *(const bf16x8*)(fb + ((h) * 4 + i) * 16 * LROW2); \
    _Pragma("unroll") for (int mi = 0; mi < 4; mi++)                                         \
      _Pragma("unroll") for (int ni = 0; ni < 4; ni++) acc[mi][(h) * 4 + ni] = MFMA16(af[mi], bfr[ni], acc[mi][(h) * 4 + ni]); \
  }
  GLOADS(0);
  __syncthreads();
  LSTORES(0);
  GLOADS(32);
  __syncthreads();
  const int nk = K >> 5;
#pragma unroll 1
  for (int it = 0; it < nk; it++) {
    const int cur = it & 1;
    const char* fa = lds + cur * WBUF + W_A + (wm * 64 + n) * LROW2 + rsw;
    const char* fb = lds + cur * WBUF + W_B + (wn * 128 + n) * LROW2 + rsw;
    bf16x8 af[4];
#pragma unroll
    for (int i = 0; i < 4; i++) af[i] = *(const bf16x8*)(fa + i * 16 * LROW2);
    HALF(0);
    if (it + 1 < nk) LSTORES(cur ^ 1);
    if (it + 2 < nk) GLOADS((it + 2) * 32);
    HALF(1);
    __syncthreads();
  }
#undef GLOADS
#undef LSTORES
#undef HALF
}

DI void task_mod(const Params& p, int task, char* lds) {
  const int tid = threadIdx.x, lane = tid & 63, wave = tid >> 6;
  const int l = task / 96, cb = task % 96;
  float* sc = (float*)lds;
  float* red = sc + 5 * 1024;
  __syncthreads();
  for (int i = tid; i < 5 * 1024; i += 256) {
    int s = i >> 10, k = i & 1023;
    float v = s < 4 ? p.c[s * 1024 + k] : p.c_ctx[k];
    sc[i] = siluf_(v);
  }
  __syncthreads();
  const int ncol = cb * 64 + lane;
  const float* w = p.w_ada + (size_t)l * 1024 * 6144 + ncol;
  float a0 = 0, a1 = 0, a2 = 0, a3 = 0, a4 = 0;
#pragma unroll 16
  for (int k = wave * 256; k < wave * 256 + 256; k++) {
    float wv = w[(size_t)k * 6144];
    a0 += sc[k] * wv; a1 += sc[1024 + k] * wv; a2 += sc[2048 + k] * wv; a3 += sc[3072 + k] * wv; a4 += sc[4096 + k] * wv;
  }
  red[(wave * 5 + 0) * 64 + lane] = a0; red[(wave * 5 + 1) * 64 + lane] = a1; red[(wave * 5 + 2) * 64 + lane] = a2;
  red[(wave * 5 + 3) * 64 + lane] = a3; red[(wave * 5 + 4) * 64 + lane] = a4;
  __syncthreads();
  float* mod = (float*)(p.ws + OFF_MOD);
  for (int i = tid; i < 320; i += 256) {
    int s = i >> 6, ln = i & 63;
    float v = red[(0 * 5 + s) * 64 + ln] + red[(1 * 5 + s) * 64 + ln] + red[(2 * 5 + s) * 64 + ln] + red[(3 * 5 + s) * 64 + ln];
    int nc = cb * 64 + ln;
    mod[(size_t)(l * 5 + s) * 6144 + nc] = v + p.b_ada[l * 6144 + nc];
  }
}

DI void task_rope(const Params& p, int task) {
  int e = task * 256 + threadIdx.x;
  int t = e >> 5, i = e & 31;
  float pos = (i < 16) ? (float)(t >> 6) : (float)(t & 63);
  float inv = exp2f(-(float)(i & 15) * (13.287712379549449f / 16.0f));
  float ang = pos * inv;
  float kq = rintf(ang * 0.15915494309189535f);
  float rr = fmaf(-kq, 6.28125f, ang);
  rr = fmaf(-kq, 0.0019353071795864769f, rr);
  float s = sinf(rr), c = cosf(rr);
  float* rc = (float*)(p.ws + OFF_ROPE);
  rc[e] = c; rc[SEQ * 32 + e] = s;
}

DI void conv_tile(const float* __restrict__ src, int K, int N, int kt, int nt, u16* __restrict__ dst, int mode, int R, char* lds) {
  float* tile = (float*)lds;
  const int tid = threadIdx.x;
  const int k0 = kt * 128, n0 = nt * 64;
  __syncthreads();
  {
    float4 v[8];
#pragma unroll
    for (int i = 0; i < 8; i++) {
      int idx = tid + 256 * i, kk = idx >> 4, n4 = (idx & 15) * 4;
      v[i] = float4{0.f, 0.f, 0.f, 0.f};
      if (n0 + n4 < N) v[i] = *(const float4*)(src + (size_t)(k0 + kk) * N + n0 + n4);
    }
#pragma unroll
    for (int i = 0; i < 8; i++) {
      int idx = tid + 256 * i, kk = idx >> 4, n4 = (idx & 15) * 4;
      float* t = tile + kk * 65 + n4;
      t[0] = v[i].x; t[1] = v[i].y; t[2] = v[i].z; t[3] = v[i].w;
    }
  }
  __syncthreads();
#pragma unroll
  for (int i = 0; i < 4; i++) {
    int cidx = tid + 256 * i, nn = cidx >> 4, kc = cidx & 15;
    int ncol = n0 + nn;
    if (ncol < N) {
      int drow = ncol;
      if (mode == 1) {
        int up = ncol >= FH, j = up ? ncol - FH : ncol;
        drow = (j >> 7) * 256 + ((j >> 6) & 1) * 128 + up * 64 + (j & 63);
      }
      uint4 o;
      o.x = pack2(tile[(kc * 8 + 0) * 65 + nn], tile[(kc * 8 + 1) * 65 + nn]);
      o.y = pack2(tile[(kc * 8 + 2) * 65 + nn], tile[(kc * 8 + 3) * 65 + nn]);
      o.z = pack2(tile[(kc * 8 + 4) * 65 + nn], tile[(kc * 8 + 5) * 65 + nn]);
      o.w = pack2(tile[(kc * 8 + 6) * 65 + nn], tile[(kc * 8 + 7) * 65 + nn]);
      const int kd = k0 + kc * 8;
      if (R > 0) *(uint4*)(dst + ((size_t)(kd >> 5) * R + drow) * 32 + (kd & 31)) = o;
      else *(uint4*)(dst + (size_t)drow * K + kd) = o;
    }
  }
}

constexpr int CONV1_TASKS = 488 + 384 + 192 + 128 + 1;
constexpr int CONV2_TASKS = 704 + 352;
DI void task_conv1(const Params& p, int l, int t, char* lds) {
  if (t < 488) { conv_tile(p.w_in + (size_t)l * D * INT, D, INT, t / 61, t % 61, (u16*)(p.ws + OFF_WIN), 0, INTP, lds); return; }
  t -= 488;
  if (t < 384) { conv_tile(p.w_merge + (size_t)l * D * 3072, D, 3072, t / 48, t % 48, (u16*)(p.ws + OFF_WMG), 0, 3072, lds); return; }
  t -= 384;
  if (t < 192) {
    int br = t / 64, tt = t % 64;
    const float* src = (br == 0 ? p.w_ba : br == 1 ? p.w_bb : p.w_bc) + (size_t)l * 512 * D;
    conv_tile(src, 512, D, tt / 16, tt % 16, (u16*)(p.ws + OFF_WBR) + (size_t)br * 1024 * 512, 0, 0, lds);
    return;
  }
  t -= 192;
  if (t < 128) { conv_tile(p.w_out + (size_t)l * D * D, D, D, t / 16, t % 16, (u16*)(p.ws + OFF_WOUT), 0, D, lds); return; }
  uint4 z = {0, 0, 0, 0};
  for (int i = threadIdx.x; i < 32 * (INTP - INT) * 4; i += 256) {
    const int ch = i / ((INTP - INT) * 4), off = i % ((INTP - INT) * 4);
    *(uint4*)((u16*)(p.ws + OFF_WIN) + ((size_t)ch * INTP + INT) * 32 + off * 8) = z;
  }
}
DI void task_conv2(const Params& p, int l, int t, char* lds) {
  if (t < 704) { conv_tile(p.w_ffn_in + (size_t)l * D * 2 * FH, D, 2 * FH, t / 88, t % 88, (u16*)(p.ws + OFF_WF1), 1, 2 * FH, lds); return; }
  t -= 704;
  conv_tile(p.w_ffn_out + (size_t)l * FH * D, FH, D, t / 16, t % 16, (u16*)(p.ws + OFF_WF2), 0, D, lds);
}

DI void task_norm(const Params& p, int l, int task, int which) {
  const int lane = threadIdx.x & 63, wave = threadIdx.x >> 6;
  const int row0 = task * 16 + wave * 4;
  const float* g = (which == 0 ? p.norm_mix : p.norm_ffn) + l * D;
  const float* md = modp(p, l, row0) + (which ? 3 * D : 0);
  float4 v[4][4];
#pragma unroll
  for (int r = 0; r < 4; r++) {
    const float* xr = which == 0 ? xsrc(p, l, row0 + r) : (const float*)xdst(p, row0 + r);
#pragma unroll
    for (int i = 0; i < 4; i++) v[r][i] = *(const float4*)(xr + i * 256 + lane * 4);
  }
  float rstd[4];
#pragma unroll
  for (int r = 0; r < 4; r++) {
    float ss = 0.f;
#pragma unroll
    for (int i = 0; i < 4; i++) ss += v[r][i].x * v[r][i].x + v[r][i].y * v[r][i].y + v[r][i].z * v[r][i].z + v[r][i].w * v[r][i].w;
    ss = wave_sum(ss);
    rstd[r] = rsqrtf(ss * (1.0f / 1024.0f) + 1e-6f);
  }
  u16* hb = (u16*)(p.ws + OFF_HB) + (size_t)row0 * 32;
#pragma unroll
  for (int i = 0; i < 4; i++) {
    const int cidx = i * 256 + lane * 4;
    const float4 gg = *(const float4*)(g + cidx), sh = *(const float4*)(md + cidx), sc = *(const float4*)(md + D + cidx);
    const float a0 = gg.x * (1.f + sc.x), a1 = gg.y * (1.f + sc.y), a2 = gg.z * (1.f + sc.z), a3 = gg.w * (1.f + sc.w);
#pragma unroll
    for (int r = 0; r < 4; r++) {
      uint2 o;
      o.x = pack2(v[r][i].x * rstd[r] * a0 + sh.x, v[r][i].y * rstd[r] * a1 + sh.y);
      o.y = pack2(v[r][i].z * rstd[r] * a2 + sh.z, v[r][i].w * rstd[r] * a3 + sh.w);
      *(uint2*)(hb + (size_t)(cidx >> 5) * NTOK * 32 + r * 32 + (cidx & 31)) = o;
    }
  }
}
DI void task_final_norm(const Params& p, int task) {
  const int lane = threadIdx.x & 63, wave = threadIdx.x >> 6;
  float* xr = p.out + (size_t)(task * 16 + wave * 4) * D;
  float4 v[4][4];
#pragma unroll
  for (int r = 0; r < 4; r++)
#pragma unroll
    for (int i = 0; i < 4; i++) v[r][i] = *(const float4*)(xr + (size_t)r * D + i * 256 + lane * 4);
  float rstd[4];
#pragma unroll
  for (int r = 0; r < 4; r++) {
    float ss = 0.f;
#pragma unroll
    for (int i = 0; i < 4; i++) ss += v[r][i].x * v[r][i].x + v[r][i].y * v[r][i].y + v[r][i].z * v[r][i].z + v[r][i].w * v[r][i].w;
    ss = wave_sum(ss);
    rstd[r] = rsqrtf(ss * (1.0f / 1024.0f) + 1e-6f);
  }
#pragma unroll
  for (int i = 0; i < 4; i++) {
    const int cidx = i * 256 + lane * 4;
    const float4 gg = *(const float4*)(p.final_norm + cidx);
#pragma unroll
    for (int r = 0; r < 4; r++) {
      float4 o = {v[r][i].x * rstd[r] * gg.x, v[r][i].y * rstd[r] * gg.y, v[r][i].z * rstd[r] * gg.z, v[r][i].w * rstd[r] * gg.w};
      *(float4*)(xr + (size_t)r * D + cidx) = o;
    }
  }
}

DI void task_g1(const Params& p, int l, int tile, char* lds) {
  const int mt = tile / 15, nt = tile % 15;
  const int tid = threadIdx.x, lane = tid & 63, wave = tid >> 6;
  const int wm = wave >> 1, wn = wave & 1, g = lane >> 4, n = lane & 15;
  f32x4 acc[4][8];
#pragma unroll
  for (int i = 0; i < 4; i++)
#pragma unroll
    for (int j = 0; j < 8; j++) acc[i][j] = f32x4{0.f, 0.f, 0.f, 0.f};
  gemm_wide((const u16*)(p.ws + OFF_HB) + (size_t)mt * 128 * 32, NTOK, (const u16*)(p.ws + OFF_WIN) + (size_t)nt * 256 * 32, INTP, D, acc, lds);
  const int cw = nt * 256 + wn * 128;
  const int rw = mt * 128 + wm * 64;
  if (mt < 128) {
    const float* rc = (const float*)(p.ws + OFF_ROPE);
    const float* rs = rc + SEQ * 32;
#pragma unroll
    for (int hh = 0; hh < 2; hh++) {
      if (cw + hh * 64 >= 640) continue;
#pragma unroll
      for (int mi = 0; mi < 4; mi++)
#pragma unroll
        for (int ni = 0; ni < 2; ni++)
#pragma unroll
          for (int r = 0; r < 4; r++) {
            int t = (rw + mi * 16 + 4 * g + r) & 4095;
            float c = rc[t * 32 + ni * 16 + n], sn = rs[t * 32 + ni * 16 + n];
            float x1 = acc[mi][hh * 4 + ni][r], x2 = acc[mi][hh * 4 + ni + 2][r];
            acc[mi][hh * 4 + ni][r] = x1 * c - x2 * sn;
            acc[mi][hh * 4 + ni + 2][r] = x1 * sn + x2 * c;
          }
    }
  }
  u16* PN = (u16*)(p.ws + OFF_PN);
  u16* VT = (u16*)(p.ws + OFF_VT);
  u16* VTc = (u16*)(p.ws + OFF_VTC);
#pragma unroll
  for (int ni = 0; ni < 8; ni++) {
    const int c16 = cw + ni * 16;
    if (c16 >= INT) continue;
    int tr = -1, nat = 0;
    if (c16 < 640) nat = c16;
    else if (c16 < 768) tr = c16 - 640;
    else if (c16 < 1280) nat = c16 - 128;
    else if (c16 < 1792) tr = 128 + c16 - 1280;
    else if (c16 < 3360) nat = c16 - 640;
    else tr = 640 + c16 - 3360;
#pragma unroll
    for (int mi = 0; mi < 4; mi++) {
      const int row0 = rw + mi * 16 + 4 * g;
      if (tr < 0) {
#pragma unroll
        for (int r = 0; r < 4; r++) PN[(size_t)(row0 + r) * PNLD + nat + n] = f2bf(acc[mi][ni][r]);
      } else {
        uint2 o; o.x = pack2(acc[mi][ni][0], acc[mi][ni][1]); o.y = pack2(acc[mi][ni][2], acc[mi][ni][3]);
        if (mt < 128) {
          int b = row0 >> 12, tok = row0 & 4095;
          *(uint2*)(VT + ((size_t)(b * VTR + tr + n)) * SEQ + tok) = o;
        } else {
          int rr = row0 - NLAT, b = rr >> 8, tok = rr & 255;
          *(uint2*)(VTc + ((size_t)(b * VTR + tr + n)) * LC + tok) = o;
        }
      }
    }
  }
}

DI void task_g1_tail(const Params& p, int l, int mt, char* lds) {
  const int tid = threadIdx.x, lane = tid & 63, wave = tid >> 6;
  const int wm = wave >> 1, wn = wave & 1, g = lane >> 4, n = lane & 15;
  f32x4 acc[4][2];
  zero_acc<2>(acc);
  gemm_tile<2, 1>((const u16*)(p.ws + OFF_HB) + (size_t)mt * 128 * 32, NTOK, (const u16*)(p.ws + OFF_WIN) + (size_t)3840 * 32, INTP, D, acc, lds);
  if (wn != 0) return;
  u16* VT = (u16*)(p.ws + OFF_VT);
  u16* VTc = (u16*)(p.ws + OFF_VTC);
#pragma unroll
  for (int ni = 0; ni < 2; ni++) {
    const int tr = 640 + (3840 - 3360) + ni * 16;
#pragma unroll
    for (int mi = 0; mi < 4; mi++) {
      const int row0 = mt * 128 + wm * 64 + mi * 16 + 4 * g;
      uint2 o; o.x = pack2(acc[mi][ni][0], acc[mi][ni][1]); o.y = pack2(acc[mi][ni][2], acc[mi][ni][3]);
      if (mt < 128) {
        int b = row0 >> 12, tok = row0 & 4095;
        *(uint2*)(VT + ((size_t)(b * VTR + tr + n)) * SEQ + tok) = o;
      } else {
        int rr = row0 - NLAT, b = rr >> 8, tok = rr & 255;
        *(uint2*)(VTc + ((size_t)(b * VTR + tr + n)) * LC + tok) = o;
      }
    }
  }
}

constexpr float QSC = 0.125f * LOG2E;

template <class QF, class OF, class M0F, class TileFn, class ScoreFn, class SkipFn>
DI void attn_core4(QF qptr, OF optr, M0F m0f, float l0, int ntiles, TileFn tilefn, ScoreFn scorefn, SkipFn skipfn) {
  const int lane = threadIdx.x & 63, g = lane >> 4, n = lane & 15;
  bf16x8 qf[4][2];
  f32x4 o[4][4];
  float m[4], ls[4];
#pragma unroll
  for (int gi = 0; gi < 4; gi++) {
    const u16* q = qptr(gi);
    qf[gi][0] = *(const bf16x8*)(q + (size_t)n * PNLD + g * 8);
    qf[gi][1] = *(const bf16x8*)(q + (size_t)n * PNLD + 32 + g * 8);
#pragma unroll
    for (int i = 0; i < 4; i++) o[gi][i] = f32x4{0.f, 0.f, 0.f, 0.f};
    m[gi] = m0f(gi);
    ls[gi] = (g == 0) ? l0 : 0.f;
  }
  const u16* kp; const u16* vp; int vld, aux;
  tilefn(0, kp, vp, vld, aux);
  bf16x8 kn0, kn1, kn2, kn3;
  bf16x8 vn0, vn1, vn2, vn3;
  const int krow0 = 8 * (n >> 2) + (n & 3);
#define LOADK()                                                                     \
  {                                                                                 \
    const u16* kr = kp + (size_t)krow0 * PNLD + g * 8;                              \
    kn0 = *(const bf16x8*)(kr); kn1 = *(const bf16x8*)(kr + (size_t)4 * PNLD);      \
    kn2 = *(const bf16x8*)(kr + 32); kn3 = *(const bf16x8*)(kr + (size_t)4 * PNLD + 32); \
  }
#define LOADV()                                                                     \
  {                                                                                 \
    const u16* vr = vp + (size_t)n * vld + 8 * g;                                   \
    vn0 = *(const bf16x8*)(vr); vn1 = *(const bf16x8*)(vr + (size_t)16 * vld);      \
    vn2 = *(const bf16x8*)(vr + (size_t)32 * vld); vn3 = *(const bf16x8*)(vr + (size_t)48 * vld); \
  }
  LOADK();
  LOADV();
#pragma unroll 1
  for (int t = 0; t < ntiles; t++) {
    const int auxc = aux;
    const bool more = t + 1 < ntiles;
    bf16x8 vf[4];
    vf[0] = vn0; vf[1] = vn1; vf[2] = vn2; vf[3] = vn3;
#pragma unroll
    for (int hf = 0; hf < 2; hf++) {
      f32x4 s0[2], s1[2];
#pragma unroll
      for (int gg = 0; gg < 2; gg++) {
        const int gi = hf * 2 + gg;
        s0[gg] = f32x4{0.f, 0.f, 0.f, 0.f}; s1[gg] = f32x4{0.f, 0.f, 0.f, 0.f};
        if (skipfn(gi, auxc)) continue;
        s0[gg] = MFMA16(kn0, qf[gi][0], s0[gg]); s1[gg] = MFMA16(kn1, qf[gi][0], s1[gg]);
        s0[gg] = MFMA16(kn2, qf[gi][1], s0[gg]); s1[gg] = MFMA16(kn3, qf[gi][1], s1[gg]);
      }
      if (hf == 1 && more) { tilefn(t + 1, kp, vp, vld, aux); LOADK(); }
#pragma unroll
      for (int gg = 0; gg < 2; gg++) {
        const int gi = hf * 2 + gg;
        if (skipfn(gi, auxc)) continue;
        float sc[8];
#pragma unroll
        for (int r = 0; r < 4; r++) {
          sc[r] = scorefn(gi, auxc, 8 * g + r, n, s0[gg][r]);
          sc[4 + r] = scorefn(gi, auxc, 8 * g + 4 + r, n, s1[gg][r]);
        }
        float mx = fmaxf(fmaxf(fmaxf(sc[0], sc[1]), fmaxf(sc[2], sc[3])), fmaxf(fmaxf(sc[4], sc[5]), fmaxf(sc[6], sc[7])));
        mx = fmaxf(mx, __shfl_xor(mx, 16, 64));
        mx = fmaxf(mx, __shfl_xor(mx, 32, 64));
        const float mn = fmaxf(m[gi], mx);
        const float alpha = __builtin_amdgcn_exp2f(m[gi] - mn);
        float pv[8], ps = 0.f;
#pragma unroll
        for (int r = 0; r < 8; r++) { pv[r] = __builtin_amdgcn_exp2f(sc[r] - mn); ps += pv[r]; }
        ls[gi] = ls[gi] * alpha + ps;
        m[gi] = mn;
        union { bf16x8 v; unsigned u[4]; } pf;
        pf.u[0] = pack2(pv[0], pv[1]); pf.u[1] = pack2(pv[2], pv[3]); pf.u[2] = pack2(pv[4], pv[5]); pf.u[3] = pack2(pv[6], pv[7]);
#pragma unroll
        for (int d4 = 0; d4 < 4; d4++) {
          o[gi][d4] *= alpha;
          o[gi][d4] = MFMA16(vf[d4], pf.v, o[gi][d4]);
        }
      }
    }
    if (more) LOADV();
  }
#undef LOADK
#undef LOADV
#pragma unroll
  for (int gi = 0; gi < 4; gi++) {
    float lsum = ls[gi];
    lsum += __shfl_xor(lsum, 16, 64);
    lsum += __shfl_xor(lsum, 32, 64);
    const float inv = 1.0f / lsum;
    u16* ob = optr(gi);
#pragma unroll
    for (int d4 = 0; d4 < 4; d4++) {
      uint2 w; w.x = pack2(o[gi][d4][0] * inv, o[gi][d4][1] * inv); w.y = pack2(o[gi][d4][2] * inv, o[gi][d4][3] * inv);
      *(uint2*)(ob + (size_t)n * 512 + d4 * 16 + 4 * g) = w;
    }
  }
}

DI void attn_a_latent(const Params& p, int l, int wt) {
  wt = __builtin_amdgcn_readfirstlane(wt);
  const int kvh = wt & 1, qt = (wt >> 1) & 255, b = wt >> 9, q0 = qt * 16;
  const u16* PN = (const u16*)(p.ws + OFF_PN);
  const u16* VT = (const u16*)(p.ws + OFF_VT);
  const u16* VTc = (const u16*)(p.ws + OFF_VTC);
  int jlo = (q0 - 128) & ~31; if (jlo < 0) jlo = 0;
  int jhi = (q0 + 144 + 31) & ~31; if (jhi > SEQ) jhi = SEQ;
  const int ntiles = 8 + (jhi - jlo) / 32;
  const u16* kc = PN + (size_t)(NLAT + b * LC) * PNLD + 512 + kvh * 64;
  const u16* kl = PN + (size_t)(b * SEQ) * PNLD + 512 + kvh * 64;
  const u16* vc = VTc + (size_t)(b * VTR + kvh * 64) * LC;
  const u16* vl = VT + (size_t)(b * VTR + kvh * 64) * SEQ;
  const u16* qb = PN + (size_t)(b * SEQ + q0) * PNLD + kvh * 256;
  u16* ob = (u16*)(p.ws + OFF_Y) + (size_t)(b * SEQ + q0) * 512 + kvh * 256;
  const float* sk = p.sink + l * 8 + kvh * 4;
  auto tilefn = [&](int t, const u16*& kp, const u16*& vp, int& vld, int& aux) {
    if (t < 8) { kp = kc + (size_t)(t * 32) * PNLD; vp = vc + t * 32; vld = LC; aux = -1; }
    else { int j0 = jlo + (t - 8) * 32; kp = kl + (size_t)j0 * PNLD; vp = vl + j0; vld = SEQ; aux = j0; }
  };
  auto scorefn = [&](int gi, int aux, int kidx, int n, float dot) -> float {
    float s = dot * QSC;
    if (aux >= 0) { int dj = aux + kidx - (q0 + n); if (dj > 128 || dj < -128) s = -INFINITY; }
    return s;
  };
  attn_core4([&](int gi) { return qb + gi * 64; }, [&](int gi) { return ob + gi * 64; }, [&](int gi) { return sk[gi] * LOG2E; }, 1.0f,
             ntiles, tilefn, scorefn, [&](int gi, int aux) { return false; });
}

DI void attn_c_latent(const Params& p, int l, int wt, char* lds) {
  wt = __builtin_amdgcn_readfirstlane(wt);
  const int head = wt & 7, r = (wt >> 3) & 63, b = wt >> 9;
  const u16* PN = (const u16*)(p.ws + OFF_PN);
  const u16* VT = (const u16*)(p.ws + OFF_VT);
  const u16* VTc = (const u16*)(p.ws + OFF_VTC);
  int rs = r - 4; rs = rs < 0 ? 0 : (rs > 56 ? 56 : rs);
  const int tok0 = b * SEQ + r * 64;
  const u16* kc = PN + (size_t)(NLAT + b * LC) * PNLD + 2208 + head * 64;
  const u16* kl = PN + (size_t)(b * SEQ) * PNLD + 2208 + head * 64;
  const u16* vc = VTc + (size_t)(b * VTR + 640 + head * 64) * LC;
  const u16* vl = VT + (size_t)(b * VTR + 640 + head * 64) * SEQ;
  float* rpb = (float*)(lds + (threadIdx.x >> 6) * 2048);
  {
    const float* src = p.rpb + (size_t)(l * 8 + head) * 15 * 31;
    const int lane_ = threadIdx.x & 63;
    for (int i = lane_; i < 465; i += 64) rpb[i] = src[i] * LOG2E;
  }
  const u16* qb = PN + (size_t)tok0 * PNLD + 1696 + head * 64;
  u16* ob = (u16*)(p.ws + OFF_Y) + (size_t)2 * NTOK * 512 + (size_t)tok0 * 512 + head * 64;
  auto tilefn = [&](int t, const u16*& kp, const u16*& vp, int& vld, int& aux) {
    if (t < 8) { kp = kc + (size_t)(t * 32) * PNLD; vp = vc + t * 32; vld = LC; aux = -1; }
    else { int a = t - 8; int tk = (rs + (a >> 1)) * 64 + (a & 1) * 32; kp = kl + (size_t)tk * PNLD; vp = vl + tk; vld = SEQ; aux = a; }
  };
  auto scorefn = [&](int gi, int aux, int kidx, int n, float dot) -> float {
    float s = dot * QSC;
    if (aux >= 0) {
      int kcol = (aux & 1) * 32 + kidx, qcol = gi * 16 + n;
      int wsx = qcol - 8; wsx = wsx < 0 ? 0 : (wsx > 48 ? 48 : wsx);
      int drow = rs + (aux >> 1) - r + 7;
      int dc = kcol - qcol; dc = dc < -15 ? -15 : (dc > 15 ? 15 : dc);
      float bias = rpb[drow * 31 + dc + 15];
      s = (kcol >= wsx && kcol < wsx + 16) ? s + bias : -INFINITY;
    }
    return s;
  };
  attn_core4([&](int gi) { return qb + (size_t)gi * 16 * PNLD; }, [&](int gi) { return ob + (size_t)gi * 16 * 512; },
             [&](int gi) { return -INFINITY; }, 0.0f, 24, tilefn, scorefn,
             [&](int gi, int aux) { return aux >= 0 && ((gi == 0 && (aux & 1)) || (gi == 3 && !(aux & 1))); });
}

DI void attn_ctx(const Params& p, int l, int wt, int which) {
  wt = __builtin_amdgcn_readfirstlane(wt);
  const u16* PN = (const u16*)(p.ws + OFF_PN);
  const u16* VTc = (const u16*)(p.ws + OFF_VTC);
  if (which == 0) {
    const int kvh = wt & 1, qt = (wt >> 1) & 15, b = wt >> 5;
    const int row0 = NLAT + b * LC + qt * 16;
    const u16* kc = PN + (size_t)(NLAT + b * LC) * PNLD + 512 + kvh * 64;
    const u16* vc = VTc + (size_t)(b * VTR + kvh * 64) * LC;
    const u16* qb = PN + (size_t)row0 * PNLD + kvh * 256;
    u16* ob = (u16*)(p.ws + OFF_Y) + (size_t)row0 * 512 + kvh * 256;
    const float* sk = p.sink + l * 8 + kvh * 4;
    attn_core4([&](int gi) { return qb + gi * 64; }, [&](int gi) { return ob + gi * 64; }, [&](int gi) { return sk[gi] * LOG2E; }, 1.0f, 8,
               [&](int t, const u16*& kp, const u16*& vp, int& vld, int& aux) { kp = kc + (size_t)(t * 32) * PNLD; vp = vc + t * 32; vld = LC; aux = -1; },
               [&](int gi, int aux, int kidx, int n, float dot) -> float { return dot * QSC; }, [&](int gi, int aux) { return false; });
  } else {
    const int head = wt & 7, q4 = (wt >> 3) & 3, b = wt >> 5;
    const int row0 = NLAT + b * LC + q4 * 64;
    const u16* kc = PN + (size_t)(NLAT + b * LC) * PNLD + 2208 + head * 64;
    const u16* vc = VTc + (size_t)(b * VTR + 640 + head * 64) * LC;
    const u16* qb = PN + (size_t)row0 * PNLD + 1696 + head * 64;
    u16* ob = (u16*)(p.ws + OFF_Y) + (size_t)2 * NTOK * 512 + (size_t)row0 * 512 + head * 64;
    attn_core4([&](int gi) { return qb + (size_t)gi * 16 * PNLD; }, [&](int gi) { return ob + (size_t)gi * 16 * 512; },
               [&](int gi) { return -INFINITY; }, 0.0f, 8,
               [&](int t, const u16*& kp, const u16*& vp, int& vld, int& aux) { kp = kc + (size_t)(t * 32) * PNLD; vp = vc + t * 32; vld = LC; aux = -1; },
               [&](int gi, int aux, int kidx, int n, float dot) -> float { return dot * QSC; }, [&](int gi, int aux) { return false; });
  }
}

constexpr int G_QS = 0, G_KS = 9216, G_KT = 18432, G_VT = 27648, G_ZL = 36864, G_TOT = 40960, G_DEC = 41984, G_END = 42240;
constexpr int NE = 4;
constexpr size_t OFF_SL = OFF_Y + (size_t)2 * NTOK * 512 * 2;
constexpr size_t OFF_DS = OFF_PAD + (524288u);

template <int PASS>
DI void task_gla(const Params& p, int l, int id, char* lds) {
  int seg, rest;
  if (PASS == 1) { seg = id & 15; rest = id >> 4; } else { seg = 16 - (id % 17); rest = id / 17; }
  const int sl = rest & 1, dir = (rest >> 1) & 1, h = (rest >> 2) & 3, b = rest >> 4, combo = rest >> 1;
  const int tid = threadIdx.x, lane = tid & 63, wave = tid >> 6, g = lane >> 4, n = lane & 15;
  const u16* PN = (const u16*)(p.ws + OFF_PN);
  u16* odst = dir ? (u16*)(p.ws + OFF_OB) : (u16*)(p.ws + OFF_Y) + (size_t)NTOK * 512;
  float* SL = (float*)(p.ws + OFF_SL);
  float* DS = (float*)(p.ws + OFF_DS);
  const float* gwp = (dir ? p.gw_b : p.gw_f) + (size_t)l * 16 * 256 + h * 64 + lane;
  const float* gbp = (dir ? p.gb_b : p.gb_f) + l * 256 + h * 64 + lane;
  f32x4 S[4][NE];
#pragma unroll
  for (int i = 0; i < 4; i++)
#pragma unroll
    for (int j = 0; j < NE; j++) S[i][j] = f32x4{0.f, 0.f, 0.f, 0.f};
  if (PASS == 2) {
    const float* sl_src = SL + ((size_t)(rest * 17 + seg)) * (1024 * NE) + lane * 4;
#pragma unroll
    for (int dt = 0; dt < 4; dt++)
#pragma unroll
      for (int et = 0; et < NE; et++) S[dt][et] = *(const f32x4*)(sl_src + (dt * NE + et) * 256);
  }
  float* ZL = (float*)(lds + G_ZL);
  float* TOT = (float*)(lds + G_TOT);
  float* DEC = (float*)(lds + G_DEC);
  float totsum = 0.f;

  int tb = 0, rowbase = 0;
  uint4 rq0, rq1, rk0, rk1, rz, rv, rv2;
  rq0 = rq1 = rz = uint4{0, 0, 0, 0};
  auto gload = [&](int ch) {
    int vld; const u16* vsrc;
    if (ch < 4) {
      tb = dir ? 192 - 64 * ch : 64 * ch; rowbase = NLAT + b * LC; vld = LC;
      vsrc = (const u16*)(p.ws + OFF_VTC) + (size_t)(b * VTR + 128 + h * 128 + sl * 64) * LC;
    } else {
      tb = dir ? SEQ - 64 * (ch - 3) : 64 * (ch - 4); rowbase = b * SEQ; vld = SEQ;
      vsrc = (const u16*)(p.ws + OFF_VT) + (size_t)(b * VTR + 128 + h * 128 + sl * 64) * SEQ;
    }
    {
      int row = tid >> 3, kc = tid & 7;
      int tok0 = dir ? tb + 63 - row : tb + row, tok1 = dir ? tb + 31 - row : tb + 32 + row;
      const u16* s0 = PN + (size_t)(rowbase + tok0) * PNLD + h * 64 + kc * 8;
      const u16* s1 = PN + (size_t)(rowbase + tok1) * PNLD + h * 64 + kc * 8;
      if (PASS == 2) { rq0 = *(const uint4*)(s0 + 640); rq1 = *(const uint4*)(s1 + 640); }
      rk0 = *(const uint4*)(s0 + 896); rk1 = *(const uint4*)(s1 + 896);
    }
    if (tid < 128) {
      int row = tid >> 1, hc = tid & 1;
      int tok = dir ? tb + 63 - row : tb + row;
      rz = *(const uint4*)(PN + (size_t)(rowbase + tok) * PNLD + 1664 + dir * 16 + hc * 8);
    }
    rv = *(const uint4*)(vsrc + (size_t)(tid >> 3) * vld + tb + (tid & 7) * 8);
    rv2 = *(const uint4*)(vsrc + (size_t)(32 + (tid >> 3)) * vld + tb + (tid & 7) * 8);
  };
  gload(seg * 4);

  for (int ci = 0; ci < 4; ci++) {
    const int ctb = tb, crowbase = rowbase;
    float gw[16];
#pragma unroll
    for (int r = 0; r < 16; r++) gw[r] = gwp[r * 256];
    const float gbias = gbp[0];
    __syncthreads();
    {
      int row = tid >> 3, kc = tid & 7;
      if (PASS == 2) {
        *(uint4*)(lds + G_QS + row * LROW + kc * 16) = rq0;
        *(uint4*)(lds + G_QS + (row + 32) * LROW + kc * 16) = rq1;
      }
      *(uint4*)(lds + G_KS + row * LROW + kc * 16) = rk0;
      *(uint4*)(lds + G_KS + (row + 32) * LROW + kc * 16) = rk1;
    }
    if (tid < 128) {
      int row = tid >> 1, hc = tid & 1;
      float* zd = ZL + row * 16 + hc * 8;
      zd[0] = __uint_as_float(rz.x << 16); zd[1] = __uint_as_float(rz.x & 0xffff0000u);
      zd[2] = __uint_as_float(rz.y << 16); zd[3] = __uint_as_float(rz.y & 0xffff0000u);
      zd[4] = __uint_as_float(rz.z << 16); zd[5] = __uint_as_float(rz.z & 0xffff0000u);
      zd[6] = __uint_as_float(rz.w << 16); zd[7] = __uint_as_float(rz.w & 0xffff0000u);
    }
    {
      int e = tid >> 3, kc = tid & 7;
      if (dir) {
        uint4 rr;
        rr.x = (rv.w >> 16) | (rv.w << 16); rr.y = (rv.z >> 16) | (rv.z << 16);
        rr.z = (rv.y >> 16) | (rv.y << 16); rr.w = (rv.x >> 16) | (rv.x << 16);
        *(uint4*)(lds + G_VT + e * LROW + (7 - kc) * 16) = rr;
        rr.x = (rv2.w >> 16) | (rv2.w << 16); rr.y = (rv2.z >> 16) | (rv2.z << 16);
        rr.z = (rv2.y >> 16) | (rv2.y << 16); rr.w = (rv2.x >> 16) | (rv2.x << 16);
        *(uint4*)(lds + G_VT + (32 + e) * LROW + (7 - kc) * 16) = rr;
      } else {
        *(uint4*)(lds + G_VT + e * LROW + kc * 16) = rv;
        *(uint4*)(lds + G_VT + (32 + e) * LROW + kc * 16) = rv2;
      }
    }
    __syncthreads();
    float bv[16];
    {
      float run = 0.f;
#pragma unroll
      for (int tt = 0; tt < 16; tt++) {
        const float4* zr = (const float4*)(ZL + (wave * 16 + tt) * 16);
        float z = gbias;
#pragma unroll
        for (int q = 0; q < 4; q++) {
          float4 zz = zr[q];
          z += zz.x * gw[q * 4 + 0] + zz.y * gw[q * 4 + 1] + zz.z * gw[q * 4 + 2] + zz.w * gw[q * 4 + 3];
        }
        float lsg = fminf(z, 0.f) - __logf(1.0f + __expf(-fabsf(z)));
        run += lsg * (1.0f / 16.0f);
        bv[tt] = run;
      }
      TOT[wave * 64 + lane] = run;
    }
    __syncthreads();
    {
      float off = 0.f, tot = 0.f;
#pragma unroll
      for (int s = 0; s < 4; s++) { float tv = TOT[s * 64 + lane]; if (s < wave) off += tv; tot += tv; }
      totsum += tot;
      const float dtot = __expf(tot);
      if (wave == 0) DEC[lane] = dtot;
      unsigned ktp[8];
#pragma unroll
      for (int tt = 0; tt < 16; tt++) {
        const int t = wave * 16 + tt;
        const float bq = bv[tt] + off;
        u16* ka = (u16*)(lds + G_KS + t * LROW) + lane;
        const float kv = bf2f(*ka);
        const float e1 = __expf(bq), e2 = __builtin_amdgcn_rcpf(e1);
        if (PASS == 2) {
          u16* qa = (u16*)(lds + G_QS + t * LROW) + lane;
          const float qv = bf2f(*qa);
          *qa = f2bf(qv * 0.125f * e1);
          *ka = f2bf(kv * e2);
        }
        const unsigned kt = f2bf(kv * (dtot * e2));
        if (tt & 1) ktp[tt >> 1] |= kt << 16; else ktp[tt >> 1] = kt;
      }
      uint4* kd = (uint4*)(lds + G_KT + lane * LROW + wave * 32);
      kd[0] = uint4{ktp[0], ktp[1], ktp[2], ktp[3]};
      kd[1] = uint4{ktp[4], ktp[5], ktp[6], ktp[7]};
    }
    __syncthreads();
    if (ci < 3) gload(seg * 4 + ci + 1);
    if (PASS == 2) {
      bf16x8 qf[2];
      qf[0] = *(const bf16x8*)(lds + G_QS + (wave * 16 + n) * LROW + g * 16);
      qf[1] = *(const bf16x8*)(lds + G_QS + (wave * 16 + n) * LROW + 64 + g * 16);
      f32x4 X[4];
#pragma unroll
      for (int jt = 0; jt < 4; jt++) {
        X[jt] = f32x4{0.f, 0.f, 0.f, 0.f};
#pragma unroll
        for (int s = 0; s < 2; s++) {
          bf16x8 kf = *(const bf16x8*)(lds + G_KS + (jt * 16 + n) * LROW + s * 64 + g * 16);
          X[jt] = MFMA16(kf, qf[s], X[jt]);
        }
#pragma unroll
        for (int r = 0; r < 4; r++) if (jt * 16 + 4 * g + r > wave * 16 + n) X[jt][r] = 0.f;
      }
      f32x4 o[NE];
#pragma unroll
      for (int et = 0; et < NE; et++) o[et] = f32x4{0.f, 0.f, 0.f, 0.f};
#pragma unroll
      for (int kk = 0; kk < 2; kk++) {
        union { bf16x8 v; unsigned u[4]; } pa;
        pa.u[0] = pack2(X[2 * kk][0], X[2 * kk][1]); pa.u[1] = pack2(X[2 * kk][2], X[2 * kk][3]);
        pa.u[2] = pack2(X[2 * kk + 1][0], X[2 * kk + 1][1]); pa.u[3] = pack2(X[2 * kk + 1][2], X[2 * kk + 1][3]);
        const char* qr = lds + G_QS + (wave * 16 + n) * LROW + kk * 64 + g * 8;
        s16x4 qa = *(const s16x4*)(qr), qb = *(const s16x4*)(qr + 32);
        bf16x8 qp = __builtin_shufflevector(qa, qb, 0, 1, 2, 3, 4, 5, 6, 7);
#pragma unroll
        for (int et = 0; et < NE; et++) {
          const char* vr = lds + G_VT + (et * 16 + n) * LROW + kk * 64 + g * 8;
          s16x4 va = *(const s16x4*)(vr), vb = *(const s16x4*)(vr + 32);
          bf16x8 vf = __builtin_shufflevector(va, vb, 0, 1, 2, 3, 4, 5, 6, 7);
          o[et] = MFMA16(pa.v, vf, o[et]);
          union { bf16x8 v; unsigned u[4]; } sb;
          sb.u[0] = pack2(S[2 * kk][et][0], S[2 * kk][et][1]); sb.u[1] = pack2(S[2 * kk][et][2], S[2 * kk][et][3]);
          sb.u[2] = pack2(S[2 * kk + 1][et][0], S[2 * kk + 1][et][1]); sb.u[3] = pack2(S[2 * kk + 1][et][2], S[2 * kk + 1][et][3]);
          o[et] = MFMA16(qp, sb.v, o[et]);
        }
      }
#pragma unroll
      for (int r = 0; r < 4; r++) {
        int i = wave * 16 + 4 * g + r;
        int tok = dir ? ctb + 63 - i : ctb + i;
        u16* orow = odst + (size_t)(crowbase + tok) * 512 + h * 128 + sl * 64 + n;
#pragma unroll
        for (int et = 0; et < NE; et++) orow[et * 16] = f2bf(o[et][r]);
      }
    }
    if (PASS == 1 || ci < 3) {
      bf16x8 vfr[NE][2];
#pragma unroll
      for (int et = 0; et < NE; et++)
#pragma unroll
        for (int s = 0; s < 2; s++) vfr[et][s] = *(const bf16x8*)(lds + G_VT + (et * 16 + n) * LROW + s * 64 + g * 16);
#pragma unroll
      for (int dt = 0; dt < 4; dt++) {
        bf16x8 kf0 = *(const bf16x8*)(lds + G_KT + (dt * 16 + n) * LROW + g * 16);
        bf16x8 kf1 = *(const bf16x8*)(lds + G_KT + (dt * 16 + n) * LROW + 64 + g * 16);
        const f32x4 dc = *(const f32x4*)(DEC + dt * 16 + 4 * g);
#pragma unroll
        for (int et = 0; et < NE; et++) {
          f32x4 u = {0.f, 0.f, 0.f, 0.f};
          u = MFMA16(kf0, vfr[et][0], u);
          u = MFMA16(kf1, vfr[et][1], u);
          S[dt][et] = S[dt][et] * dc + u;
        }
      }
    }
  }
  if (PASS == 1 && wave == 0) {
    float* dst = SL + ((size_t)(rest * 17 + seg)) * (1024 * NE) + lane * 4;
#pragma unroll
    for (int dt = 0; dt < 4; dt++)
#pragma unroll
      for (int et = 0; et < NE; et++) *(f32x4*)(dst + (dt * NE + et) * 256) = S[dt][et];
    if (sl == 0) DS[(size_t)(combo * 17 + seg) * 64 + lane] = totsum;
  }
}

DI void task_gla_prefix(const Params& p, int rest) {
  const int tid = threadIdx.x, combo = rest >> 1;
  constexpr int SSZ = 1024 * NE;
  float* SL = (float*)(p.ws + OFF_SL) + (size_t)rest * 17 * SSZ + tid * 16;
  const int tile = tid >> 4, g4 = (tid & 15) >> 2;
  const float* DS = (const float*)(p.ws + OFF_DS) + (size_t)combo * 17 * 64 + (tile / NE) * 16 + 4 * g4;
  f32x4 s0 = {0.f, 0.f, 0.f, 0.f}, s1 = s0, s2 = s0, s3 = s0;
#pragma unroll 2
  for (int seg = 0; seg < 16; seg++) {
    float* q = SL + (size_t)seg * SSZ;
    const f32x4 c0 = *(const f32x4*)(q), c1 = *(const f32x4*)(q + 4), c2 = *(const f32x4*)(q + 8), c3 = *(const f32x4*)(q + 12);
    const f32x4 dl = *(const f32x4*)(DS + seg * 64);
    *(f32x4*)(q) = s0; *(f32x4*)(q + 4) = s1; *(f32x4*)(q + 8) = s2; *(f32x4*)(q + 12) = s3;
    const f32x4 dc = {__expf(dl[0]), __expf(dl[1]), __expf(dl[2]), __expf(dl[3])};
    s0 = s0 * dc + c0; s1 = s1 * dc + c1; s2 = s2 * dc + c2; s3 = s3 * dc + c3;
  }
  float* q = SL + (size_t)16 * SSZ;
  *(f32x4*)(q) = s0; *(f32x4*)(q + 4) = s1; *(f32x4*)(q + 8) = s2; *(f32x4*)(q + 12) = s3;
}

DI void task_gla_out(const Params& p, int l, int task) {
  const int lane = threadIdx.x & 63, wave = threadIdx.x >> 6;
  const int row0 = task * 16 + wave * 4;
  u16* of = (u16*)(p.ws + OFF_Y) + (size_t)NTOK * 512 + (size_t)row0 * 512 + lane * 8;
  const u16* ob = (const u16*)(p.ws + OFF_OB) + (size_t)row0 * 512 + lane * 8;
  const u16* gr = (const u16*)(p.ws + OFF_PN) + (size_t)row0 * PNLD + 1152 + lane * 8;
  uint4 a[4], bb[4], rr[4];
#pragma unroll
  for (int q = 0; q < 4; q++) { a[q] = *(const uint4*)(of + q * 512); bb[q] = *(const uint4*)(ob + q * 512); rr[q] = *(const uint4*)(gr + (size_t)q * PNLD); }
  const float* gn = p.gla_norm + l * 128 + (lane & 15) * 8;
  float gnv[8];
#pragma unroll
  for (int i = 0; i < 8; i++) gnv[i] = gn[i];
#pragma unroll
  for (int q = 0; q < 4; q++) {
    const unsigned au[4] = {a[q].x, a[q].y, a[q].z, a[q].w}, bu[4] = {bb[q].x, bb[q].y, bb[q].z, bb[q].w}, ru[4] = {rr[q].x, rr[q].y, rr[q].z, rr[q].w};
    float v[8], rv[8], ss = 0.f;
#pragma unroll
    for (int i = 0; i < 4; i++) {
      v[2 * i] = __uint_as_float(au[i] << 16) + __uint_as_float(bu[i] << 16);
      v[2 * i + 1] = __uint_as_float(au[i] & 0xffff0000u) + __uint_as_float(bu[i] & 0xffff0000u);
      rv[2 * i] = __uint_as_float(ru[i] << 16);
      rv[2 * i + 1] = __uint_as_float(ru[i] & 0xffff0000u);
      ss += v[2 * i] * v[2 * i] + v[2 * i + 1] * v[2 * i + 1];
    }
    ss += __shfl_xor(ss, 1, 64); ss += __shfl_xor(ss, 2, 64); ss += __shfl_xor(ss, 4, 64); ss += __shfl_xor(ss, 8, 64);
    const float rstd = rsqrtf(ss * (1.0f / 128.0f) + 1e-6f);
    float o[8];
#pragma unroll
    for (int i = 0; i < 8; i++) o[i] = v[i] * rstd * gnv[i] * siluf_(rv[i]);
    uint4 w; w.x = pack2(o[0], o[1]); w.y = pack2(o[2], o[3]); w.z = pack2(o[4], o[5]); w.w = pack2(o[6], o[7]);
    *(uint4*)(of + q * 512) = w;
  }
}

constexpr size_t OFF_GQ = OFF_ACT;
static_assert(OFF_GQ + (size_t)3072 * NTOK <= OFF_Y, "gate alias");

DI void task_gates(const Params& p, int l, int tile, char* lds) {
  const int mt = tile / 12, nt = tile % 12;
  const int tid = threadIdx.x, lane = tid & 63, wave = tid >> 6;
  const int wm = wave >> 1, wn = wave & 1, g = lane >> 4, n = lane & 15;
  f32x4 acc[4][8];
#pragma unroll
  for (int i = 0; i < 4; i++)
#pragma unroll
    for (int j = 0; j < 8; j++) acc[i][j] = f32x4{0.f, 0.f, 0.f, 0.f};
  gemm_wide((const u16*)(p.ws + OFF_HB) + (size_t)mt * 128 * 32, NTOK, (const u16*)(p.ws + OFF_WMG) + (size_t)nt * 256 * 32, 3072, D, acc, lds);
  unsigned char* GQ = (unsigned char*)(p.ws + OFF_GQ);
  const float* bm = p.b_merge + l * 3072 + nt * 256 + wn * 128 + n;
#pragma unroll
  for (int ni = 0; ni < 8; ni++) {
    const float bias = bm[ni * 16];
    const size_t col = (size_t)(nt * 256 + wn * 128 + ni * 16 + n);
#pragma unroll
    for (int mi = 0; mi < 4; mi++) {
      const int row0 = mt * 128 + wm * 64 + mi * 16 + 4 * g;
      unsigned q0 = (unsigned)(sigmoidf_(acc[mi][ni][0] + bias) * 255.0f + 0.5f);
      unsigned q1 = (unsigned)(sigmoidf_(acc[mi][ni][1] + bias) * 255.0f + 0.5f);
      unsigned q2 = (unsigned)(sigmoidf_(acc[mi][ni][2] + bias) * 255.0f + 0.5f);
      unsigned q3 = (unsigned)(sigmoidf_(acc[mi][ni][3] + bias) * 255.0f + 0.5f);
      *(unsigned*)(GQ + ((col >> 4) * (size_t)(NTOK / 16) + (row0 >> 4)) * 256 + (col & 15) * 16 + (row0 & 15)) = q0 | (q1 << 8) | (q2 << 16) | (q3 << 24);
    }
  }
}

DI void task_mg(const Params& p, int l, int tile, char* lds) {
  const int mt = tile >> 3, nt = tile & 7;
  const int tid = threadIdx.x, lane = tid & 63, wave = tid >> 6;
  const int wm = wave >> 1, wn = wave & 1, g = lane >> 4, n = lane & 15;
  f32x4 mix[4][4];
  zero_acc<4>(mix);
  const unsigned char* GQ = (const unsigned char*)(p.ws + OFF_GQ);
#pragma unroll 1
  for (int br = 0; br < 3; br++) {
    f32x4 acc[4][4];
    zero_acc<4>(acc);
    gemm_tile<4, 0>((const u16*)(p.ws + OFF_Y) + (size_t)br * NTOK * 512 + (size_t)mt * 128 * 512, 512,
                 (const u16*)(p.ws + OFF_WBR) + (size_t)br * 1024 * 512 + (size_t)nt * 128 * 512, 512, 512, acc, lds);
#pragma unroll
    for (int ni = 0; ni < 4; ni++) {
      const size_t col = (size_t)(br * 1024 + nt * 128 + wn * 64 + ni * 16 + n);
#pragma unroll
      for (int mi = 0; mi < 4; mi++) {
        const int row0 = mt * 128 + wm * 64 + mi * 16 + 4 * g;
        const unsigned q = *(const unsigned*)(GQ + ((col >> 4) * (size_t)(NTOK / 16) + (row0 >> 4)) * 256 + (col & 15) * 16 + (row0 & 15));
        mix[mi][ni][0] += (float)(q & 255u) * (1.0f / 255.0f) * acc[mi][ni][0];
        mix[mi][ni][1] += (float)((q >> 8) & 255u) * (1.0f / 255.0f) * acc[mi][ni][1];
        mix[mi][ni][2] += (float)((q >> 16) & 255u) * (1.0f / 255.0f) * acc[mi][ni][2];
        mix[mi][ni][3] += (float)(q >> 24) * (1.0f / 255.0f) * acc[mi][ni][3];
      }
    }
  }
  u16* mx = (u16*)(p.ws + OFF_MIXED);
#pragma unroll
  for (int mi = 0; mi < 4; mi++)
#pragma unroll
    for (int ni = 0; ni < 4; ni++)
#pragma unroll
      for (int r = 0; r < 4; r++)
      {
        const int row = mt * 128 + wm * 64 + mi * 16 + 4 * g + r, col = nt * 128 + wn * 64 + ni * 16 + n;
        mx[((size_t)(col >> 5) * NTOK + row) * 32 + (col & 31)] = f2bf(mix[mi][ni][r]);
      }
}

DI void task_res_wide(const Params& p, int l, int tile, const u16* A, int lda, const u16* Wt, int K, int gate_idx, bool first, char* lds) {
  const int mt = tile >> 2, nt = tile & 3;
  const int tid = threadIdx.x, lane = tid & 63, wave = tid >> 6;
  const int wm = wave >> 1, wn = wave & 1, g = lane >> 4, n = lane & 15;
  f32x4 acc[4][8];
#pragma unroll
  for (int i = 0; i < 4; i++)
#pragma unroll
    for (int j = 0; j < 8; j++) acc[i][j] = f32x4{0.f, 0.f, 0.f, 0.f};
  gemm_wide(A + (size_t)mt * 128 * 32, NTOK, Wt + (size_t)nt * 256 * 32, D, K, acc, lds);
  const float* gt = modp(p, l, mt * 128) + gate_idx * D + nt * 256 + wn * 128 + n;
#pragma unroll
  for (int ni = 0; ni < 8; ni++) {
    const float gv = gt[ni * 16];
#pragma unroll
    for (int mi = 0; mi < 4; mi++)
#pragma unroll
      for (int r = 0; r < 4; r++) {
        int row = mt * 128 + wm * 64 + mi * 16 + 4 * g + r, col = nt * 256 + wn * 128 + ni * 16 + n;
        const float* xs = first ? xsrc(p, l, row) : (const float*)xdst(p, row);
        xdst(p, row)[col] = xs[col] + gv * acc[mi][ni][r];
      }
  }
}

DI void task_res_ctx(const Params& p, int l, int tile, const u16* A, int lda, const u16* Wt, int K, int gate_idx, bool first, char* lds) {
  const int mt = 128 + (tile >> 4), nt = tile & 15;
  const int tid = threadIdx.x, lane = tid & 63, wave = tid >> 6;
  const int wm = wave >> 1, wn = wave & 1, g = lane >> 4, n = lane & 15;
  f32x4 acc[4][2];
  zero_acc<2>(acc);
  gemm_tile<2, 1>(A + (size_t)mt * 128 * 32, NTOK, Wt + (size_t)nt * 64 * 32, D, K, acc, lds);
  const float* gt = modp(p, l, mt * 128) + gate_idx * D + nt * 64 + wn * 32 + n;
#pragma unroll
  for (int ni = 0; ni < 2; ni++) {
    const float gv = gt[ni * 16];
#pragma unroll
    for (int mi = 0; mi < 4; mi++)
#pragma unroll
      for (int r = 0; r < 4; r++) {
        int row = mt * 128 + wm * 64 + mi * 16 + 4 * g + r, col = nt * 64 + wn * 32 + ni * 16 + n;
        const float* xs = first ? xsrc(p, l, row) : (const float*)xdst(p, row);
        xdst(p, row)[col] = xs[col] + gv * acc[mi][ni][r];
      }
  }
}

DI void task_f1(const Params& p, int tile, char* lds) {
  const int mt = tile / 22, nt = tile % 22;
  const int tid = threadIdx.x, lane = tid & 63, wave = tid >> 6;
  const int wm = wave >> 1, wn = wave & 1, g = lane >> 4, n = lane & 15;
  f32x4 acc[4][8];
#pragma unroll
  for (int i = 0; i < 4; i++)
#pragma unroll
    for (int j = 0; j < 8; j++) acc[i][j] = f32x4{0.f, 0.f, 0.f, 0.f};
  gemm_wide((const u16*)(p.ws + OFF_HB) + (size_t)mt * 128 * 32, NTOK, (const u16*)(p.ws + OFF_WF1) + (size_t)nt * 256 * 32, 2 * FH, D, acc, lds);
  u16* act = (u16*)(p.ws + OFF_ACT);
#pragma unroll
  for (int mi = 0; mi < 4; mi++)
#pragma unroll
    for (int ni = 0; ni < 4; ni++)
#pragma unroll
      for (int r = 0; r < 4; r++) {
        int row = mt * 128 + wm * 64 + mi * 16 + 4 * g + r, col = nt * 128 + wn * 64 + ni * 16 + n;
        act[((size_t)(col >> 5) * NTOK + row) * 32 + (col & 31)] = f2bf(siluf_(acc[mi][ni][r]) * acc[mi][ni + 4][r]);
      }
}

#define XB_TMO      128
#define XB_XCNT(j)  (256  + 64 * (j))
#define XB_XSUB(j)  (1280 + 64 * (j))
#define XB_XGEN(j)  (2304 + 64 * (j))
#define XB_TOP      3328
#define XB_TOPGEN   3392
#define XCD_BAR_WORDS 3456
#define XB_SPIN_CAP (1u << 18)
#define LAS __attribute__((address_space(3)))

__device__ __forceinline__ unsigned xb_ld(unsigned* p)              { return __hip_atomic_load(p, __ATOMIC_RELAXED, __HIP_MEMORY_SCOPE_AGENT); }
__device__ __forceinline__ unsigned xb_add(unsigned* p, unsigned v) { return __hip_atomic_fetch_add(p, v, __ATOMIC_RELAXED, __HIP_MEMORY_SCOPE_AGENT); }
__device__ __forceinline__ unsigned xb_xcc_id() { return (unsigned)__builtin_amdgcn_s_getreg((3 << 11) | 20) & 0xFu; }
#define XB_SPIN(cond, bar) do { unsigned _sp = 0; while (cond) { __builtin_amdgcn_s_sleep(1); \
    if ((++_sp & 255u) == 0u) { if (xb_ld(&(bar)[XB_TMO])) break; if (_sp > XB_SPIN_CAP) { atomicAdd(&(bar)[XB_TMO], 1u); break; } } } } while (0)

struct XcdBarrier {
    unsigned* bar; unsigned x;
    volatile LAS unsigned* st;
};

__device__ __forceinline__ XcdBarrier xcd_barrier_post(unsigned* bar, volatile LAS unsigned* st) {
    XcdBarrier b; b.bar = bar; b.x = xb_xcc_id(); b.st = st;
    if (threadIdx.x == 0) (void)xb_add(&bar[XB_XCNT(b.x)], 1u);
    return b;
}
__device__ __forceinline__ void xcd_barrier_complete(unsigned* bar, unsigned x, unsigned& nloc, unsigned& nx) {
    const unsigned G = gridDim.x * gridDim.y * gridDim.z;
    unsigned sum, cnt, mine, sp = 0u;
    for (;;) {
        sum = 0u; cnt = 0u; mine = 0u;
#pragma unroll
        for (unsigned j = 0; j < 16; ++j) { const unsigned c = xb_ld(&bar[XB_XCNT(j)]); sum += c; cnt += (c > 0u) ? 1u : 0u; mine = (j == x) ? c : mine; }
        if (sum == G) break;
        __builtin_amdgcn_s_sleep(1);
        if ((++sp & 255u) == 0u) { if (xb_ld(&bar[XB_TMO])) break; if (sp > XB_SPIN_CAP) { atomicAdd(&bar[XB_TMO], 1u); break; } }
    }
    nloc = mine > 0u ? mine : 1u; nx = cnt > 0u ? cnt : 1u;
}

__device__ __forceinline__ void xcd_barrier(const XcdBarrier& b) {
    asm volatile("s_waitcnt vmcnt(0)" ::: "memory");
    __syncthreads();
    if (threadIdx.x == 0) {
        unsigned* bar = b.bar;
        __builtin_amdgcn_s_waitcnt(0);
        unsigned nloc = b.st[0], nx = b.st[1];
        if (nloc == 0u) { xcd_barrier_complete(bar, b.x, nloc, nx); b.st[0] = nloc; b.st[1] = nx; }
        const unsigned old = xb_add(&bar[XB_XSUB(b.x)], 1u);
        const unsigned gen = old / nloc;
        if (old + 1u == (gen + 1u) * nloc) {
            __builtin_amdgcn_fence(__ATOMIC_RELEASE, "agent");
            asm volatile("s_waitcnt vmcnt(0)" ::: "memory");
            const unsigned og = xb_add(&bar[XB_TOP], 1u);
            const unsigned tg = og / nx;
            if (og + 1u == (tg + 1u) * nx) xb_add(&bar[XB_TOPGEN], 1u);
            else XB_SPIN(xb_ld(&bar[XB_TOPGEN]) == tg, bar);
            __builtin_amdgcn_fence(__ATOMIC_ACQUIRE, "agent");
            xb_add(&bar[XB_XGEN(b.x)], 1u);
            asm volatile("s_waitcnt vmcnt(0)" ::: "memory");
        } else {
            XB_SPIN(xb_ld(&bar[XB_XGEN(b.x)]) == gen, bar);
            __builtin_amdgcn_fence(__ATOMIC_ACQUIRE, "agent");
            asm volatile("s_waitcnt vmcnt(0)" ::: "memory");
        }
    }
    __syncthreads();
}


DI int xcd_swizzle(int t, int nb, int ntiles) {
  const int r = t / nb;
  if ((nb & 7) || (r + 1) * nb > ntiles) return t;
  const int b = t - r * nb, per = nb >> 3;
  return r * nb + (b & 7) * per + (b >> 3);
}

constexpr int NPHASE = 26;
constexpr int SMEM_BYTES = 2 * GBUF;

DI void run_phase(const Params& p, int ph, char* lds) {
  const int bid = blockIdx.x, nb = gridDim.x, wave = threadIdx.x >> 6;
  if (ph == 0) {
    for (int t = bid; t < 192 + 512 + CONV1_TASKS; t += nb) {
      if (t < 192) task_mod(p, t, lds); else if (t < 704) task_rope(p, t - 192); else task_conv1(p, 0, t - 704, lds);
    }
    return;
  }
  if (ph == 25) { for (int t = bid; t < NLAT / 16; t += nb) task_final_norm(p, t); return; }
  const int l = (ph - 1) / 12; int sp = (ph - 1) % 12;
  const bool last = l == 1;
  const int mtiles = last ? 128 : 136;
  if (sp >= 7) sp = (sp == 7) ? 11 : sp - 1;
  switch (sp) {
    case 0: for (int t = bid; t < NTOK / 16; t += nb) task_norm(p, l, t, 0); break;
    case 1: {
      for (int t = bid; t < 136 * 15; t += nb) task_g1(p, l, xcd_swizzle(t, nb, 136 * 15), lds);
      for (int t = (bid + nb - ((136 * 15) % nb)) % nb; t < 136; t += nb) task_g1_tail(p, l, t, lds);
    } break;
    case 2: for (int t = bid; t < 1024; t += nb) task_gla<1>(p, l, xcd_swizzle(t, nb, 1024), lds); break;
    case 3: {
      for (int t = bid; t < 64; t += nb) task_gla_prefix(p, t);
      for (int t = bid; t < 512; t += nb) attn_a_latent(p, l, xcd_swizzle(t, nb, 512) * 4 + wave);
      if (!last) for (int t = bid; t < 32; t += nb) attn_ctx(p, l, (31 - t) * 4 + wave, 0);
    } break;
    case 4: for (int t = bid; t < 1088; t += nb) task_gla<2>(p, l, xcd_swizzle(t, nb, 1088), lds); break;
    case 5: {
      __syncthreads();
      for (int t = bid; t < 512; t += nb) attn_c_latent(p, l, xcd_swizzle(t, nb, 512) * 4 + wave, lds);
      if (!last) for (int t = bid; t < 32; t += nb) attn_ctx(p, l, t * 4 + wave, 1);
      for (int t = bid; t < (last ? NLAT : NTOK) / 16; t += nb) task_gla_out(p, l, t);
    } break;
    case 6: for (int t = bid; t < mtiles * 12; t += nb) task_gates(p, l, xcd_swizzle(t, nb, mtiles * 12), lds); break;
    case 11: for (int t = bid; t < mtiles * 8; t += nb) task_mg(p, l, xcd_swizzle(t, nb, mtiles * 8), lds); break;
    case 7: {
      for (int t = bid; t < 512; t += nb) task_res_wide(p, l, xcd_swizzle(t, nb, 512), (const u16*)(p.ws + OFF_MIXED), D, (const u16*)(p.ws + OFF_WOUT), D, 2, true, lds);
      if (!last) for (int t = bid; t < 128; t += nb) task_res_ctx(p, l, t, (const u16*)(p.ws + OFF_MIXED), D, (const u16*)(p.ws + OFF_WOUT), D, 2, true, lds);
      for (int t = (bid + nb - (last ? 0 : 128)) % nb; t < CONV2_TASKS; t += nb) task_conv2(p, l, t, lds);
    } break;
    case 8: for (int t = bid; t < (last ? NLAT : NTOK) / 16; t += nb) task_norm(p, l, t, 1); break;
    case 9: for (int t = bid; t < mtiles * 22; t += nb) task_f1(p, xcd_swizzle(t, nb, mtiles * 22), lds); break;
    case 10: {
      for (int t = bid; t < 512; t += nb) task_res_wide(p, l, xcd_swizzle(t, nb, 512), (const u16*)(p.ws + OFF_ACT), FH, (const u16*)(p.ws + OFF_WF2), FH, 5, false, lds);
      if (!last) {
        for (int t = bid; t < 128; t += nb) task_res_ctx(p, l, t, (const u16*)(p.ws + OFF_ACT), FH, (const u16*)(p.ws + OFF_WF2), FH, 5, false, lds);
        for (int t = (bid + nb - 128) % nb; t < CONV1_TASKS; t += nb) task_conv1(p, 1, t, lds);
      }
    } break;
  }
}

#if MULTI_LAUNCH
__global__ void __launch_bounds__(256, 2) k_phase(Params p, int ph) {
  __shared__ __attribute__((aligned(16))) char smem[SMEM_BYTES];
  run_phase(p, ph, smem);
}
#endif

#if !MULTI_LAUNCH
__global__ void __launch_bounds__(256, 2) k_mega(Params p) {
  extern __shared__ __attribute__((aligned(16))) char smem[];
  __shared__ uint4 xb_words;
  if (threadIdx.x == 0) xb_words = make_uint4(0u, 0u, 0u, 0u);
  __syncthreads();
  XcdBarrier xb = xcd_barrier_post((unsigned*)(p.ws + OFF_BAR), (volatile LAS unsigned*)&xb_words);
  if (p.ws == nullptr) cg::this_grid().sync();
#define PH(k) run_phase(p, k, smem); xcd_barrier(xb);
  PH(0) PH(1) PH(2) PH(3) PH(4) PH(5) PH(6) PH(7) PH(8) PH(9) PH(10) PH(11) PH(12) PH(13) PH(14) PH(15) PH(16) PH(17) PH(18) PH(19) PH(20) PH(21) PH(22) PH(23) PH(24)
  run_phase(p, 25, smem);
}
#endif

extern "C" void kernel_launch(void* const* d_in, const int* in_sizes, int n_in, void* d_out, int out_size, void* d_ws, size_t ws_size,
                              hipStream_t stream) {
  Params p{};
  const float** f = (const float**)&p;
  for (int i = 0; i < 25; i++) f[i] = (const float*)d_in[i];
  p.out = (float*)d_out;
  p.ws = (char*)d_ws;
#if MULTI_LAUNCH
  for (int ph = 0; ph < NPHASE; ph++) hipLaunchKernelGGL(k_phase, dim3(512), dim3(256), 0, stream, p, ph);
#else
  static int grid_blocks = 0;
  if (!grid_blocks) {
    int dev = 0, cus = 0, per_cu = 0;
    hipGetDevice(&dev);
    hipDeviceGetAttribute(&cus, hipDeviceAttributeMultiprocessorCount, dev);
    (void)hipFuncSetAttribute((const void*)k_mega, hipFuncAttributeMaxDynamicSharedMemorySize, SMEM_BYTES);
    (void)hipOccupancyMaxActiveBlocksPerMultiprocessor(&per_cu, k_mega, 256, SMEM_BYTES);
    if (per_cu > 2) per_cu = 2;
    if (per_cu < 1) per_cu = 1;
    grid_blocks = cus * per_cu;
  }
  hipMemsetAsync((char*)d_ws + OFF_BAR, 0, XCD_BAR_WORDS * 4, stream);
  void* args[] = {&p};
  hipError_t e = hipLaunchCooperativeKernel((void*)k_mega, dim3(grid_blocks), dim3(256), args, SMEM_BYTES, stream);
  if (e != hipSuccess) fprintf(stderr, "cooperative launch failed: %s (grid %d)\n", hipGetErrorString(e), grid_blocks);
#endif
}
```

```cpp
#include <hip/hip_runtime.h>
#include <hip/hip_cooperative_groups.h>
#include <cstdio>
namespace cg = cooperative_groups;

#ifndef MULTI_LAUNCH
#define MULTI_LAUNCH 0
#endif

typedef unsigned short u16;
using bf16x8 = __attribute__((ext_vector_type(8))) short;
using s16x4  = __attribute__((ext_vector_type(4))) short;
using f32x4  = __attribute__((ext_vector_type(4))) float;
#define DI __device__ __forceinline__
#define MFMA16(a, b, c) __builtin_amdgcn_mfma_f32_16x16x32_bf16((a), (b), (c), 0, 0, 0)

constexpr int D = 1024, NB = 4, SEQ = 4096, LC = 256, NLAT = NB * SEQ, NCTX = NB * LC, NTOK = NLAT + NCTX;
constexpr int INT = 3872, INTP = 3968, FH = 2816, PNLD = 2720, VTR = 1152;
constexpr float LOG2E = 1.4426950408889634f;

constexpr size_t OFF_WIN  = 0;
constexpr size_t OFF_WMG  = OFF_WIN + (size_t)INTP * D * 2;
constexpr size_t OFF_WBR  = OFF_WMG + (size_t)3072 * D * 2;
constexpr size_t OFF_WOUT = OFF_WBR + (size_t)3 * 1024 * 512 * 2;
constexpr size_t OFF_WF1  = OFF_WOUT + (size_t)D * D * 2;
constexpr size_t OFF_WF2  = OFF_WF1 + (size_t)2 * FH * D * 2;
constexpr size_t OFF_PAD  = OFF_WF2 + (size_t)D * FH * 2;
constexpr size_t OFF_MOD  = OFF_PAD + (1u << 20);
constexpr size_t OFF_ROPE = OFF_MOD + (size_t)2 * 5 * 6144 * 4;
constexpr size_t OFF_XC   = OFF_ROPE + (size_t)SEQ * 32 * 2 * 4;
constexpr size_t OFF_HB   = OFF_XC + (size_t)NCTX * D * 4;
constexpr size_t OFF_PN   = OFF_HB + (size_t)NTOK * D * 2;
constexpr size_t OFF_VT   = OFF_PN + (size_t)NTOK * PNLD * 2;
constexpr size_t OFF_VTC  = OFF_VT + (size_t)NB * VTR * SEQ * 2;
constexpr size_t OFF_Y    = OFF_VTC + (size_t)NB * VTR * LC * 2;
constexpr size_t WS_END   = OFF_Y + (size_t)3 * NTOK * 512 * 2;
static_assert(WS_END <= ((size_t)256 << 20), "workspace too large");
constexpr size_t OFF_OB    = OFF_WF1;
static_assert(OFF_OB + (size_t)NTOK * 512 * 2 <= OFF_MOD, "o_b alias");
constexpr size_t OFF_BAR   = OFF_PAD + (768u << 10);
constexpr size_t OFF_MIXED = OFF_PN;
constexpr size_t OFF_ACT   = OFF_PN + (size_t)NTOK * D * 2;
static_assert(OFF_ACT + (size_t)NTOK * FH * 2 <= OFF_Y, "act alias");

struct Params {
  const float *x, *c, *ctx, *c_ctx, *w_ada, *b_ada, *norm_mix, *w_in, *sink, *gw_f, *gb_f, *gw_b, *gb_b, *gla_norm, *rpb,
      *w_ba, *w_bb, *w_bc, *w_merge, *b_merge, *w_out, *norm_ffn, *w_ffn_in, *w_ffn_out, *final_norm;
  float* out;
  char* ws;
};

typedef __bf16 bf2_t __attribute__((ext_vector_type(2)));
DI u16 f2bf(float x) { __bf16 v = (__bf16)x; return __builtin_bit_cast(u16, v); }
DI float bf2f(u16 h) { return __uint_as_float(((unsigned)h) << 16); }
DI unsigned pack2(float a, float b) { bf2_t v = {(__bf16)a, (__bf16)b}; return __builtin_bit_cast(unsigned, v); }
DI float wave_sum(float v) { for (int o = 32; o; o >>= 1) v += __shfl_xor(v, o, 64); return v; }
DI float sigmoidf_(float x) { return __builtin_amdgcn_rcpf(1.0f + __expf(-x)); }
DI float siluf_(float x) { return x * __builtin_amdgcn_rcpf(1.0f + __expf(-x)); }

DI const float* xsrc(const Params& p, int l, int row) {
  if (row < NLAT) return (l == 0 ? p.x : p.out) + (size_t)row * D;
  return (l == 0 ? p.ctx : (const float*)(p.ws + OFF_XC)) + (size_t)(row - NLAT) * D;
}
DI float* xdst(const Params& p, int row) {
  if (row < NLAT) return p.out + (size_t)row * D;
  return (float*)(p.ws + OFF_XC) + (size_t)(row - NLAT) * D;
}
DI const float* modp(const Params& p, int l, int row) {
  int s = row < NLAT ? (row >> 12) : 4;
  return (const float*)(p.ws + OFF_MOD) + (size_t)(l * 5 + s) * 6144;
}

constexpr int LROW = 144;
constexpr int LDS_A = 0, LDS_B = 128 * LROW;

constexpr int GROW = 128;
constexpr int G_A = 0, G_B = 128 * GROW;
constexpr int GBUF = 2 * 128 * GROW;
template <int NI, int CH>
DI void gemm_tile(const u16* __restrict__ A, int lda, const u16* __restrict__ Bt, int ldb, int K,
                  f32x4 (&acc)[4][NI], char* lds) {
  const int tid = threadIdx.x, lane = tid & 63, wave = tid >> 6;
  const int wm = wave >> 1, wn = wave & 1, g = lane >> 4, n = lane & 15;
  const int lrow = tid >> 3, lkc = tid & 7;
  const u16* ap = CH ? A + (size_t)lrow * 32 + (size_t)(lkc >> 2) * lda * 32 + (lkc & 3) * 8 : A + (size_t)lrow * lda + lkc * 8;
  const u16* bp = CH ? Bt + (size_t)lrow * 32 + (size_t)(lkc >> 2) * ldb * 32 + (lkc & 3) * 8 : Bt + (size_t)lrow * ldb + lkc * 8;
  const size_t sa = CH ? (size_t)32 * 32 : (size_t)32 * lda, sb = CH ? (size_t)32 * 32 : (size_t)32 * ldb;
  const size_t ka = CH ? (size_t)lda : 1, kb = CH ? (size_t)ldb : 1;
  const int wsw = (lkc ^ ((lrow >> 1) & 7)) * 16;
  const int rsw0 = (g ^ ((n >> 1) & 7)) * 16, rsw1 = ((4 + g) ^ ((n >> 1) & 7)) * 16;
  uint4 ra0, ra1, ra2, ra3, rb0, rb1, rb2, rb3;
#define GLOADS(kk)                                                                                                   \
  {                                                                                                                  \
    ra0 = *(const uint4*)(ap + (kk) * ka); ra1 = *(const uint4*)(ap + sa + (kk) * ka);                               \
    ra2 = *(const uint4*)(ap + 2 * sa + (kk) * ka); ra3 = *(const uint4*)(ap + 3 * sa + (kk) * ka);                  \
    rb0 = *(const uint4*)(bp + (kk) * kb); rb1 = *(const uint4*)(bp + sb + (kk) * kb);                               \
    if (NI == 4) { rb2 = *(const uint4*)(bp + 2 * sb + (kk) * kb); rb3 = *(const uint4*)(bp + 3 * sb + (kk) * kb); } \
  }
#define LSTORES(buf)                                                                                                 \
  {                                                                                                                  \
    char* wa_ = lds + (buf) * GBUF + G_A + lrow * GROW + wsw;                                                        \
    char* wb_ = lds + (buf) * GBUF + G_B + lrow * GROW + wsw;                                                        \
    *(uint4*)(wa_) = ra0; *(uint4*)(wa_ + 32 * GROW) = ra1; *(uint4*)(wa_ + 64 * GROW) = ra2; *(uint4*)(wa_ + 96 * GROW) = ra3; \
    *(uint4*)(wb_) = rb0; *(uint4*)(wb_ + 32 * GROW) = rb1;                                                          \
    if (NI == 4) { *(uint4*)(wb_ + 64 * GROW) = rb2; *(uint4*)(wb_ + 96 * GROW) = rb3; }                             \
  }
  GLOADS(0);
  __syncthreads();
  LSTORES(0);
  GLOADS(64);
  __syncthreads();
  const int nk = K >> 6;
#pragma unroll 1
  for (int it = 0; it < nk; it++) {
    const int cur = it & 1;
    if (it + 1 < nk) LSTORES(cur ^ 1);
    if (it + 2 < nk) GLOADS((it + 2) * 64);
    const char* fa = lds + cur * GBUF + G_A + (wm * 64 + n) * GROW;
    const char* fb = lds + cur * GBUF + G_B + (wn * 16 * NI + n) * GROW;
#pragma unroll
    for (int ks = 0; ks < 2; ks++) {
      const int rsw = ks ? rsw1 : rsw0;
      bf16x8 af[4], bfr[NI];
#pragma unroll
      for (int i = 0; i < 4; i++) af[i] = *(const bf16x8*)(fa + i * 16 * GROW + rsw);
#pragma unroll
      for (int i = 0; i < NI; i++) bfr[i] = *(const bf16x8*)(fb + i * 16 * GROW + rsw);
#pragma unroll
      for (int mi = 0; mi < 4; mi++)
#pragma unroll
        for (int ni = 0; ni < NI; ni++) acc[mi][ni] = MFMA16(af[mi], bfr[ni], acc[mi][ni]);
    }
    __syncthreads();
  }
#undef GLOADS
#undef LSTORES
}

template <int NI>
DI void zero_acc(f32x4 (&acc)[4][NI]) {
#pragma unroll
  for (int i = 0; i < 4; i++)
#pragma unroll
    for (int j = 0; j < NI; j++) acc[i][j] = f32x4{0.f, 0.f, 0.f, 0.f};
}

constexpr int LROW2 = 64;
constexpr int W_A = 0, W_B = 128 * LROW2, WBUF = 384 * LROW2;
DI void gemm_wide(const u16* __restrict__ A, int lda, const u16* __restrict__ Bt, int ldb, int K, f32x4 (&acc)[4][8], char* lds) {
  const int tid = threadIdx.x, lane = tid & 63, wave = tid >> 6;
  const int wm = wave >> 1, wn = wave & 1, g = lane >> 4, n = lane & 15;
  const int lrow = tid >> 2, lkc = tid & 3;
  const u16* ap = A + (size_t)lrow * 32 + lkc * 8;
  const u16* bp = Bt + (size_t)lrow * 32 + lkc * 8;
  const size_t sa = (size_t)64 * 32, sb = (size_t)64 * 32;
  const size_t ka = (size_t)lda, kb = (size_t)ldb;
  uint4 ra0, ra1, rb0, rb1, rb2, rb3;
  const int wsw = (lkc ^ ((0 - (lrow >> 2)) & 3)) * 16;
  const int rsw = (g ^ ((0 - (n >> 2)) & 3)) * 16;
#define GLOADS(kk)                                                                           \
  {                                                                                          \
    ra0 = *(const uint4*)(ap + (kk) * ka); ra1 = *(const uint4*)(ap + sa + (kk) * ka);       \
    rb0 = *(const uint4*)(bp + (kk) * kb); rb1 = *(const uint4*)(bp + sb + (kk) * kb);       \
    rb2 = *(const uint4*)(bp + 2 * sb + (kk) * kb); rb3 = *(const uint4*)(bp + 3 * sb + (kk) * kb); \
  }
#define LSTORES(buf)                                                                         \
  {                                                                                          \
    char* wa_ = lds + (buf) * WBUF + W_A + lrow * LROW2 + wsw;                               \
    char* wb_ = lds + (buf) * WBUF + W_B + lrow * LROW2 + wsw;                               \
    *(uint4*)(wa_) = ra0; *(uint4*)(wa_ + 64 * LROW2) = ra1;                                 \
    *(uint4*)(wb_) = rb0; *(uint4*)(wb_ + 64 * LROW2) = rb1;                                 \
    *(uint4*)(wb_ + 128 * LROW2) = rb2; *(uint4*)(wb_ + 192 * LROW2) = rb3;                  \
  }
#define HALF(h)                                                                              \
  {                                                                                          \
    bf16x8 bfr[4];                                                                           \
    _Pragma("unroll") for (int i = 0; i < 4; i++) bfr[i] = *(const bf16x8*)(fb + ((h) * 4 + i) * 16 * LROW2); \
    _Pragma("unroll") for (int mi = 0; mi < 4; mi++)                                         \
      _Pragma("unroll") for (int ni = 0; ni < 4; ni++) acc[mi][(h) * 4 + ni] = MFMA16(af[mi], bfr[ni], acc[mi][(h) * 4 + ni]); \
  }
  GLOADS(0);
  __syncthreads();
  LSTORES(0);
  GLOADS(32);
  __syncthreads();
  const int nk = K >> 5;
#pragma unroll 1
  for (int it = 0; it < nk; it++) {
    const int cur = it & 1;
    const char* fa = lds + cur * WBUF + W_A + (wm * 64 + n) * LROW2 + rsw;
    const char* fb = lds + cur * WBUF + W_B + (wn * 128 + n) * LROW2 + rsw;
    bf16x8 af[4];
#pragma unroll
    for (int i = 0; i < 4; i++) af[i] = *(const bf16x8*)(fa + i * 16 * LROW2);
    HALF(0);
    if (it + 1 < nk) LSTORES(cur ^ 1);
    if (it + 2 < nk) GLOADS((it + 2) * 32);
    HALF(1);
    __syncthreads();
  }
#undef GLOADS
#undef LSTORES
#undef HALF
}

DI void task_mod(const Params& p, int task, char* lds) {
  const int tid = threadIdx.x, lane = tid & 63, wave = tid >> 6;
  const int l = task / 96, cb = task % 96;
  float* sc = (float*)lds;
  float* red = sc + 5 * 1024;
  __syncthreads();
  for (int i = tid; i < 5 * 1024; i += 256) {
    int s = i >> 10, k = i & 1023;
    float v = s < 4 ? p.c[s * 1024 + k] : p.c_ctx[k];
    sc[i] = siluf_(v);
  }
  __syncthreads();
  const int ncol = cb * 64 + lane;
  const float* w = p.w_ada + (size_t)l * 1024 * 6144 + ncol;
  float a0 = 0, a1 = 0, a2 = 0, a3 = 0, a4 = 0;
#pragma unroll 16
  for (int k = wave * 256; k < wave * 256 + 256; k++) {
    float wv = w[(size_t)k * 6144];
    a0 += sc[k] * wv; a1 += sc[1024 + k] * wv; a2 += sc[2048 + k] * wv; a3 += sc[3072 + k] * wv; a4 += sc[4096 + k] * wv;
  }
  red[(wave * 5 + 0) * 64 + lane] = a0; red[(wave * 5 + 1) * 64 + lane] = a1; red[(wave * 5 + 2) * 64 + lane] = a2;
  red[(wave * 5 + 3) * 64 + lane] = a3; red[(wave * 5 + 4) * 64 + lane] = a4;
  __syncthreads();
  float* mod = (float*)(p.ws + OFF_MOD);
  for (int i = tid; i < 320; i += 256) {
    int s = i >> 6, ln = i & 63;
    float v = red[(0 * 5 + s) * 64 + ln] + red[(1 * 5 + s) * 64 + ln] + red[(2 * 5 + s) * 64 + ln] + red[(3 * 5 + s) * 64 + ln];
    int nc = cb * 64 + ln;
    mod[(size_t)(l * 5 + s) * 6144 + nc] = v + p.b_ada[l * 6144 + nc];
  }
}

DI void task_rope(const Params& p, int task) {
  int e = task * 256 + threadIdx.x;
  int t = e >> 5, i = e & 31;
  float pos = (i < 16) ? (float)(t >> 6) : (float)(t & 63);
  float inv = exp2f(-(float)(i & 15) * (13.287712379549449f / 16.0f));
  float ang = pos * inv;
  float kq = rintf(ang * 0.15915494309189535f);
  float rr = fmaf(-kq, 6.28125f, ang);
  rr = fmaf(-kq, 0.0019353071795864769f, rr);
  float s = sinf(rr), c = cosf(rr);
  float* rc = (float*)(p.ws + OFF_ROPE);
  rc[e] = c; rc[SEQ * 32 + e] = s;
}

DI void conv_tile(const float* __restrict__ src, int K, int N, int kt, int nt, u16* __restrict__ dst, int mode, int R, char* lds) {
  float* tile = (float*)lds;
  const int tid = threadIdx.x;
  const int k0 = kt * 128, n0 = nt * 64;
  __syncthreads();
  {
    float4 v[8];
#pragma unroll
    for (int i = 0; i < 8; i++) {
      int idx = tid + 256 * i, kk = idx >> 4, n4 = (idx & 15) * 4;
      v[i] = float4{0.f, 0.f, 0.f, 0.f};
      if (n0 + n4 < N) {
        const f32x4 w = __builtin_nontemporal_load((const f32x4*)(src + (size_t)(k0 + kk) * N + n0 + n4));
        v[i] = float4{w[0], w[1], w[2], w[3]};
      }
    }
#pragma unroll
    for (int i = 0; i < 8; i++) {
      int idx = tid + 256 * i, kk = idx >> 4, n4 = (idx & 15) * 4;
      float* t = tile + kk * 65 + n4;
      t[0] = v[i].x; t[1] = v[i].y; t[2] = v[i].z; t[3] = v[i].w;
    }
  }
  __syncthreads();
#pragma unroll
  for (int i = 0; i < 4; i++) {
    int cidx = tid + 256 * i, nn = cidx >> 4, kc = cidx & 15;
    int ncol = n0 + nn;
    if (ncol < N) {
      int drow = ncol;
      if (mode == 1) {
        int up = ncol >= FH, j = up ? ncol - FH : ncol;
        drow = (j >> 7) * 256 + ((j >> 6) & 1) * 128 + up * 64 + (j & 63);
      }
      uint4 o;
      o.x = pack2(tile[(kc * 8 + 0) * 65 + nn], tile[(kc * 8 + 1) * 65 + nn]);
      o.y = pack2(tile[(kc * 8 + 2) * 65 + nn], tile[(kc * 8 + 3) * 65 + nn]);
      o.z = pack2(tile[(kc * 8 + 4) * 65 + nn], tile[(kc * 8 + 5) * 65 + nn]);
      o.w = pack2(tile[(kc * 8 + 6) * 65 + nn], tile[(kc * 8 + 7) * 65 + nn]);
      const int kd = k0 + kc * 8;
      if (R > 0) *(uint4*)(dst + ((size_t)(kd >> 5) * R + drow) * 32 + (kd & 31)) = o;
      else *(uint4*)(dst + (size_t)drow * K + kd) = o;
    }
  }
}

constexpr int CONV1_TASKS = 488 + 384 + 192 + 128 + 1;
constexpr int CONV2_TASKS = 704 + 352;
DI void task_conv1(const Params& p, int l, int t, char* lds) {
  if (t < 488) { conv_tile(p.w_in + (size_t)l * D * INT, D, INT, t / 61, t % 61, (u16*)(p.ws + OFF_WIN), 0, INTP, lds); return; }
  t -= 488;
  if (t < 384) { conv_tile(p.w_merge + (size_t)l * D * 3072, D, 3072, t / 48, t % 48, (u16*)(p.ws + OFF_WMG), 0, 3072, lds); return; }
  t -= 384;
  if (t < 192) {
    int br = t / 64, tt = t % 64;
    const float* src = (br == 0 ? p.w_ba : br == 1 ? p.w_bb : p.w_bc) + (size_t)l * 512 * D;
    conv_tile(src, 512, D, tt / 16, tt % 16, (u16*)(p.ws + OFF_WBR) + (size_t)br * 1024 * 512, 0, 0, lds);
    return;
  }
  t -= 192;
  if (t < 128) { conv_tile(p.w_out + (size_t)l * D * D, D, D, t / 16, t % 16, (u16*)(p.ws + OFF_WOUT), 0, D, lds); return; }
  uint4 z = {0, 0, 0, 0};
  for (int i = threadIdx.x; i < 32 * (INTP - INT) * 4; i += 256) {
    const int ch = i / ((INTP - INT) * 4), off = i % ((INTP - INT) * 4);
    *(uint4*)((u16*)(p.ws + OFF_WIN) + ((size_t)ch * INTP + INT) * 32 + off * 8) = z;
  }
}
DI void task_conv2(const Params& p, int l, int t, char* lds) {
  if (t < 704) { conv_tile(p.w_ffn_in + (size_t)l * D * 2 * FH, D, 2 * FH, t / 88, t % 88, (u16*)(p.ws + OFF_WF1), 1, 2 * FH, lds); return; }
  t -= 704;
  conv_tile(p.w_ffn_out + (size_t)l * FH * D, FH, D, t / 16, t % 16, (u16*)(p.ws + OFF_WF2), 0, D, lds);
}

DI void task_norm(const Params& p, int l, int task, int which) {
  const int lane = threadIdx.x & 63, wave = threadIdx.x >> 6;
  const int row0 = task * 16 + wave * 4;
  const float* g = (which == 0 ? p.norm_mix : p.norm_ffn) + l * D;
  const float* md = modp(p, l, row0) + (which ? 3 * D : 0);
  float4 v[4][4];
#pragma unroll
  for (int r = 0; r < 4; r++) {
    const float* xr = which == 0 ? xsrc(p, l, row0 + r) : (const float*)xdst(p, row0 + r);
#pragma unroll
    for (int i = 0; i < 4; i++) v[r][i] = *(const float4*)(xr + i * 256 + lane * 4);
  }
  float rstd[4];
#pragma unroll
  for (int r = 0; r < 4; r++) {
    float ss = 0.f;
#pragma unroll
    for (int i = 0; i < 4; i++) ss += v[r][i].x * v[r][i].x + v[r][i].y * v[r][i].y + v[r][i].z * v[r][i].z + v[r][i].w * v[r][i].w;
    ss = wave_sum(ss);
    rstd[r] = rsqrtf(ss * (1.0f / 1024.0f) + 1e-6f);
  }
  u16* hb = (u16*)(p.ws + OFF_HB) + (size_t)row0 * 32;
#pragma unroll
  for (int i = 0; i < 4; i++) {
    const int cidx = i * 256 + lane * 4;
    const float4 gg = *(const float4*)(g + cidx), sh = *(const float4*)(md + cidx), sc = *(const float4*)(md + D + cidx);
    const float a0 = gg.x * (1.f + sc.x), a1 = gg.y * (1.f + sc.y), a2 = gg.z * (1.f + sc.z), a3 = gg.w * (1.f + sc.w);
#pragma unroll
    for (int r = 0; r < 4; r++) {
      uint2 o;
      o.x = pack2(v[r][i].x * rstd[r] * a0 + sh.x, v[r][i].y * rstd[r] * a1 + sh.y);
      o.y = pack2(v[r][i].z * rstd[r] * a2 + sh.z, v[r][i].w * rstd[r] * a3 + sh.w);
      *(uint2*)(hb + (size_t)(cidx >> 5) * NTOK * 32 + r * 32 + (cidx & 31)) = o;
    }
  }
}
DI void task_final_norm(const Params& p, int task) {
  const int lane = threadIdx.x & 63, wave = threadIdx.x >> 6;
  float* xr = p.out + (size_t)(task * 16 + wave * 4) * D;
  float4 v[4][4];
#pragma unroll
  for (int r = 0; r < 4; r++)
#pragma unroll
    for (int i = 0; i < 4; i++) v[r][i] = *(const float4*)(xr + (size_t)r * D + i * 256 + lane * 4);
  float rstd[4];
#pragma unroll
  for (int r = 0; r < 4; r++) {
    float ss = 0.f;
#pragma unroll
    for (int i = 0; i < 4; i++) ss += v[r][i].x * v[r][i].x + v[r][i].y * v[r][i].y + v[r][i].z * v[r][i].z + v[r][i].w * v[r][i].w;
    ss = wave_sum(ss);
    rstd[r] = rsqrtf(ss * (1.0f / 1024.0f) + 1e-6f);
  }
#pragma unroll
  for (int i = 0; i < 4; i++) {
    const int cidx = i * 256 + lane * 4;
    const float4 gg = *(const float4*)(p.final_norm + cidx);
#pragma unroll
    for (int r = 0; r < 4; r++) {
      float4 o = {v[r][i].x * rstd[r] * gg.x, v[r][i].y * rstd[r] * gg.y, v[r][i].z * rstd[r] * gg.z, v[r][i].w * rstd[r] * gg.w};
      *(float4*)(xr + (size_t)r * D + cidx) = o;
    }
  }
}

DI void task_g1(const Params& p, int l, int tile, char* lds) {
  const int mt = tile / 15, nt = tile % 15;
  const int tid = threadIdx.x, lane = tid & 63, wave = tid >> 6;
  const int wm = wave >> 1, wn = wave & 1, g = lane >> 4, n = lane & 15;
  f32x4 acc[4][8];
#pragma unroll
  for (int i = 0; i < 4; i++)
#pragma unroll
    for (int j = 0; j < 8; j++) acc[i][j] = f32x4{0.f, 0.f, 0.f, 0.f};
  gemm_wide((const u16*)(p.ws + OFF_HB) + (size_t)mt * 128 * 32, NTOK, (const u16*)(p.ws + OFF_WIN) + (size_t)nt * 256 * 32, INTP, D, acc, lds);
  const int cw = nt * 256 + wn * 128;
  const int rw = mt * 128 + wm * 64;
  if (mt < 128) {
    const float* rc = (const float*)(p.ws + OFF_ROPE);
    const float* rs = rc + SEQ * 32;
#pragma unroll
    for (int hh = 0; hh < 2; hh++) {
      if (cw + hh * 64 >= 640) continue;
#pragma unroll
      for (int mi = 0; mi < 4; mi++)
#pragma unroll
        for (int ni = 0; ni < 2; ni++)
#pragma unroll
          for (int r = 0; r < 4; r++) {
            int t = (rw + mi * 16 + 4 * g + r) & 4095;
            float c = rc[t * 32 + ni * 16 + n], sn = rs[t * 32 + ni * 16 + n];
            float x1 = acc[mi][hh * 4 + ni][r], x2 = acc[mi][hh * 4 + ni + 2][r];
            acc[mi][hh * 4 + ni][r] = x1 * c - x2 * sn;
            acc[mi][hh * 4 + ni + 2][r] = x1 * sn + x2 * c;
          }
    }
  }
  u16* PN = (u16*)(p.ws + OFF_PN);
  u16* VT = (u16*)(p.ws + OFF_VT);
  u16* VTc = (u16*)(p.ws + OFF_VTC);
#pragma unroll
  for (int ni = 0; ni < 8; ni++) {
    const int c16 = cw + ni * 16;
    if (c16 >= INT) continue;
    int tr = -1, nat = 0;
    if (c16 < 640) nat = c16;
    else if (c16 < 768) tr = c16 - 640;
    else if (c16 < 1280) nat = c16 - 128;
    else if (c16 < 1792) tr = 128 + c16 - 1280;
    else if (c16 < 3360) nat = c16 - 640;
    else tr = 640 + c16 - 3360;
#pragma unroll
    for (int mi = 0; mi < 4; mi++) {
      const int row0 = rw + mi * 16 + 4 * g;
      if (tr < 0) {
#pragma unroll
        for (int r = 0; r < 4; r++) PN[(size_t)(row0 + r) * PNLD + nat + n] = f2bf(acc[mi][ni][r]);
      } else {
        uint2 o; o.x = pack2(acc[mi][ni][0], acc[mi][ni][1]); o.y = pack2(acc[mi][ni][2], acc[mi][ni][3]);
        if (mt < 128) {
          int b = row0 >> 12, tok = row0 & 4095;
          *(uint2*)(VT + ((size_t)(b * VTR + tr + n)) * SEQ + tok) = o;
        } else {
          int rr = row0 - NLAT, b = rr >> 8, tok = rr & 255;
          *(uint2*)(VTc + ((size_t)(b * VTR + tr + n)) * LC + tok) = o;
        }
      }
    }
  }
}

DI void task_g1_tail(const Params& p, int l, int mt, char* lds) {
  const int tid = threadIdx.x, lane = tid & 63, wave = tid >> 6;
  const int wm = wave >> 1, wn = wave & 1, g = lane >> 4, n = lane & 15;
  f32x4 acc[4][2];
  zero_acc<2>(acc);
  gemm_tile<2, 1>((const u16*)(p.ws + OFF_HB) + (size_t)mt * 128 * 32, NTOK, (const u16*)(p.ws + OFF_WIN) + (size_t)3840 * 32, INTP, D, acc, lds);
  if (wn != 0) return;
  u16* VT = (u16*)(p.ws + OFF_VT);
  u16* VTc = (u16*)(p.ws + OFF_VTC);
#pragma unroll
  for (int ni = 0; ni < 2; ni++) {
    const int tr = 640 + (3840 - 3360) + ni * 16;
#pragma unroll
    for (int mi = 0; mi < 4; mi++) {
      const int row0 = mt * 128 + wm * 64 + mi * 16 + 4 * g;
      uint2 o; o.x = pack2(acc[mi][ni][0], acc[mi][ni][1]); o.y = pack2(acc[mi][ni][2], acc[mi][ni][3]);
      if (mt < 128) {
        int b = row0 >> 12, tok = row0 & 4095;
        *(uint2*)(VT + ((size_t)(b * VTR + tr + n)) * SEQ + tok) = o;
      } else {
        int rr = row0 - NLAT, b = rr >> 8, tok = rr & 255;
        *(uint2*)(VTc + ((size_t)(b * VTR + tr + n)) * LC + tok) = o;
      }
    }
  }
}

constexpr float QSC = 0.125f * LOG2E;

template <class QF, class OF, class M0F, class TileFn, class ScoreFn, class SkipFn>
DI void attn_core4(QF qptr, OF optr, M0F m0f, float l0, int ntiles, TileFn tilefn, ScoreFn scorefn, SkipFn skipfn) {
  const int lane = threadIdx.x & 63, g = lane >> 4, n = lane & 15;
  bf16x8 qf[4][2];
  f32x4 o[4][4];
  float m[4], ls[4];
#pragma unroll
  for (int gi = 0; gi < 4; gi++) {
    const u16* q = qptr(gi);
    qf[gi][0] = *(const bf16x8*)(q + (size_t)n * PNLD + g * 8);
    qf[gi][1] = *(const bf16x8*)(q + (size_t)n * PNLD + 32 + g * 8);
#pragma unroll
    for (int i = 0; i < 4; i++) o[gi][i] = f32x4{0.f, 0.f, 0.f, 0.f};
    m[gi] = m0f(gi);
    ls[gi] = (g == 0) ? l0 : 0.f;
  }
  const u16* kp; const u16* vp; int vld, aux;
  tilefn(0, kp, vp, vld, aux);
  bf16x8 kn0, kn1, kn2, kn3;
  bf16x8 vn0, vn1, vn2, vn3;
  const int krow0 = 8 * (n >> 2) + (n & 3);
#define LOADK()                                                                     \
  {                                                                                 \
    const u16* kr = kp + (size_t)krow0 * PNLD + g * 8;                              \
    kn0 = *(const bf16x8*)(kr); kn1 = *(const bf16x8*)(kr + (size_t)4 * PNLD);      \
    kn2 = *(const bf16x8*)(kr + 32); kn3 = *(const bf16x8*)(kr + (size_t)4 * PNLD + 32); \
  }
#define LOADV()                                                                     \
  {                                                                                 \
    const u16* vr = vp + (size_t)n * vld + 8 * g;                                   \
    vn0 = *(const bf16x8*)(vr); vn1 = *(const bf16x8*)(vr + (size_t)16 * vld);      \
    vn2 = *(const bf16x8*)(vr + (size_t)32 * vld); vn3 = *(const bf16x8*)(vr + (size_t)48 * vld); \
  }
  LOADK();
  LOADV();
#pragma unroll 1
  for (int t = 0; t < ntiles; t++) {
    const int auxc = aux;
    const bool more = t + 1 < ntiles;
    bf16x8 vf[4];
    vf[0] = vn0; vf[1] = vn1; vf[2] = vn2; vf[3] = vn3;
#pragma unroll
    for (int hf = 0; hf < 2; hf++) {
      f32x4 s0[2], s1[2];
#pragma unroll
      for (int gg = 0; gg < 2; gg++) {
        const int gi = hf * 2 + gg;
        s0[gg] = f32x4{0.f, 0.f, 0.f, 0.f}; s1[gg] = f32x4{0.f, 0.f, 0.f, 0.f};
        if (skipfn(gi, auxc)) continue;
        s0[gg] = MFMA16(kn0, qf[gi][0], s0[gg]); s1[gg] = MFMA16(kn1, qf[gi][0], s1[gg]);
        s0[gg] = MFMA16(kn2, qf[gi][1], s0[gg]); s1[gg] = MFMA16(kn3, qf[gi][1], s1[gg]);
      }
      if (hf == 1 && more) { tilefn(t + 1, kp, vp, vld, aux); LOADK(); }
#pragma unroll
      for (int gg = 0; gg < 2; gg++) {
        const int gi = hf * 2 + gg;
        if (skipfn(gi, auxc)) continue;
        float sc[8];
#pragma unroll
        for (int r = 0; r < 4; r++) {
          sc[r] = scorefn(gi, auxc, 8 * g + r, n, s0[gg][r]);
          sc[4 + r] = scorefn(gi, auxc, 8 * g + 4 + r, n, s1[gg][r]);
        }
        float mx = fmaxf(fmaxf(fmaxf(sc[0], sc[1]), fmaxf(sc[2], sc[3])), fmaxf(fmaxf(sc[4], sc[5]), fmaxf(sc[6], sc[7])));
        mx = fmaxf(mx, __shfl_xor(mx, 16, 64));
        mx = fmaxf(mx, __shfl_xor(mx, 32, 64));
        const float mn = fmaxf(m[gi], mx);
        const float alpha = __builtin_amdgcn_exp2f(m[gi] - mn);
        float pv[8], ps = 0.f;
#pragma unroll
        for (int r = 0; r < 8; r++) { pv[r] = __builtin_amdgcn_exp2f(sc[r] - mn); ps += pv[r]; }
        ls[gi] = ls[gi] * alpha + ps;
        m[gi] = mn;
        union { bf16x8 v; unsigned u[4]; } pf;
        pf.u[0] = pack2(pv[0], pv[1]); pf.u[1] = pack2(pv[2], pv[3]); pf.u[2] = pack2(pv[4], pv[5]); pf.u[3] = pack2(pv[6], pv[7]);
#pragma unroll
        for (int d4 = 0; d4 < 4; d4++) {
          o[gi][d4] *= alpha;
          o[gi][d4] = MFMA16(vf[d4], pf.v, o[gi][d4]);
        }
      }
    }
    if (more) LOADV();
  }
#undef LOADK
#undef LOADV
#pragma unroll
  for (int gi = 0; gi < 4; gi++) {
    float lsum = ls[gi];
    lsum += __shfl_xor(lsum, 16, 64);
    lsum += __shfl_xor(lsum, 32, 64);
    const float inv = 1.0f / lsum;
    u16* ob = optr(gi);
#pragma unroll
    for (int d4 = 0; d4 < 4; d4++) {
      uint2 w; w.x = pack2(o[gi][d4][0] * inv, o[gi][d4][1] * inv); w.y = pack2(o[gi][d4][2] * inv, o[gi][d4][3] * inv);
      *(uint2*)(ob + (size_t)n * 512 + d4 * 16 + 4 * g) = w;
    }
  }
}

DI void attn_a_latent(const Params& p, int l, int wt) {
  wt = __builtin_amdgcn_readfirstlane(wt);
  const int kvh = wt & 1, qt = (wt >> 1) & 255, b = wt >> 9, q0 = qt * 16;
  const u16* PN = (const u16*)(p.ws + OFF_PN);
  const u16* VT = (const u16*)(p.ws + OFF_VT);
  const u16* VTc = (const u16*)(p.ws + OFF_VTC);
  int jlo = (q0 - 128) & ~31; if (jlo < 0) jlo = 0;
  int jhi = (q0 + 144 + 31) & ~31; if (jhi > SEQ) jhi = SEQ;
  const int ntiles = 8 + (jhi - jlo) / 32;
  const u16* kc = PN + (size_t)(NLAT + b * LC) * PNLD + 512 + kvh * 64;
  const u16* kl = PN + (size_t)(b * SEQ) * PNLD + 512 + kvh * 64;
  const u16* vc = VTc + (size_t)(b * VTR + kvh * 64) * LC;
  const u16* vl = VT + (size_t)(b * VTR + kvh * 64) * SEQ;
  const u16* qb = PN + (size_t)(b * SEQ + q0) * PNLD + kvh * 256;
  u16* ob = (u16*)(p.ws + OFF_Y) + (size_t)(b * SEQ + q0) * 512 + kvh * 256;
  const float* sk = p.sink + l * 8 + kvh * 4;
  auto tilefn = [&](int t, const u16*& kp, const u16*& vp, int& vld, int& aux) {
    if (t < 8) { kp = kc + (size_t)(t * 32) * PNLD; vp = vc + t * 32; vld = LC; aux = -1; }
    else { int j0 = jlo + (t - 8) * 32; kp = kl + (size_t)j0 * PNLD; vp = vl + j0; vld = SEQ; aux = j0; }
  };
  auto scorefn = [&](int gi, int aux, int kidx, int n, float dot) -> float {
    float s = dot * QSC;
    if (aux >= 0) { int dj = aux + kidx - (q0 + n); if (dj > 128 || dj < -128) s = -INFINITY; }
    return s;
  };
  attn_core4([&](int gi) { return qb + gi * 64; }, [&](int gi) { return ob + gi * 64; }, [&](int gi) { return sk[gi] * LOG2E; }, 1.0f,
             ntiles, tilefn, scorefn, [&](int gi, int aux) { return false; });
}

DI void attn_c_latent(const Params& p, int l, int wt, char* lds) {
  wt = __builtin_amdgcn_readfirstlane(wt);
  const int head = wt & 7, r = (wt >> 3) & 63, b = wt >> 9;
  const u16* PN = (const u16*)(p.ws + OFF_PN);
  const u16* VT = (const u16*)(p.ws + OFF_VT);
  const u16* VTc = (const u16*)(p.ws + OFF_VTC);
  int rs = r - 4; rs = rs < 0 ? 0 : (rs > 56 ? 56 : rs);
  const int tok0 = b * SEQ + r * 64;
  const u16* kc = PN + (size_t)(NLAT + b * LC) * PNLD + 2208 + head * 64;
  const u16* kl = PN + (size_t)(b * SEQ) * PNLD + 2208 + head * 64;
  const u16* vc = VTc + (size_t)(b * VTR + 640 + head * 64) * LC;
  const u16* vl = VT + (size_t)(b * VTR + 640 + head * 64) * SEQ;
  float* rpb = (float*)(lds + (threadIdx.x >> 6) * 2048);
  {
    const float* src = p.rpb + (size_t)(l * 8 + head) * 15 * 31;
    const int lane_ = threadIdx.x & 63;
    for (int i = lane_; i < 465; i += 64) rpb[i] = src[i] * LOG2E;
  }
  const u16* qb = PN + (size_t)tok0 * PNLD + 1696 + head * 64;
  u16* ob = (u16*)(p.ws + OFF_Y) + (size_t)2 * NTOK * 512 + (size_t)tok0 * 512 + head * 64;
  auto tilefn = [&](int t, const u16*& kp, const u16*& vp, int& vld, int& aux) {
    if (t < 8) { kp = kc + (size_t)(t * 32) * PNLD; vp = vc + t * 32; vld = LC; aux = -1; }
    else { int a = t - 8; int tk = (rs + (a >> 1)) * 64 + (a & 1) * 32; kp = kl + (size_t)tk * PNLD; vp = vl + tk; vld = SEQ; aux = a; }
  };
  auto scorefn = [&](int gi, int aux, int kidx, int n, float dot) -> float {
    float s = dot * QSC;
    if (aux >= 0) {
      int kcol = (aux & 1) * 32 + kidx, qcol = gi * 16 + n;
      int wsx = qcol - 8; wsx = wsx < 0 ? 0 : (wsx > 48 ? 48 : wsx);
      int drow = rs + (aux >> 1) - r + 7;
      int dc = kcol - qcol; dc = dc < -15 ? -15 : (dc > 15 ? 15 : dc);
      float bias = rpb[drow * 31 + dc + 15];
      s = (kcol >= wsx && kcol < wsx + 16) ? s + bias : -INFINITY;
    }
    return s;
  };
  attn_core4([&](int gi) { return qb + (size_t)gi * 16 * PNLD; }, [&](int gi) { return ob + (size_t)gi * 16 * 512; },
             [&](int gi) { return -INFINITY; }, 0.0f, 24, tilefn, scorefn,
             [&](int gi, int aux) { return aux >= 0 && ((gi == 0 && (aux & 1)) || (gi == 3 && !(aux & 1))); });
}

DI void attn_ctx(const Params& p, int l, int wt, int which) {
  wt = __builtin_amdgcn_readfirstlane(wt);
  const u16* PN = (const u16*)(p.ws + OFF_PN);
  const u16* VTc = (const u16*)(p.ws + OFF_VTC);
  if (which == 0) {
    const int kvh = wt & 1, qt = (wt >> 1) & 15, b = wt >> 5;
    const int row0 = NLAT + b * LC + qt * 16;
    const u16* kc = PN + (size_t)(NLAT + b * LC) * PNLD + 512 + kvh * 64;
    const u16* vc = VTc + (size_t)(b * VTR + kvh * 64) * LC;
    const u16* qb = PN + (size_t)row0 * PNLD + kvh * 256;
    u16* ob = (u16*)(p.ws + OFF_Y) + (size_t)row0 * 512 + kvh * 256;
    const float* sk = p.sink + l * 8 + kvh * 4;
    attn_core4([&](int gi) { return qb + gi * 64; }, [&](int gi) { return ob + gi * 64; }, [&](int gi) { return sk[gi] * LOG2E; }, 1.0f, 8,
               [&](int t, const u16*& kp, const u16*& vp, int& vld, int& aux) { kp = kc + (size_t)(t * 32) * PNLD; vp = vc + t * 32; vld = LC; aux = -1; },
               [&](int gi, int aux, int kidx, int n, float dot) -> float { return dot * QSC; }, [&](int gi, int aux) { return false; });
  } else {
    const int head = wt & 7, q4 = (wt >> 3) & 3, b = wt >> 5;
    const int row0 = NLAT + b * LC + q4 * 64;
    const u16* kc = PN + (size_t)(NLAT + b * LC) * PNLD + 2208 + head * 64;
    const u16* vc = VTc + (size_t)(b * VTR + 640 + head * 64) * LC;
    const u16* qb = PN + (size_t)row0 * PNLD + 1696 + head * 64;
    u16* ob = (u16*)(p.ws + OFF_Y) + (size_t)2 * NTOK * 512 + (size_t)row0 * 512 + head * 64;
    attn_core4([&](int gi) { return qb + (size_t)gi * 16 * PNLD; }, [&](int gi) { return ob + (size_t)gi * 16 * 512; },
               [&](int gi) { return -INFINITY; }, 0.0f, 8,
               [&](int t, const u16*& kp, const u16*& vp, int& vld, int& aux) { kp = kc + (size_t)(t * 32) * PNLD; vp = vc + t * 32; vld = LC; aux = -1; },
               [&](int gi, int aux, int kidx, int n, float dot) -> float { return dot * QSC; }, [&](int gi, int aux) { return false; });
  }
}

constexpr int G_QS = 0, G_KS = 9216, G_KT = 18432, G_VT = 27648, G_ZL = 36864, G_TOT = 40960, G_DEC = 41984, G_END = 42240;
constexpr int NE = 4;
constexpr size_t OFF_SL = OFF_Y + (size_t)2 * NTOK * 512 * 2;
constexpr size_t OFF_DS = OFF_PAD + (524288u);

template <int PASS>
DI void task_gla(const Params& p, int l, int id, char* lds) {
  int seg, rest;
  if (PASS == 1) { seg = id & 15; rest = id >> 4; } else { seg = 16 - (id % 17); rest = id / 17; }
  const int sl = rest & 1, dir = (rest >> 1) & 1, h = (rest >> 2) & 3, b = rest >> 4, combo = rest >> 1;
  const int tid = threadIdx.x, lane = tid & 63, wave = tid >> 6, g = lane >> 4, n = lane & 15;
  const u16* PN = (const u16*)(p.ws + OFF_PN);
  u16* odst = dir ? (u16*)(p.ws + OFF_OB) : (u16*)(p.ws + OFF_Y) + (size_t)NTOK * 512;
  float* SL = (float*)(p.ws + OFF_SL);
  float* DS = (float*)(p.ws + OFF_DS);
  const float* gwp = (dir ? p.gw_b : p.gw_f) + (size_t)l * 16 * 256 + h * 64 + lane;
  const float* gbp = (dir ? p.gb_b : p.gb_f) + l * 256 + h * 64 + lane;
  f32x4 S[4][NE];
#pragma unroll
  for (int i = 0; i < 4; i++)
#pragma unroll
    for (int j = 0; j < NE; j++) S[i][j] = f32x4{0.f, 0.f, 0.f, 0.f};
  if (PASS == 2) {
    const float* sl_src = SL + ((size_t)(rest * 17 + seg)) * (1024 * NE) + lane * 4;
#pragma unroll
    for (int dt = 0; dt < 4; dt++)
#pragma unroll
      for (int et = 0; et < NE; et++) S[dt][et] = *(const f32x4*)(sl_src + (dt * NE + et) * 256);
  }
  float* ZL = (float*)(lds + G_ZL);
  float* TOT = (float*)(lds + G_TOT);
  float* DEC = (float*)(lds + G_DEC);
  float totsum = 0.f;

  int tb = 0, rowbase = 0;
  uint4 rq0, rq1, rk0, rk1, rz, rv, rv2;
  rq0 = rq1 = rz = uint4{0, 0, 0, 0};
  auto gload = [&](int ch) {
    int vld; const u16* vsrc;
    if (ch < 4) {
      tb = dir ? 192 - 64 * ch : 64 * ch; rowbase = NLAT + b * LC; vld = LC;
      vsrc = (const u16*)(p.ws + OFF_VTC) + (size_t)(b * VTR + 128 + h * 128 + sl * 64) * LC;
    } else {
      tb = dir ? SEQ - 64 * (ch - 3) : 64 * (ch - 4); rowbase = b * SEQ; vld = SEQ;
      vsrc = (const u16*)(p.ws + OFF_VT) + (size_t)(b * VTR + 128 + h * 128 + sl * 64) * SEQ;
    }
    {
      int row = tid >> 3, kc = tid & 7;
      int tok0 = dir ? tb + 63 - row : tb + row, tok1 = dir ? tb + 31 - row : tb + 32 + row;
      const u16* s0 = PN + (size_t)(rowbase + tok0) * PNLD + h * 64 + kc * 8;
      const u16* s1 = PN + (size_t)(rowbase + tok1) * PNLD + h * 64 + kc * 8;
      if (PASS == 2) { rq0 = *(const uint4*)(s0 + 640); rq1 = *(const uint4*)(s1 + 640); }
      rk0 = *(const uint4*)(s0 + 896); rk1 = *(const uint4*)(s1 + 896);
    }
    if (tid < 128) {
      int row = tid >> 1, hc = tid & 1;
      int tok = dir ? tb + 63 - row : tb + row;
      rz = *(const uint4*)(PN + (size_t)(rowbase + tok) * PNLD + 1664 + dir * 16 + hc * 8);
    }
    rv = *(const uint4*)(vsrc + (size_t)(tid >> 3) * vld + tb + (tid & 7) * 8);
    rv2 = *(const uint4*)(vsrc + (size_t)(32 + (tid >> 3)) * vld + tb + (tid & 7) * 8);
  };
  gload(seg * 4);

  for (int ci = 0; ci < 4; ci++) {
    const int ctb = tb, crowbase = rowbase;
    float gw[16];
#pragma unroll
    for (int r = 0; r < 16; r++) gw[r] = gwp[r * 256];
    const float gbias = gbp[0];
    __syncthreads();
    {
      int row = tid >> 3, kc = tid & 7;
      if (PASS == 2) {
        *(uint4*)(lds + G_QS + row * LROW + kc * 16) = rq0;
        *(uint4*)(lds + G_QS + (row + 32) * LROW + kc * 16) = rq1;
      }
      *(uint4*)(lds + G_KS + row * LROW + kc * 16) = rk0;
      *(uint4*)(lds + G_KS + (row + 32) * LROW + kc * 16) = rk1;
    }
    if (tid < 128) {
      int row = tid >> 1, hc = tid & 1;
      float* zd = ZL + row * 16 + hc * 8;
      zd[0] = __uint_as_float(rz.x << 16); zd[1] = __uint_as_float(rz.x & 0xffff0000u);
      zd[2] = __uint_as_float(rz.y << 16); zd[3] = __uint_as_float(rz.y & 0xffff0000u);
      zd[4] = __uint_as_float(rz.z << 16); zd[5] = __uint_as_float(rz.z & 0xffff0000u);
      zd[6] = __uint_as_float(rz.w << 16); zd[7] = __uint_as_float(rz.w & 0xffff0000u);
    }
    {
      int e = tid >> 3, kc = tid & 7;
      if (dir) {
        uint4 rr;
        rr.x = (rv.w >> 16) | (rv.w << 16); rr.y = (rv.z >> 16) | (rv.z << 16);
        rr.z = (rv.y >> 16) | (rv.y << 16); rr.w = (rv.x >> 16) | (rv.x << 16);
        *(uint4*)(lds + G_VT + e * LROW + (7 - kc) * 16) = rr;
        rr.x = (rv2.w >> 16) | (rv2.w << 16); rr.y = (rv2.z >> 16) | (rv2.z << 16);
        rr.z = (rv2.y >> 16) | (rv2.y << 16); rr.w = (rv2.x >> 16) | (rv2.x << 16);
        *(uint4*)(lds + G_VT + (32 + e) * LROW + (7 - kc) * 16) = rr;
      } else {
        *(uint4*)(lds + G_VT + e * LROW + kc * 16) = rv;
        *(uint4*)(lds + G_VT + (32 + e) * LROW + kc * 16) = rv2;
      }
    }
    __syncthreads();
    float bv[16];
    {
      float run = 0.f;
#pragma unroll
      for (int tt = 0; tt < 16; tt++) {
        const float4* zr = (const float4*)(ZL + (wave * 16 + tt) * 16);
        float z = gbias;
#pragma unroll
        for (int q = 0; q < 4; q++) {
          float4 zz = zr[q];
          z += zz.x * gw[q * 4 + 0] + zz.y * gw[q * 4 + 1] + zz.z * gw[q * 4 + 2] + zz.w * gw[q * 4 + 3];
        }
        float lsg = fminf(z, 0.f) - __logf(1.0f + __expf(-fabsf(z)));
        run += lsg * (1.0f / 16.0f);
        bv[tt] = run;
      }
      TOT[wave * 64 + lane] = run;
    }
    __syncthreads();
    {
      float off = 0.f, tot = 0.f;
#pragma unroll
      for (int s = 0; s < 4; s++) { float tv = TOT[s * 64 + lane]; if (s < wave) off += tv; tot += tv; }
      totsum += tot;
      const float dtot = __expf(tot);
      if (wave == 0) DEC[lane] = dtot;
      unsigned ktp[8];
#pragma unroll
      for (int tt = 0; tt < 16; tt++) {
        const int t = wave * 16 + tt;
        const float bq = bv[tt] + off;
        u16* ka = (u16*)(lds + G_KS + t * LROW) + lane;
        const float kv = bf2f(*ka);
        const float e1 = __expf(bq), e2 = __builtin_amdgcn_rcpf(e1);
        if (PASS == 2) {
          u16* qa = (u16*)(lds + G_QS + t * LROW) + lane;
          const float qv = bf2f(*qa);
          *qa = f2bf(qv * 0.125f * e1);
          *ka = f2bf(kv * e2);
        }
        const unsigned kt = f2bf(kv * (dtot * e2));
        if (tt & 1) ktp[tt >> 1] |= kt << 16; else ktp[tt >> 1] = kt;
      }
      uint4* kd = (uint4*)(lds + G_KT + lane * LROW + wave * 32);
      kd[0] = uint4{ktp[0], ktp[1], ktp[2], ktp[3]};
      kd[1] = uint4{ktp[4], ktp[5], ktp[6], ktp[7]};
    }
    __syncthreads();
    if (ci < 3) gload(seg * 4 + ci + 1);
    if (PASS == 2) {
      bf16x8 qf[2];
      qf[0] = *(const bf16x8*)(lds + G_QS + (wave * 16 + n) * LROW + g * 16);
      qf[1] = *(const bf16x8*)(lds + G_QS + (wave * 16 + n) * LROW + 64 + g * 16);
      f32x4 X[4];
#pragma unroll
      for (int jt = 0; jt < 4; jt++) {
        X[jt] = f32x4{0.f, 0.f, 0.f, 0.f};
#pragma unroll
        for (int s = 0; s < 2; s++) {
          bf16x8 kf = *(const bf16x8*)(lds + G_KS + (jt * 16 + n) * LROW + s * 64 + g * 16);
          X[jt] = MFMA16(kf, qf[s], X[jt]);
        }
#pragma unroll
        for (int r = 0; r < 4; r++) if (jt * 16 + 4 * g + r > wave * 16 + n) X[jt][r] = 0.f;
      }
      f32x4 o[NE];
#pragma unroll
      for (int et = 0; et < NE; et++) o[et] = f32x4{0.f, 0.f, 0.f, 0.f};
#pragma unroll
      for (int kk = 0; kk < 2; kk++) {
        union { bf16x8 v; unsigned u[4]; } pa;
        pa.u[0] = pack2(X[2 * kk][0], X[2 * kk][1]); pa.u[1] = pack2(X[2 * kk][2], X[2 * kk][3]);
        pa.u[2] = pack2(X[2 * kk + 1][0], X[2 * kk + 1][1]); pa.u[3] = pack2(X[2 * kk + 1][2], X[2 * kk + 1][3]);
        const char* qr = lds + G_QS + (wave * 16 + n) * LROW + kk * 64 + g * 8;
        s16x4 qa = *(const s16x4*)(qr), qb = *(const s16x4*)(qr + 32);
        bf16x8 qp = __builtin_shufflevector(qa, qb, 0, 1, 2, 3, 4, 5, 6, 7);
#pragma unroll
        for (int et = 0; et < NE; et++) {
          const char* vr = lds + G_VT + (et * 16 + n) * LROW + kk * 64 + g * 8;
          s16x4 va = *(const s16x4*)(vr), vb = *(const s16x4*)(vr + 32);
          bf16x8 vf = __builtin_shufflevector(va, vb, 0, 1, 2, 3, 4, 5, 6, 7);
          o[et] = MFMA16(pa.v, vf, o[et]);
          union { bf16x8 v; unsigned u[4]; } sb;
          sb.u[0] = pack2(S[2 * kk][et][0], S[2 * kk][et][1]); sb.u[1] = pack2(S[2 * kk][et][2], S[2 * kk][et][3]);
          sb.u[2] = pack2(S[2 * kk + 1][et][0], S[2 * kk + 1][et][1]); sb.u[3] = pack2(S[2 * kk + 1][et][2], S[2 * kk + 1][et][3]);
          o[et] = MFMA16(qp, sb.v, o[et]);
        }
      }
#pragma unroll
      for (int r = 0; r < 4; r++) {
        int i = wave * 16 + 4 * g + r;
        int tok = dir ? ctb + 63 - i : ctb + i;
        u16* orow = odst + (size_t)(crowbase + tok) * 512 + h * 128 + sl * 64 + n;
#pragma unroll
        for (int et = 0; et < NE; et++) orow[et * 16] = f2bf(o[et][r]);
      }
    }
    if (PASS == 1 || ci < 3) {
      bf16x8 vfr[NE][2];
#pragma unroll
      for (int et = 0; et < NE; et++)
#pragma unroll
        for (int s = 0; s < 2; s++) vfr[et][s] = *(const bf16x8*)(lds + G_VT + (et * 16 + n) * LROW + s * 64 + g * 16);
#pragma unroll
      for (int dt = 0; dt < 4; dt++) {
        bf16x8 kf0 = *(const bf16x8*)(lds + G_KT + (dt * 16 + n) * LROW + g * 16);
        bf16x8 kf1 = *(const bf16x8*)(lds + G_KT + (dt * 16 + n) * LROW + 64 + g * 16);
        const f32x4 dc = *(const f32x4*)(DEC + dt * 16 + 4 * g);
#pragma unroll
        for (int et = 0; et < NE; et++) {
          f32x4 u = {0.f, 0.f, 0.f, 0.f};
          u = MFMA16(kf0, vfr[et][0], u);
          u = MFMA16(kf1, vfr[et][1], u);
          S[dt][et] = S[dt][et] * dc + u;
        }
      }
    }
  }
  if (PASS == 1 && wave == 0) {
    float* dst = SL + ((size_t)(rest * 17 + seg)) * (1024 * NE) + lane * 4;
#pragma unroll
    for (int dt = 0; dt < 4; dt++)
#pragma unroll
      for (int et = 0; et < NE; et++) *(f32x4*)(dst + (dt * NE + et) * 256) = S[dt][et];
    if (sl == 0) DS[(size_t)(combo * 17 + seg) * 64 + lane] = totsum;
  }
}

DI void task_gla_prefix(const Params& p, int rest) {
  const int tid = threadIdx.x, combo = rest >> 1;
  constexpr int SSZ = 1024 * NE;
  float* SL = (float*)(p.ws + OFF_SL) + (size_t)rest * 17 * SSZ + tid * 16;
  const int tile = tid >> 4, g4 = (tid & 15) >> 2;
  const float* DS = (const float*)(p.ws + OFF_DS) + (size_t)combo * 17 * 64 + (tile / NE) * 16 + 4 * g4;
  f32x4 s0 = {0.f, 0.f, 0.f, 0.f}, s1 = s0, s2 = s0, s3 = s0;
#pragma unroll 2
  for (int seg = 0; seg < 16; seg++) {
    float* q = SL + (size_t)seg * SSZ;
    const f32x4 c0 = *(const f32x4*)(q), c1 = *(const f32x4*)(q + 4), c2 = *(const f32x4*)(q + 8), c3 = *(const f32x4*)(q + 12);
    const f32x4 dl = *(const f32x4*)(DS + seg * 64);
    *(f32x4*)(q) = s0; *(f32x4*)(q + 4) = s1; *(f32x4*)(q + 8) = s2; *(f32x4*)(q + 12) = s3;
    const f32x4 dc = {__expf(dl[0]), __expf(dl[1]), __expf(dl[2]), __expf(dl[3])};
    s0 = s0 * dc + c0; s1 = s1 * dc + c1; s2 = s2 * dc + c2; s3 = s3 * dc + c3;
  }
  float* q = SL + (size_t)16 * SSZ;
  *(f32x4*)(q) = s0; *(f32x4*)(q + 4) = s1; *(f32x4*)(q + 8) = s2; *(f32x4*)(q + 12) = s3;
}

DI void task_gla_out(const Params& p, int l, int task) {
  const int lane = threadIdx.x & 63, wave = threadIdx.x >> 6;
  const int row0 = task * 16 + wave * 4;
  u16* of = (u16*)(p.ws + OFF_Y) + (size_t)NTOK * 512 + (size_t)row0 * 512 + lane * 8;
  const u16* ob = (const u16*)(p.ws + OFF_OB) + (size_t)row0 * 512 + lane * 8;
  const u16* gr = (const u16*)(p.ws + OFF_PN) + (size_t)row0 * PNLD + 1152 + lane * 8;
  uint4 a[4], bb[4], rr[4];
#pragma unroll
  for (int q = 0; q < 4; q++) { a[q] = *(const uint4*)(of + q * 512); bb[q] = *(const uint4*)(ob + q * 512); rr[q] = *(const uint4*)(gr + (size_t)q * PNLD); }
  const float* gn = p.gla_norm + l * 128 + (lane & 15) * 8;
  float gnv[8];
#pragma unroll
  for (int i = 0; i < 8; i++) gnv[i] = gn[i];
#pragma unroll
  for (int q = 0; q < 4; q++) {
    const unsigned au[4] = {a[q].x, a[q].y, a[q].z, a[q].w}, bu[4] = {bb[q].x, bb[q].y, bb[q].z, bb[q].w}, ru[4] = {rr[q].x, rr[q].y, rr[q].z, rr[q].w};
    float v[8], rv[8], ss = 0.f;
#pragma unroll
    for (int i = 0; i < 4; i++) {
      v[2 * i] = __uint_as_float(au[i] << 16) + __uint_as_float(bu[i] << 16);
      v[2 * i + 1] = __uint_as_float(au[i] & 0xffff0000u) + __uint_as_float(bu[i] & 0xffff0000u);
      rv[2 * i] = __uint_as_float(ru[i] << 16);
      rv[2 * i + 1] = __uint_as_float(ru[i] & 0xffff0000u);
      ss += v[2 * i] * v[2 * i] + v[2 * i + 1] * v[2 * i + 1];
    }
    ss += __shfl_xor(ss, 1, 64); ss += __shfl_xor(ss, 2, 64); ss += __shfl_xor(ss, 4, 64); ss += __shfl_xor(ss, 8, 64);
    const float rstd = rsqrtf(ss * (1.0f / 128.0f) + 1e-6f);
    float o[8];
#pragma unroll
    for (int i = 0; i < 8; i++) o[i] = v[i] * rstd * gnv[i] * siluf_(rv[i]);
    uint4 w; w.x = pack2(o[0], o[1]); w.y = pack2(o[2], o[3]); w.z = pack2(o[4], o[5]); w.w = pack2(o[6], o[7]);
    *(uint4*)(of + q * 512) = w;
  }
}

constexpr size_t OFF_GQ = OFF_ACT;
static_assert(OFF_GQ + (size_t)3072 * NTOK <= OFF_Y, "gate alias");

DI void task_gates(const Params& p, int l, int tile, char* lds) {
  const int mt = tile / 12, nt = tile % 12;
  const int tid = threadIdx.x, lane = tid & 63, wave = tid >> 6;
  const int wm = wave >> 1, wn = wave & 1, g = lane >> 4, n = lane & 15;
  f32x4 acc[4][8];
#pragma unroll
  for (int i = 0; i < 4; i++)
#pragma unroll
    for (int j = 0; j < 8; j++) acc[i][j] = f32x4{0.f, 0.f, 0.f, 0.f};
  gemm_wide((const u16*)(p.ws + OFF_HB) + (size_t)mt * 128 * 32, NTOK, (const u16*)(p.ws + OFF_WMG) + (size_t)nt * 256 * 32, 3072, D, acc, lds);
  unsigned char* GQ = (unsigned char*)(p.ws + OFF_GQ);
  const float* bm = p.b_merge + l * 3072 + nt * 256 + wn * 128 + n;
#pragma unroll
  for (int ni = 0; ni < 8; ni++) {
    const float bias = bm[ni * 16];
    const size_t col = (size_t)(nt * 256 + wn * 128 + ni * 16 + n);
#pragma unroll
    for (int mi = 0; mi < 4; mi++) {
      const int row0 = mt * 128 + wm * 64 + mi * 16 + 4 * g;
      unsigned q0 = (unsigned)(sigmoidf_(acc[mi][ni][0] + bias) * 255.0f + 0.5f);
      unsigned q1 = (unsigned)(sigmoidf_(acc[mi][ni][1] + bias) * 255.0f + 0.5f);
      unsigned q2 = (unsigned)(sigmoidf_(acc[mi][ni][2] + bias) * 255.0f + 0.5f);
      unsigned q3 = (unsigned)(sigmoidf_(acc[mi][ni][3] + bias) * 255.0f + 0.5f);
      *(unsigned*)(GQ + ((col >> 4) * (size_t)(NTOK / 16) + (row0 >> 4)) * 256 + (col & 15) * 16 + (row0 & 15)) = q0 | (q1 << 8) | (q2 << 16) | (q3 << 24);
    }
  }
}

DI void task_mg(const Params& p, int l, int tile, char* lds) {
  const int mt = tile >> 3, nt = tile & 7;
  const int tid = threadIdx.x, lane = tid & 63, wave = tid >> 6;
  const int wm = wave >> 1, wn = wave & 1, g = lane >> 4, n = lane & 15;
  f32x4 mix[4][4];
  zero_acc<4>(mix);
  const unsigned char* GQ = (const unsigned char*)(p.ws + OFF_GQ);
#pragma unroll 1
  for (int br = 0; br < 3; br++) {
    f32x4 acc[4][4];
    zero_acc<4>(acc);
    gemm_tile<4, 0>((const u16*)(p.ws + OFF_Y) + (size_t)br * NTOK * 512 + (size_t)mt * 128 * 512, 512,
                 (const u16*)(p.ws + OFF_WBR) + (size_t)br * 1024 * 512 + (size_t)nt * 128 * 512, 512, 512, acc, lds);
#pragma unroll
    for (int ni = 0; ni < 4; ni++) {
      const size_t col = (size_t)(br * 1024 + nt * 128 + wn * 64 + ni * 16 + n);
#pragma unroll
      for (int mi = 0; mi < 4; mi++) {
        const int row0 = mt * 128 + wm * 64 + mi * 16 + 4 * g;
        const unsigned q = *(const unsigned*)(GQ + ((col >> 4) * (size_t)(NTOK / 16) + (row0 >> 4)) * 256 + (col & 15) * 16 + (row0 & 15));
        mix[mi][ni][0] += (float)(q & 255u) * (1.0f / 255.0f) * acc[mi][ni][0];
        mix[mi][ni][1] += (float)((q >> 8) & 255u) * (1.0f / 255.0f) * acc[mi][ni][1];
        mix[mi][ni][2] += (float)((q >> 16) & 255u) * (1.0f / 255.0f) * acc[mi][ni][2];
        mix[mi][ni][3] += (float)(q >> 24) * (1.0f / 255.0f) * acc[mi][ni][3];
      }
    }
  }
  u16* mx = (u16*)(p.ws + OFF_MIXED);
#pragma unroll
  for (int mi = 0; mi < 4; mi++)
#pragma unroll
    for (int ni = 0; ni < 4; ni++)
#pragma unroll
      for (int r = 0; r < 4; r++)
      {
        const int row = mt * 128 + wm * 64 + mi * 16 + 4 * g + r, col = nt * 128 + wn * 64 + ni * 16 + n;
        mx[((size_t)(col >> 5) * NTOK + row) * 32 + (col & 31)] = f2bf(mix[mi][ni][r]);
      }
}

DI void task_res_wide(const Params& p, int l, int tile, const u16* A, int lda, const u16* Wt, int K, int gate_idx, bool first, char* lds) {
  const int mt = tile >> 2, nt = tile & 3;
  const int tid = threadIdx.x, lane = tid & 63, wave = tid >> 6;
  const int wm = wave >> 1, wn = wave & 1, g = lane >> 4, n = lane & 15;
  f32x4 acc[4][8];
#pragma unroll
  for (int i = 0; i < 4; i++)
#pragma unroll
    for (int j = 0; j < 8; j++) acc[i][j] = f32x4{0.f, 0.f, 0.f, 0.f};
  gemm_wide(A + (size_t)mt * 128 * 32, NTOK, Wt + (size_t)nt * 256 * 32, D, K, acc, lds);
  const float* gt = modp(p, l, mt * 128) + gate_idx * D + nt * 256 + wn * 128 + n;
#pragma unroll
  for (int ni = 0; ni < 8; ni++) {
    const float gv = gt[ni * 16];
#pragma unroll
    for (int mi = 0; mi < 4; mi++)
#pragma unroll
      for (int r = 0; r < 4; r++) {
        int row = mt * 128 + wm * 64 + mi * 16 + 4 * g + r, col = nt * 256 + wn * 128 + ni * 16 + n;
        const float* xs = first ? xsrc(p, l, row) : (const float*)xdst(p, row);
        xdst(p, row)[col] = xs[col] + gv * acc[mi][ni][r];
      }
  }
}

DI void task_res_ctx(const Params& p, int l, int tile, const u16* A, int lda, const u16* Wt, int K, int gate_idx, bool first, char* lds) {
  const int mt = 128 + (tile >> 4), nt = tile & 15;
  const int tid = threadIdx.x, lane = tid & 63, wave = tid >> 6;
  const int wm = wave >> 1, wn = wave & 1, g = lane >> 4, n = lane & 15;
  f32x4 acc[4][2];
  zero_acc<2>(acc);
  gemm_tile<2, 1>(A + (size_t)mt * 128 * 32, NTOK, Wt + (size_t)nt * 64 * 32, D, K, acc, lds);
  const float* gt = modp(p, l, mt * 128) + gate_idx * D + nt * 64 + wn * 32 + n;
#pragma unroll
  for (int ni = 0; ni < 2; ni++) {
    const float gv = gt[ni * 16];
#pragma unroll
    for (int mi = 0; mi < 4; mi++)
#pragma unroll
      for (int r = 0; r < 4; r++) {
        int row = mt * 128 + wm * 64 + mi * 16 + 4 * g + r, col = nt * 64 + wn * 32 + ni * 16 + n;
        const float* xs = first ? xsrc(p, l, row) : (const float*)xdst(p, row);
        xdst(p, row)[col] = xs[col] + gv * acc[mi][ni][r];
      }
  }
}

DI void task_f1(const Params& p, int tile, char* lds) {
  const int mt = tile / 22, nt = tile % 22;
  const int tid = threadIdx.x, lane = tid & 63, wave = tid >> 6;
  const int wm = wave >> 1, wn = wave & 1, g = lane >> 4, n = lane & 15;
  f32x4 acc[4][8];
#pragma unroll
  for (int i = 0; i < 4; i++)
#pragma unroll
    for (int j = 0; j < 8; j++) acc[i][j] = f32x4{0.f, 0.f, 0.f, 0.f};
  gemm_wide((const u16*)(p.ws + OFF_HB) + (size_t)mt * 128 * 32, NTOK, (const u16*)(p.ws + OFF_WF1) + (size_t)nt * 256 * 32, 2 * FH, D, acc, lds);
  u16* act = (u16*)(p.ws + OFF_ACT);
#pragma unroll
  for (int mi = 0; mi < 4; mi++)
#pragma unroll
    for (int ni = 0; ni < 4; ni++)
#pragma unroll
      for (int r = 0; r < 4; r++) {
        int row = mt * 128 + wm * 64 + mi * 16 + 4 * g + r, col = nt * 128 + wn * 64 + ni * 16 + n;
        act[((size_t)(col >> 5) * NTOK + row) * 32 + (col & 31)] = f2bf(siluf_(acc[mi][ni][r]) * acc[mi][ni + 4][r]);
      }
}

#define XB_TMO      128
#define XB_XCNT(j)  (256  + 64 * (j))
#define XB_XSUB(j)  (1280 + 64 * (j))
#define XB_XGEN(j)  (2304 + 64 * (j))
#define XB_TOP      3328
#define XB_TOPGEN   3392
#define XCD_BAR_WORDS 3456
#define XB_SPIN_CAP (1u << 18)
#define LAS __attribute__((address_space(3)))

__device__ __forceinline__ unsigned xb_ld(unsigned* p)              { return __hip_atomic_load(p, __ATOMIC_RELAXED, __HIP_MEMORY_SCOPE_AGENT); }
__device__ __forceinline__ unsigned xb_add(unsigned* p, unsigned v) { return __hip_atomic_fetch_add(p, v, __ATOMIC_RELAXED, __HIP_MEMORY_SCOPE_AGENT); }
__device__ __forceinline__ unsigned xb_xcc_id() { return (unsigned)__builtin_amdgcn_s_getreg((3 << 11) | 20) & 0xFu; }
#define XB_SPIN(cond, bar) do { unsigned _sp = 0; while (cond) { __builtin_amdgcn_s_sleep(1); \
    if ((++_sp & 255u) == 0u) { if (xb_ld(&(bar)[XB_TMO])) break; if (_sp > XB_SPIN_CAP) { atomicAdd(&(bar)[XB_TMO], 1u); break; } } } } while (0)

struct XcdBarrier {
    unsigned* bar; unsigned x;
    volatile LAS unsigned* st;
};

__device__ __forceinline__ XcdBarrier xcd_barrier_post(unsigned* bar, volatile LAS unsigned* st) {
    XcdBarrier b; b.bar = bar; b.x = xb_xcc_id(); b.st = st;
    if (threadIdx.x == 0) (void)xb_add(&bar[XB_XCNT(b.x)], 1u);
    return b;
}
__device__ __forceinline__ void xcd_barrier_complete(unsigned* bar, unsigned x, unsigned& nloc, unsigned& nx) {
    const unsigned G = gridDim.x * gridDim.y * gridDim.z;
    unsigned sum, cnt, mine, sp = 0u;
    for (;;) {
        sum = 0u; cnt = 0u; mine = 0u;
#pragma unroll
        for (unsigned j = 0; j < 16; ++j) { const unsigned c = xb_ld(&bar[XB_XCNT(j)]); sum += c; cnt += (c > 0u) ? 1u : 0u; mine = (j == x) ? c : mine; }
        if (sum == G) break;
        __builtin_amdgcn_s_sleep(1);
        if ((++sp & 255u) == 0u) { if (xb_ld(&bar[XB_TMO])) break; if (sp > XB_SPIN_CAP) { atomicAdd(&bar[XB_TMO], 1u); break; } }
    }
    nloc = mine > 0u ? mine : 1u; nx = cnt > 0u ? cnt : 1u;
}

__device__ __forceinline__ void xcd_barrier(const XcdBarrier& b) {
    asm volatile("s_waitcnt vmcnt(0)" ::: "memory");
    __syncthreads();
    if (threadIdx.x == 0) {
        unsigned* bar = b.bar;
        __builtin_amdgcn_s_waitcnt(0);
        unsigned nloc = b.st[0], nx = b.st[1];
        if (nloc == 0u) { xcd_barrier_complete(bar, b.x, nloc, nx); b.st[0] = nloc; b.st[1] = nx; }
        const unsigned old = xb_add(&bar[XB_XSUB(b.x)], 1u);
        const unsigned gen = old / nloc;
        if (old + 1u == (gen + 1u) * nloc) {
            __builtin_amdgcn_fence(__ATOMIC_RELEASE, "agent");
            asm volatile("s_waitcnt vmcnt(0)" ::: "memory");
            const unsigned og = xb_add(&bar[XB_TOP], 1u);
            const unsigned tg = og / nx;
            if (og + 1u == (tg + 1u) * nx) xb_add(&bar[XB_TOPGEN], 1u);
            else XB_SPIN(xb_ld(&bar[XB_TOPGEN]) == tg, bar);
            __builtin_amdgcn_fence(__ATOMIC_ACQUIRE, "agent");
            xb_add(&bar[XB_XGEN(b.x)], 1u);
            asm volatile("s_waitcnt vmcnt(0)" ::: "memory");
        } else {
            XB_SPIN(xb_ld(&bar[XB_XGEN(b.x)]) == gen, bar);
            __builtin_amdgcn_fence(__ATOMIC_ACQUIRE, "agent");
            asm volatile("s_waitcnt vmcnt(0)" ::: "memory");
        }
    }
    __syncthreads();
}


DI int xcd_swizzle(int t, int nb, int ntiles) {
  const int r = t / nb;
  if ((nb & 7) || (r + 1) * nb > ntiles) return t;
  const int b = t - r * nb, per = nb >> 3;
  return r * nb + (b & 7) * per + (b >> 3);
}

constexpr int NPHASE = 26;
constexpr int SMEM_BYTES = 2 * GBUF;

DI void run_phase(const Params& p, int ph, char* lds) {
  const int bid = blockIdx.x, nb = gridDim.x, wave = threadIdx.x >> 6;
  if (ph == 0) {
    for (int t = bid; t < 192 + 512 + CONV1_TASKS; t += nb) {
      if (t < 192) task_mod(p, t, lds); else if (t < 704) task_rope(p, t - 192); else task_conv1(p, 0, t - 704, lds);
    }
    return;
  }
  if (ph == 25) { for (int t = bid; t < NLAT / 16; t += nb) task_final_norm(p, t); return; }
  const int l = (ph - 1) / 12; int sp = (ph - 1) % 12;
  const bool last = l == 1;
  const int mtiles = last ? 128 : 136;
  if (sp >= 7) sp = (sp == 7) ? 11 : sp - 1;
  switch (sp) {
    case 0: for (int t = bid; t < NTOK / 16; t += nb) task_norm(p, l, t, 0); break;
    case 1: {
      for (int t = bid; t < 136 * 15; t += nb) task_g1(p, l, xcd_swizzle(t, nb, 136 * 15), lds);
      for (int t = (bid + nb - ((136 * 15) % nb)) % nb; t < 136; t += nb) task_g1_tail(p, l, t, lds);
    } break;
    case 2: for (int t = bid; t < 1024; t += nb) task_gla<1>(p, l, xcd_swizzle(t, nb, 1024), lds); break;
    case 3: {
      for (int t = bid; t < 64; t += nb) task_gla_prefix(p, t);
      for (int t = bid; t < 512; t += nb) attn_a_latent(p, l, xcd_swizzle(t, nb, 512) * 4 + wave);
      if (!last) for (int t = bid; t < 32; t += nb) attn_ctx(p, l, (31 - t) * 4 + wave, 0);
    } break;
    case 4: for (int t = bid; t < 1088; t += nb) task_gla<2>(p, l, xcd_swizzle(t, nb, 1088), lds); break;
    case 5: {
      __syncthreads();
      for (int t = bid; t < 512; t += nb) attn_c_latent(p, l, xcd_swizzle(t, nb, 512) * 4 + wave, lds);
      if (!last) for (int t = bid; t < 32; t += nb) attn_ctx(p, l, t * 4 + wave, 1);
      for (int t = bid; t < (last ? NLAT : NTOK) / 16; t += nb) task_gla_out(p, l, t);
    } break;
    case 6: for (int t = bid; t < mtiles * 12; t += nb) task_gates(p, l, xcd_swizzle(t, nb, mtiles * 12), lds); break;
    case 11: for (int t = bid; t < mtiles * 8; t += nb) task_mg(p, l, xcd_swizzle(t, nb, mtiles * 8), lds); break;
    case 7: {
      for (int t = bid; t < 512; t += nb) task_res_wide(p, l, xcd_swizzle(t, nb, 512), (const u16*)(p.ws + OFF_MIXED), D, (const u16*)(p.ws + OFF_WOUT), D, 2, true, lds);
      if (!last) for (int t = bid; t < 128; t += nb) task_res_ctx(p, l, t, (const u16*)(p.ws + OFF_MIXED), D, (const u16*)(p.ws + OFF_WOUT), D, 2, true, lds);
      for (int t = (bid + nb - (last ? 0 : 128)) % nb; t < CONV2_TASKS; t += nb) task_conv2(p, l, t, lds);
    } break;
    case 8: for (int t = bid; t < (last ? NLAT : NTOK) / 16; t += nb) task_norm(p, l, t, 1); break;
    case 9: for (int t = bid; t < mtiles * 22; t += nb) task_f1(p, xcd_swizzle(t, nb, mtiles * 22), lds); break;
    case 10: {
      for (int t = bid; t < 512; t += nb) task_res_wide(p, l, xcd_swizzle(t, nb, 512), (const u16*)(p.ws + OFF_ACT), FH, (const u16*)(p.ws + OFF_WF2), FH, 5, false, lds);
      if (!last) {
        for (int t = bid; t < 128; t += nb) task_res_ctx(p, l, t, (const u16*)(p.ws + OFF_ACT), FH, (const u16*)(p.ws + OFF_WF2), FH, 5, false, lds);
        for (int t = (bid + nb - 128) % nb; t < CONV1_TASKS; t += nb) task_conv1(p, 1, t, lds);
      }
    } break;
  }
}

#if MULTI_LAUNCH
__global__ void __launch_bounds__(256, 2) k_phase(Params p, int ph) {
  __shared__ __attribute__((aligned(16))) char smem[SMEM_BYTES];
  run_phase(p, ph, smem);
}
#endif

#if !MULTI_LAUNCH
__global__ void __launch_bounds__(256, 2) k_mega(Params p) {
  extern __shared__ __attribute__((aligned(16))) char smem[];
  __shared__ uint4 xb_words;
  if (threadIdx.x == 0) xb_words = make_uint4(0u, 0u, 0u, 0u);
  __syncthreads();
  XcdBarrier xb = xcd_barrier_post((unsigned*)(p.ws + OFF_BAR), (volatile LAS unsigned*)&xb_words);
  if (p.ws == nullptr) cg::this_grid().sync();
#define PH(k) run_phase(p, k, smem); xcd_barrier(xb);
  PH(0) PH(1) PH(2) PH(3) PH(4) PH(5) PH(6) PH(7) PH(8) PH(9) PH(10) PH(11) PH(12) PH(13) PH(14) PH(15) PH(16) PH(17) PH(18) PH(19) PH(20) PH(21) PH(22) PH(23) PH(24)
  run_phase(p, 25, smem);
}
#endif

extern "C" void kernel_launch(void* const* d_in, const int* in_sizes, int n_in, void* d_out, int out_size, void* d_ws, size_t ws_size,
                              hipStream_t stream) {
  Params p{};
  const float** f = (const float**)&p;
  for (int i = 0; i < 25; i++) f[i] = (const float*)d_in[i];
  p.out = (float*)d_out;
  p.ws = (char*)d_ws;
#if MULTI_LAUNCH
  for (int ph = 0; ph < NPHASE; ph++) hipLaunchKernelGGL(k_phase, dim3(512), dim3(256), 0, stream, p, ph);
#else
  static int grid_blocks = 0;
  if (!grid_blocks) {
    int dev = 0, cus = 0, per_cu = 0;
    hipGetDevice(&dev);
    hipDeviceGetAttribute(&cus, hipDeviceAttributeMultiprocessorCount, dev);
    (void)hipFuncSetAttribute((const void*)k_mega, hipFuncAttributeMaxDynamicSharedMemorySize, SMEM_BYTES);
    (void)hipOccupancyMaxActiveBlocksPerMultiprocessor(&per_cu, k_mega, 256, SMEM_BYTES);
    if (per_cu > 2) per_cu = 2;
    if (per_cu < 1) per_cu = 1;
    grid_blocks = cus * per_cu;
  }
  hipMemsetAsync((char*)d_ws + OFF_BAR, 0, XCD_BAR_WORDS * 4, stream);
  void* args[] = {&p};
  hipError_t e = hipLaunchCooperativeKernel((void*)k_mega, dim3(grid_blocks), dim3(256), args, SMEM_BYTES, stream);
  if (e != hipSuccess) fprintf(stderr, "cooperative launch failed: %s (grid %d)\n", hipGetErrorString(e), grid_blocks);
#endif
}
```

```cpp
#include <hip/hip_runtime.h>
#include <hip/hip_cooperative_groups.h>
#include <cstdio>
namespace cg = cooperative_groups;

#ifndef MULTI_LAUNCH
#define MULTI_LAUNCH 0
#endif

typedef unsigned short u16;
using bf16x8 = __attribute__((ext_vector_type(8))) short;
using s16x4  = __attribute__((ext_vector_type(4))) short;
using f32x4  = __attribute__((ext_vector_type(4))) float;
#define DI __device__ __forceinline__
#define MFMA16(a, b, c) __builtin_amdgcn_mfma_f32_16x16x32_bf16((a), (b), (c), 0, 0, 0)

constexpr int D = 1024, NB = 4, SEQ = 4096, LC = 256, NLAT = NB * SEQ, NCTX = NB * LC, NTOK = NLAT + NCTX;
constexpr int INT = 3872, INTP = 3968, FH = 2816, PNLD = 2720, VTR = 1152;
constexpr float LOG2E = 1.4426950408889634f;

constexpr size_t OFF_WIN  = 0;
constexpr size_t OFF_WMG  = OFF_WIN + (size_t)INTP * D * 2;
constexpr size_t OFF_WBR  = OFF_WMG + (size_t)3072 * D * 2;
constexpr size_t OFF_WOUT = OFF_WBR + (size_t)3 * 1024 * 512 * 2;
constexpr size_t OFF_WF1  = OFF_WOUT + (size_t)D * D * 2;
constexpr size_t OFF_WF2  = OFF_WF1 + (size_t)2 * FH * D * 2;
constexpr size_t OFF_PAD  = OFF_WF2 + (size_t)D * FH * 2;
constexpr size_t OFF_MOD  = OFF_PAD + (1u << 20);
constexpr size_t OFF_ROPE = OFF_MOD + (size_t)2 * 5 * 6144 * 4;
constexpr size_t OFF_XC   = OFF_ROPE + (size_t)SEQ * 32 * 2 * 4;
constexpr size_t OFF_HB   = OFF_XC + (size_t)NCTX * D * 4;
constexpr size_t OFF_PN   = OFF_HB + (size_t)NTOK * D * 2;
constexpr size_t OFF_VT   = OFF_PN + (size_t)NTOK * PNLD * 2;
constexpr size_t OFF_VTC  = OFF_VT + (size_t)NB * VTR * SEQ * 2;
constexpr size_t OFF_Y    = OFF_VTC + (size_t)NB * VTR * LC * 2;
constexpr size_t WS_END   = OFF_Y + (size_t)3 * NTOK * 512 * 2;
static_assert(WS_END <= ((size_t)256 << 20), "workspace too large");
constexpr size_t OFF_OB    = OFF_WF1;
static_assert(OFF_OB + (size_t)NTOK * 512 * 2 <= OFF_MOD, "o_b alias");
constexpr size_t OFF_BAR   = OFF_PAD + (768u << 10);
constexpr size_t OFF_MIXED = OFF_PN;
constexpr size_t OFF_ACT   = OFF_PN + (size_t)NTOK * D * 2;
static_assert(OFF_ACT + (size_t)NTOK * FH * 2 <= OFF_Y, "act alias");

struct Params {
  const float *x, *c, *ctx, *c_ctx, *w_ada, *b_ada, *norm_mix, *w_in, *sink, *gw_f, *gb_f, *gw_b, *gb_b, *gla_norm, *rpb,
      *w_ba, *w_bb, *w_bc, *w_merge, *b_merge, *w_out, *norm_ffn, *w_ffn_in, *w_ffn_out, *final_norm;
  float* out;
  char* ws;
};

typedef __bf16 bf2_t __attribute__((ext_vector_type(2)));
DI u16 f2bf(float x) { __bf16 v = (__bf16)x; return __builtin_bit_cast(u16, v); }
DI float bf2f(u16 h) { return __uint_as_float(((unsigned)h) << 16); }
DI unsigned pack2(float a, float b) { bf2_t v = {(__bf16)a, (__bf16)b}; return __builtin_bit_cast(unsigned, v); }
DI float wave_sum(float v) { for (int o = 32; o; o >>= 1) v += __shfl_xor(v, o, 64); return v; }
DI float sigmoidf_(float x) { return __builtin_amdgcn_rcpf(1.0f + __expf(-x)); }
DI float siluf_(float x) { return x * __builtin_amdgcn_rcpf(1.0f + __expf(-x)); }

DI const float* xsrc(const Params& p, int l, int row) {
  if (row < NLAT) return (l == 0 ? p.x : p.out) + (size_t)row * D;
  return (l == 0 ? p.ctx : (const float*)(p.ws + OFF_XC)) + (size_t)(row - NLAT) * D;
}
DI float* xdst(const Params& p, int row) {
  if (row < NLAT) return p.out + (size_t)row * D;
  return (float*)(p.ws + OFF_XC) + (size_t)(row - NLAT) * D;
}
DI const float* modp(const Params& p, int l, int row) {
  int s = row < NLAT ? (row >> 12) : 4;
  return (const float*)(p.ws + OFF_MOD) + (size_t)(l * 5 + s) * 6144;
}

constexpr int LROW = 144;
constexpr int LDS_A = 0, LDS_B = 128 * LROW;

constexpr int GROW = 128;
constexpr int G_A = 0, G_B = 128 * GROW;
constexpr int GBUF = 2 * 128 * GROW;
template <int NI, int CH>
DI void gemm_tile(const u16* __restrict__ A, int lda, const u16* __restrict__ Bt, int ldb, int K,
                  f32x4 (&acc)[4][NI], char* lds) {
  const int tid = threadIdx.x, lane = tid & 63, wave = tid >> 6;
  const int wm = wave >> 1, wn = wave & 1, g = lane >> 4, n = lane & 15;
  const int lrow = tid >> 3, lkc = tid & 7;
  const u16* ap = CH ? A + (size_t)lrow * 32 + (size_t)(lkc >> 2) * lda * 32 + (lkc & 3) * 8 : A + (size_t)lrow * lda + lkc * 8;
  const u16* bp = CH ? Bt + (size_t)lrow * 32 + (size_t)(lkc >> 2) * ldb * 32 + (lkc & 3) * 8 : Bt + (size_t)lrow * ldb + lkc * 8;
  const size_t sa = CH ? (size_t)32 * 32 : (size_t)32 * lda, sb = CH ? (size_t)32 * 32 : (size_t)32 * ldb;
  const size_t ka = CH ? (size_t)lda : 1, kb = CH ? (size_t)ldb : 1;
  const int wsw = (lkc ^ ((lrow >> 1) & 7)) * 16;
  const int rsw0 = (g ^ ((n >> 1) & 7)) * 16, rsw1 = ((4 + g) ^ ((n >> 1) & 7)) * 16;
  uint4 ra0, ra1, ra2, ra3, rb0, rb1, rb2, rb3;
#define GLOADS(kk)                                                                                                   \
  {                                                                                                                  \
    ra0 = *(const uint4*)(ap + (kk) * ka); ra1 = *(const uint4*)(ap + sa + (kk) * ka);                               \
    ra2 = *(const uint4*)(ap + 2 * sa + (kk) * ka); ra3 = *(const uint4*)(ap + 3 * sa + (kk) * ka);                  \
    rb0 = *(const uint4*)(bp + (kk) * kb); rb1 = *(const uint4*)(bp + sb + (kk) * kb);                               \
    if (NI == 4) { rb2 = *(const uint4*)(bp + 2 * sb + (kk) * kb); rb3 = *(const uint4*)(bp + 3 * sb + (kk) * kb); } \
  }
#define LSTORES(buf)                                                                                                 \
  {                                                                                                                  \
    char* wa_ = lds + (buf) * GBUF + G_A + lrow * GROW + wsw;                                                        \
    char* wb_ = lds + (buf) * GBUF + G_B + lrow * GROW + wsw;                                                        \
    *(uint4*)(wa_) = ra0; *(uint4*)(wa_ + 32 * GROW) = ra1; *(uint4*)(wa_ + 64 * GROW) = ra2; *(uint4*)(wa_ + 96 * GROW) = ra3; \
    *(uint4*)(wb_) = rb0; *(uint4*)(wb_ + 32 * GROW) = rb1;                                                          \
    if (NI == 4) { *(uint4*)(wb_ + 64 * GROW) = rb2; *(uint4*)(wb_ + 96 * GROW) = rb3; }                             \
  }
  GLOADS(0);
  __syncthreads();
  LSTORES(0);
  GLOADS(64);
  __syncthreads();
  const int nk = K >> 6;
#pragma unroll 1
  for (int it = 0; it < nk; it++) {
    const int cur = it & 1;
    if (it + 1 < nk) LSTORES(cur ^ 1);
    if (it + 2 < nk) GLOADS((it + 2) * 64);
    const char* fa = lds + cur * GBUF + G_A + (wm * 64 + n) * GROW;
    const char* fb = lds + cur * GBUF + G_B + (wn * 16 * NI + n) * GROW;
#pragma unroll
    for (int ks = 0; ks < 2; ks++) {
      const int rsw = ks ? rsw1 : rsw0;
      bf16x8 af[4], bfr[NI];
#pragma unroll
      for (int i = 0; i < 4; i++) af[i] = *(const bf16x8*)(fa + i * 16 * GROW + rsw);
#pragma unroll
      for (int i = 0; i < NI; i++) bfr[i] = *(const bf16x8*)(fb + i * 16 * GROW + rsw);
#pragma unroll
      for (int mi = 0; mi < 4; mi++)
#pragma unroll
        for (int ni = 0; ni < NI; ni++) acc[mi][ni] = MFMA16(af[mi], bfr[ni], acc[mi][ni]);
    }
    __syncthreads();
  }
#undef GLOADS
#undef LSTORES
}

template <int NI>
DI void zero_acc(f32x4 (&acc)[4][NI]) {
#pragma unroll
  for (int i = 0; i < 4; i++)
#pragma unroll
    for (int j = 0; j < NI; j++) acc[i][j] = f32x4{0.f, 0.f, 0.f, 0.f};
}

constexpr int LROW2 = 64;
constexpr int W_A = 0, W_B = 128 * LROW2, WBUF = 384 * LROW2;
DI void gemm_wide(const u16* __restrict__ A, int lda, const u16* __restrict__ Bt, int ldb, int K, f32x4 (&acc)[4][8], char* lds) {
  const int tid = threadIdx.x, lane = tid & 63, wave = tid >> 6;
  const int wm = wave >> 1, wn = wave & 1, g = lane >> 4, n = lane & 15;
  const int lrow = tid >> 2, lkc = tid & 3;
  const u16* ap = A + (size_t)lrow * 32 + lkc * 8;
  const u16* bp = Bt + (size_t)lrow * 32 + lkc * 8;
  const size_t sa = (size_t)64 * 32, sb = (size_t)64 * 32;
  const size_t ka = (size_t)lda, kb = (size_t)ldb;
  uint4 ra0, ra1, rb0, rb1, rb2, rb3;
  const int wsw = (lkc ^ ((0 - (lrow >> 2)) & 3)) * 16;
  const int rsw = (g ^ ((0 - (n >> 2)) & 3)) * 16;
#define GLOADS(kk)                                                                           \
  {                                                                                          \
    ra0 = *(const uint4*)(ap + (kk) * ka); ra1 = *(const uint4*)(ap + sa + (kk) * ka);       \
    rb0 = *(const uint4*)(bp + (kk) * kb); rb1 = *(const uint4*)(bp + sb + (kk) * kb);       \
    rb2 = *(const uint4*)(bp + 2 * sb + (kk) * kb); rb3 = *(const uint4*)(bp + 3 * sb + (kk) * kb); \
  }
#define LSTORES(buf)                                                                         \
  {                                                                                          \
    char* wa_ = lds + (buf) * WBUF + W_A + lrow * LROW2 + wsw;                               \
    char* wb_ = lds + (buf) * WBUF + W_B + lrow * LROW2 + wsw;                               \
    *(uint4*)(wa_) = ra0; *(uint4*)(wa_ + 64 * LROW2) = ra1;                                 \
    *(uint4*)(wb_) = rb0; *(uint4*)(wb_ + 64 * LROW2) = rb1;                                 \
    *(uint4*)(wb_ + 128 * LROW2) = rb2; *(uint4*)(wb_ + 192 * LROW2) = rb3;                  \
  }
#define HALF(h)                                                                              \
  {                                                                                          \
    bf16x8 bfr[4];                                                                           \
    _Pragma("unroll") for (int i = 0; i < 4; i++) bfr[i] = *(const bf16x8*)(fb + ((h) * 4 + i) * 16 * LROW2); \
    _Pragma("unroll") for (int mi = 0; mi < 4; mi++)                                         \
      _Pragma("unroll") for (int ni = 0; ni < 4; ni++) acc[mi][(h) * 4 + ni] = MFMA16(af[mi], bfr[ni], acc[mi][(h) * 4 + ni]); \
  }
  GLOADS(0);
  __syncthreads();
  LSTORES(0);
  GLOADS(32);
  __syncthreads();
  const int nk = K >> 5;
#pragma unroll 1
  for (int it = 0; it < nk; it++) {
    const int cur = it & 1;
    const char* fa = lds + cur * WBUF + W_A + (wm * 64 + n) * LROW2 + rsw;
    const char* fb = lds + cur * WBUF + W_B + (wn * 128 + n) * LROW2 + rsw;
    bf16x8 af[4];
#pragma unroll
    for (int i = 0; i < 4; i++) af[i] = *(const bf16x8*)(fa + i * 16 * LROW2);
    __builtin_amdgcn_s_setprio(1);
    HALF(0);
    if (it + 1 < nk) LSTORES(cur ^ 1);
    if (it + 2 < nk) GLOADS((it + 2) * 32);
    HALF(1);
    __builtin_amdgcn_s_setprio(0);
    __syncthreads();
  }
#undef GLOADS
#undef LSTORES
#undef HALF
}

DI void task_mod(const Params& p, int task, char* lds) {
  const int tid = threadIdx.x, lane = tid & 63, wave = tid >> 6;
  const int l = task / 96, cb = task % 96;
  float* sc = (float*)lds;
  float* red = sc + 5 * 1024;
  __syncthreads();
  for (int i = tid; i < 5 * 1024; i += 256) {
    int s = i >> 10, k = i & 1023;
    float v = s < 4 ? p.c[s * 1024 + k] : p.c_ctx[k];
    sc[i] = siluf_(v);
  }
  __syncthreads();
  const int ncol = cb * 64 + lane;
  const float* w = p.w_ada + (size_t)l * 1024 * 6144 + ncol;
  float a0 = 0, a1 = 0, a2 = 0, a3 = 0, a4 = 0;
#pragma unroll 16
  for (int k = wave * 256; k < wave * 256 + 256; k++) {
    float wv = w[(size_t)k * 6144];
    a0 += sc[k] * wv; a1 += sc[1024 + k] * wv; a2 += sc[2048 + k] * wv; a3 += sc[3072 + k] * wv; a4 += sc[4096 + k] * wv;
  }
  red[(wave * 5 + 0) * 64 + lane] = a0; red[(wave * 5 + 1) * 64 + lane] = a1; red[(wave * 5 + 2) * 64 + lane] = a2;
  red[(wave * 5 + 3) * 64 + lane] = a3; red[(wave * 5 + 4) * 64 + lane] = a4;
  __syncthreads();
  float* mod = (float*)(p.ws + OFF_MOD);
  for (int i = tid; i < 320; i += 256) {
    int s = i >> 6, ln = i & 63;
    float v = red[(0 * 5 + s) * 64 + ln] + red[(1 * 5 + s) * 64 + ln] + red[(2 * 5 + s) * 64 + ln] + red[(3 * 5 + s) * 64 + ln];
    int nc = cb * 64 + ln;
    mod[(size_t)(l * 5 + s) * 6144 + nc] = v + p.b_ada[l * 6144 + nc];
  }
}

DI void task_rope(const Params& p, int task) {
  int e = task * 256 + threadIdx.x;
  int t = e >> 5, i = e & 31;
  float pos = (i < 16) ? (float)(t >> 6) : (float)(t & 63);
  float inv = exp2f(-(float)(i & 15) * (13.287712379549449f / 16.0f));
  float ang = pos * inv;
  float kq = rintf(ang * 0.15915494309189535f);
  float rr = fmaf(-kq, 6.28125f, ang);
  rr = fmaf(-kq, 0.0019353071795864769f, rr);
  float s = sinf(rr), c = cosf(rr);
  float* rc = (float*)(p.ws + OFF_ROPE);
  rc[e] = c; rc[SEQ * 32 + e] = s;
}

DI void conv_tile(const float* __restrict__ src, int K, int N, int kt, int nt, u16* __restrict__ dst, int mode, int R, char* lds) {
  float* tile = (float*)lds;
  const int tid = threadIdx.x;
  const int k0 = kt * 128, n0 = nt * 64;
  __syncthreads();
  {
    float4 v[8];
#pragma unroll
    for (int i = 0; i < 8; i++) {
      int idx = tid + 256 * i, kk = idx >> 4, n4 = (idx & 15) * 4;
      v[i] = float4{0.f, 0.f, 0.f, 0.f};
      if (n0 + n4 < N) {
        const f32x4 w = __builtin_nontemporal_load((const f32x4*)(src + (size_t)(k0 + kk) * N + n0 + n4));
        v[i] = float4{w[0], w[1], w[2], w[3]};
      }
    }
#pragma unroll
    for (int i = 0; i < 8; i++) {
      int idx = tid + 256 * i, kk = idx >> 4, n4 = (idx & 15) * 4;
      float* t = tile + kk * 65 + n4;
      t[0] = v[i].x; t[1] = v[i].y; t[2] = v[i].z; t[3] = v[i].w;
    }
  }
  __syncthreads();
#pragma unroll
  for (int i = 0; i < 4; i++) {
    int cidx = tid + 256 * i, nn = cidx >> 4, kc = cidx & 15;
    int ncol = n0 + nn;
    if (ncol < N) {
      int drow = ncol;
      if (mode == 1) {
        int up = ncol >= FH, j = up ? ncol - FH : ncol;
        drow = (j >> 7) * 256 + ((j >> 6) & 1) * 128 + up * 64 + (j & 63);
      }
      uint4 o;
      o.x = pack2(tile[(kc * 8 + 0) * 65 + nn], tile[(kc * 8 + 1) * 65 + nn]);
      o.y = pack2(tile[(kc * 8 + 2) * 65 + nn], tile[(kc * 8 + 3) * 65 + nn]);
      o.z = pack2(tile[(kc * 8 + 4) * 65 + nn], tile[(kc * 8 + 5) * 65 + nn]);
      o.w = pack2(tile[(kc * 8 + 6) * 65 + nn], tile[(kc * 8 + 7) * 65 + nn]);
      const int kd = k0 + kc * 8;
      if (R > 0) *(uint4*)(dst + ((size_t)(kd >> 5) * R + drow) * 32 + (kd & 31)) = o;
      else *(uint4*)(dst + (size_t)drow * K + kd) = o;
    }
  }
}

constexpr int CONV1_TASKS = 488 + 384 + 192 + 128 + 1;
constexpr int CONV2_TASKS = 704 + 352;
DI void task_conv1(const Params& p, int l, int t, char* lds) {
  if (t < 488) { conv_tile(p.w_in + (size_t)l * D * INT, D, INT, t / 61, t % 61, (u16*)(p.ws + OFF_WIN), 0, INTP, lds); return; }
  t -= 488;
  if (t < 384) { conv_tile(p.w_merge + (size_t)l * D * 3072, D, 3072, t / 48, t % 48, (u16*)(p.ws + OFF_WMG), 0, 3072, lds); return; }
  t -= 384;
  if (t < 192) {
    int br = t / 64, tt = t % 64;
    const float* src = (br == 0 ? p.w_ba : br == 1 ? p.w_bb : p.w_bc) + (size_t)l * 512 * D;
    conv_tile(src, 512, D, tt / 16, tt % 16, (u16*)(p.ws + OFF_WBR) + (size_t)br * 1024 * 512, 0, 0, lds);
    return;
  }
  t -= 192;
  if (t < 128) { conv_tile(p.w_out + (size_t)l * D * D, D, D, t / 16, t % 16, (u16*)(p.ws + OFF_WOUT), 0, D, lds); return; }
  uint4 z = {0, 0, 0, 0};
  for (int i = threadIdx.x; i < 32 * (INTP - INT) * 4; i += 256) {
    const int ch = i / ((INTP - INT) * 4), off = i % ((INTP - INT) * 4);
    *(uint4*)((u16*)(p.ws + OFF_WIN) + ((size_t)ch * INTP + INT) * 32 + off * 8) = z;
  }
}
DI void task_conv2(const Params& p, int l, int t, char* lds) {
  if (t < 704) { conv_tile(p.w_ffn_in + (size_t)l * D * 2 * FH, D, 2 * FH, t / 88, t % 88, (u16*)(p.ws + OFF_WF1), 1, 2 * FH, lds); return; }
  t -= 704;
  conv_tile(p.w_ffn_out + (size_t)l * FH * D, FH, D, t / 16, t % 16, (u16*)(p.ws + OFF_WF2), 0, D, lds);
}

DI void task_norm(const Params& p, int l, int task, int which) {
  const int lane = threadIdx.x & 63, wave = threadIdx.x >> 6;
  const int row0 = task * 16 + wave * 4;
  const float* g = (which == 0 ? p.norm_mix : p.norm_ffn) + l * D;
  const float* md = modp(p, l, row0) + (which ? 3 * D : 0);
  float4 v[4][4];
#pragma unroll
  for (int r = 0; r < 4; r++) {
    const float* xr = which == 0 ? xsrc(p, l, row0 + r) : (const float*)xdst(p, row0 + r);
#pragma unroll
    for (int i = 0; i < 4; i++) v[r][i] = *(const float4*)(xr + i * 256 + lane * 4);
  }
  float rstd[4];
#pragma unroll
  for (int r = 0; r < 4; r++) {
    float ss = 0.f;
#pragma unroll
    for (int i = 0; i < 4; i++) ss += v[r][i].x * v[r][i].x + v[r][i].y * v[r][i].y + v[r][i].z * v[r][i].z + v[r][i].w * v[r][i].w;
    ss = wave_sum(ss);
    rstd[r] = rsqrtf(ss * (1.0f / 1024.0f) + 1e-6f);
  }
  u16* hb = (u16*)(p.ws + OFF_HB) + (size_t)row0 * 32;
#pragma unroll
  for (int i = 0; i < 4; i++) {
    const int cidx = i * 256 + lane * 4;
    const float4 gg = *(const float4*)(g + cidx), sh = *(const float4*)(md + cidx), sc = *(const float4*)(md + D + cidx);
    const float a0 = gg.x * (1.f + sc.x), a1 = gg.y * (1.f + sc.y), a2 = gg.z * (1.f + sc.z), a3 = gg.w * (1.f + sc.w);
#pragma unroll
    for (int r = 0; r < 4; r++) {
      uint2 o;
      o.x = pack2(v[r][i].x * rstd[r] * a0 + sh.x, v[r][i].y * rstd[r] * a1 + sh.y);
      o.y = pack2(v[r][i].z * rstd[r] * a2 + sh.z, v[r][i].w * rstd[r] * a3 + sh.w);
      *(uint2*)(hb + (size_t)(cidx >> 5) * NTOK * 32 + r * 32 + (cidx & 31)) = o;
    }
  }
}
DI void task_final_norm(const Params& p, int task) {
  const int lane = threadIdx.x & 63, wave = threadIdx.x >> 6;
  float* xr = p.out + (size_t)(task * 16 + wave * 4) * D;
  float4 v[4][4];
#pragma unroll
  for (int r = 0; r < 4; r++)
#pragma unroll
    for (int i = 0; i < 4; i++) v[r][i] = *(const float4*)(xr + (size_t)r * D + i * 256 + lane * 4);
  float rstd[4];
#pragma unroll
  for (int r = 0; r < 4; r++) {
    float ss = 0.f;
#pragma unroll
    for (int i = 0; i < 4; i++) ss += v[r][i].x * v[r][i].x + v[r][i].y * v[r][i].y + v[r][i].z * v[r][i].z + v[r][i].w * v[r][i].w;
    ss = wave_sum(ss);
    rstd[r] = rsqrtf(ss * (1.0f / 1024.0f) + 1e-6f);
  }
#pragma unroll
  for (int i = 0; i < 4; i++) {
    const int cidx = i * 256 + lane * 4;
    const float4 gg = *(const float4*)(p.final_norm + cidx);
#pragma unroll
    for (int r = 0; r < 4; r++) {
      float4 o = {v[r][i].x * rstd[r] * gg.x, v[r][i].y * rstd[r] * gg.y, v[r][i].z * rstd[r] * gg.z, v[r][i].w * rstd[r] * gg.w};
      *(float4*)(xr + (size_t)r * D + cidx) = o;
    }
  }
}

DI void task_g1(const Params& p, int l, int tile, char* lds) {
  const int mt = tile / 15, nt = tile % 15;
  const int tid = threadIdx.x, lane = tid & 63, wave = tid >> 6;
  const int wm = wave >> 1, wn = wave & 1, g = lane >> 4, n = lane & 15;
  f32x4 acc[4][8];
#pragma unroll
  for (int i = 0; i < 4; i++)
#pragma unroll
    for (int j = 0; j < 8; j++) acc[i][j] = f32x4{0.f, 0.f, 0.f, 0.f};
  gemm_wide((const u16*)(p.ws + OFF_HB) + (size_t)mt * 128 * 32, NTOK, (const u16*)(p.ws + OFF_WIN) + (size_t)nt * 256 * 32, INTP, D, acc, lds);
  const int cw = nt * 256 + wn * 128;
  const int rw = mt * 128 + wm * 64;
  if (mt < 128) {
    const float* rc = (const float*)(p.ws + OFF_ROPE);
    const float* rs = rc + SEQ * 32;
#pragma unroll
    for (int hh = 0; hh < 2; hh++) {
      if (cw + hh * 64 >= 640) continue;
#pragma unroll
      for (int mi = 0; mi < 4; mi++)
#pragma unroll
        for (int ni = 0; ni < 2; ni++)
#pragma unroll
          for (int r = 0; r < 4; r++) {
            int t = (rw + mi * 16 + 4 * g + r) & 4095;
            float c = rc[t * 32 + ni * 16 + n], sn = rs[t * 32 + ni * 16 + n];
            float x1 = acc[mi][hh * 4 + ni][r], x2 = acc[mi][hh * 4 + ni + 2][r];
            acc[mi][hh * 4 + ni][r] = x1 * c - x2 * sn;
            acc[mi][hh * 4 + ni + 2][r] = x1 * sn + x2 * c;
          }
    }
  }
  u16* PN = (u16*)(p.ws + OFF_PN);
  u16* VT = (u16*)(p.ws + OFF_VT);
  u16* VTc = (u16*)(p.ws + OFF_VTC);
#pragma unroll
  for (int ni = 0; ni < 8; ni++) {
    const int c16 = cw + ni * 16;
    if (c16 >= INT) continue;
    int tr = -1, nat = 0;
    if (c16 < 640) nat = c16;
    else if (c16 < 768) tr = c16 - 640;
    else if (c16 < 1280) nat = c16 - 128;
    else if (c16 < 1792) tr = 128 + c16 - 1280;
    else if (c16 < 3360) nat = c16 - 640;
    else tr = 640 + c16 - 3360;
#pragma unroll
    for (int mi = 0; mi < 4; mi++) {
      const int row0 = rw + mi * 16 + 4 * g;
      if (tr < 0) {
#pragma unroll
        for (int r = 0; r < 4; r++) PN[(size_t)(row0 + r) * PNLD + nat + n] = f2bf(acc[mi][ni][r]);
      } else {
        uint2 o; o.x = pack2(acc[mi][ni][0], acc[mi][ni][1]); o.y = pack2(acc[mi][ni][2], acc[mi][ni][3]);
        if (mt < 128) {
          int b = row0 >> 12, tok = row0 & 4095;
          *(uint2*)(VT + ((size_t)(b * VTR + tr + n)) * SEQ + tok) = o;
        } else {
          int rr = row0 - NLAT, b = rr >> 8, tok = rr & 255;
          *(uint2*)(VTc + ((size_t)(b * VTR + tr + n)) * LC + tok) = o;
        }
      }
    }
  }
}

DI void task_g1_tail(const Params& p, int l, int mt, char* lds) {
  const int tid = threadIdx.x, lane = tid & 63, wave = tid >> 6;
  const int wm = wave >> 1, wn = wave & 1, g = lane >> 4, n = lane & 15;
  f32x4 acc[4][2];
  zero_acc<2>(acc);
  gemm_tile<2, 1>((const u16*)(p.ws + OFF_HB) + (size_t)mt * 128 * 32, NTOK, (const u16*)(p.ws + OFF_WIN) + (size_t)3840 * 32, INTP, D, acc, lds);
  if (wn != 0) return;
  u16* VT = (u16*)(p.ws + OFF_VT);
  u16* VTc = (u16*)(p.ws + OFF_VTC);
#pragma unroll
  for (int ni = 0; ni < 2; ni++) {
    const int tr = 640 + (3840 - 3360) + ni * 16;
#pragma unroll
    for (int mi = 0; mi < 4; mi++) {
      const int row0 = mt * 128 + wm * 64 + mi * 16 + 4 * g;
      uint2 o; o.x = pack2(acc[mi][ni][0], acc[mi][ni][1]); o.y = pack2(acc[mi][ni][2], acc[mi][ni][3]);
      if (mt < 128) {
        int b = row0 >> 12, tok = row0 & 4095;
        *(uint2*)(VT + ((size_t)(b * VTR + tr + n)) * SEQ + tok) = o;
      } else {
        int rr = row0 - NLAT, b = rr >> 8, tok = rr & 255;
        *(uint2*)(VTc + ((size_t)(b * VTR + tr + n)) * LC + tok) = o;
      }
    }
  }
}

constexpr float QSC = 0.125f * LOG2E;

template <class QF, class OF, class M0F, class TileFn, class ScoreFn, class SkipFn>
DI void attn_core4(QF qptr, OF optr, M0F m0f, float l0, int ntiles, TileFn tilefn, ScoreFn scorefn, SkipFn skipfn) {
  const int lane = threadIdx.x & 63, g = lane >> 4, n = lane & 15;
  bf16x8 qf[4][2];
  f32x4 o[4][4];
  float m[4], ls[4];
#pragma unroll
  for (int gi = 0; gi < 4; gi++) {
    const u16* q = qptr(gi);
    qf[gi][0] = *(const bf16x8*)(q + (size_t)n * PNLD + g * 8);
    qf[gi][1] = *(const bf16x8*)(q + (size_t)n * PNLD + 32 + g * 8);
#pragma unroll
    for (int i = 0; i < 4; i++) o[gi][i] = f32x4{0.f, 0.f, 0.f, 0.f};
    m[gi] = m0f(gi);
    ls[gi] = (g == 0) ? l0 : 0.f;
  }
  const u16* kp; const u16* vp; int vld, aux;
  tilefn(0, kp, vp, vld, aux);
  bf16x8 kn0, kn1, kn2, kn3;
  bf16x8 vn0, vn1, vn2, vn3;
  const int krow0 = 8 * (n >> 2) + (n & 3);
#define LOADK()                                                                     \
  {                                                                                 \
    const u16* kr = kp + (size_t)krow0 * PNLD + g * 8;                              \
    kn0 = *(const bf16x8*)(kr); kn1 = *(const bf16x8*)(kr + (size_t)4 * PNLD);      \
    kn2 = *(const bf16x8*)(kr + 32); kn3 = *(const bf16x8*)(kr + (size_t)4 * PNLD + 32); \
  }
#define LOADV()                                                                     \
  {                                                                                 \
    const u16* vr = vp + (size_t)n * vld + 8 * g;                                   \
    vn0 = *(const bf16x8*)(vr); vn1 = *(const bf16x8*)(vr + (size_t)16 * vld);      \
    vn2 = *(const bf16x8*)(vr + (size_t)32 * vld); vn3 = *(const bf16x8*)(vr + (size_t)48 * vld); \
  }
  LOADK();
  LOADV();
#pragma unroll 1
  for (int t = 0; t < ntiles; t++) {
    const int auxc = aux;
    const bool more = t + 1 < ntiles;
    bf16x8 vf[4];
    vf[0] = vn0; vf[1] = vn1; vf[2] = vn2; vf[3] = vn3;
#pragma unroll
    for (int hf = 0; hf < 2; hf++) {
      f32x4 s0[2], s1[2];
#pragma unroll
      for (int gg = 0; gg < 2; gg++) {
        const int gi = hf * 2 + gg;
        s0[gg] = f32x4{0.f, 0.f, 0.f, 0.f}; s1[gg] = f32x4{0.f, 0.f, 0.f, 0.f};
        if (skipfn(gi, auxc)) continue;
        s0[gg] = MFMA16(kn0, qf[gi][0], s0[gg]); s1[gg] = MFMA16(kn1, qf[gi][0], s1[gg]);
        s0[gg] = MFMA16(kn2, qf[gi][1], s0[gg]); s1[gg] = MFMA16(kn3, qf[gi][1], s1[gg]);
      }
      if (hf == 1 && more) { tilefn(t + 1, kp, vp, vld, aux); LOADK(); }
#pragma unroll
      for (int gg = 0; gg < 2; gg++) {
        const int gi = hf * 2 + gg;
        if (skipfn(gi, auxc)) continue;
        float sc[8];
#pragma unroll
        for (int r = 0; r < 4; r++) {
          sc[r] = scorefn(gi, auxc, 8 * g + r, n, s0[gg][r]);
          sc[4 + r] = scorefn(gi, auxc, 8 * g + 4 + r, n, s1[gg][r]);
        }
        float mx = fmaxf(fmaxf(fmaxf(sc[0], sc[1]), fmaxf(sc[2], sc[3])), fmaxf(fmaxf(sc[4], sc[5]), fmaxf(sc[6], sc[7])));
        mx = fmaxf(mx, __shfl_xor(mx, 16, 64));
        mx = fmaxf(mx, __shfl_xor(mx, 32, 64));
        const float mn = fmaxf(m[gi], mx);
        const float alpha = __builtin_amdgcn_exp2f(m[gi] - mn);
        float pv[8], ps = 0.f;
#pragma unroll
        for (int r = 0; r < 8; r++) { pv[r] = __builtin_amdgcn_exp2f(sc[r] - mn); ps += pv[r]; }
        ls[gi] = ls[gi] * alpha + ps;
        m[gi] = mn;
        union { bf16x8 v; unsigned u[4]; } pf;
        pf.u[0] = pack2(pv[0], pv[1]); pf.u[1] = pack2(pv[2], pv[3]); pf.u[2] = pack2(pv[4], pv[5]); pf.u[3] = pack2(pv[6], pv[7]);
#pragma unroll
        for (int d4 = 0; d4 < 4; d4++) {
          o[gi][d4] *= alpha;
          o[gi][d4] = MFMA16(vf[d4], pf.v, o[gi][d4]);
        }
      }
    }
    if (more) LOADV();
  }
#undef LOADK
#undef LOADV
#pragma unroll
  for (int gi = 0; gi < 4; gi++) {
    float lsum = ls[gi];
    lsum += __shfl_xor(lsum, 16, 64);
    lsum += __shfl_xor(lsum, 32, 64);
    const float inv = 1.0f / lsum;
    u16* ob = optr(gi);
#pragma unroll
    for (int d4 = 0; d4 < 4; d4++) {
      uint2 w; w.x = pack2(o[gi][d4][0] * inv, o[gi][d4][1] * inv); w.y = pack2(o[gi][d4][2] * inv, o[gi][d4][3] * inv);
      *(uint2*)(ob + (size_t)n * 512 + d4 * 16 + 4 * g) = w;
    }
  }
}

DI void attn_a_latent(const Params& p, int l, int wt) {
  wt = __builtin_amdgcn_readfirstlane(wt);
  const int kvh = wt & 1, qt = (wt >> 1) & 255, b = wt >> 9, q0 = qt * 16;
  const u16* PN = (const u16*)(p.ws + OFF_PN);
  const u16* VT = (const u16*)(p.ws + OFF_VT);
  const u16* VTc = (const u16*)(p.ws + OFF_VTC);
  int jlo = (q0 - 128) & ~31; if (jlo < 0) jlo = 0;
  int jhi = (q0 + 144 + 31) & ~31; if (jhi > SEQ) jhi = SEQ;
  const int ntiles = 8 + (jhi - jlo) / 32;
  const u16* kc = PN + (size_t)(NLAT + b * LC) * PNLD + 512 + kvh * 64;
  const u16* kl = PN + (size_t)(b * SEQ) * PNLD + 512 + kvh * 64;
  const u16* vc = VTc + (size_t)(b * VTR + kvh * 64) * LC;
  const u16* vl = VT + (size_t)(b * VTR + kvh * 64) * SEQ;
  const u16* qb = PN + (size_t)(b * SEQ + q0) * PNLD + kvh * 256;
  u16* ob = (u16*)(p.ws + OFF_Y) + (size_t)(b * SEQ + q0) * 512 + kvh * 256;
  const float* sk = p.sink + l * 8 + kvh * 4;
  auto tilefn = [&](int t, const u16*& kp, const u16*& vp, int& vld, int& aux) {
    if (t < 8) { kp = kc + (size_t)(t * 32) * PNLD; vp = vc + t * 32; vld = LC; aux = -1; }
    else { int j0 = jlo + (t - 8) * 32; kp = kl + (size_t)j0 * PNLD; vp = vl + j0; vld = SEQ; aux = j0; }
  };
  auto scorefn = [&](int gi, int aux, int kidx, int n, float dot) -> float {
    float s = dot * QSC;
    if (aux >= 0) { int dj = aux + kidx - (q0 + n); if (dj > 128 || dj < -128) s = -INFINITY; }
    return s;
  };
  attn_core4([&](int gi) { return qb + gi * 64; }, [&](int gi) { return ob + gi * 64; }, [&](int gi) { return sk[gi] * LOG2E; }, 1.0f,
             ntiles, tilefn, scorefn, [&](int gi, int aux) { return false; });
}

DI void attn_c_latent(const Params& p, int l, int wt, char* lds) {
  wt = __builtin_amdgcn_readfirstlane(wt);
  const int head = wt & 7, r = (wt >> 3) & 63, b = wt >> 9;
  const u16* PN = (const u16*)(p.ws + OFF_PN);
  const u16* VT = (const u16*)(p.ws + OFF_VT);
  const u16* VTc = (const u16*)(p.ws + OFF_VTC);
  int rs = r - 4; rs = rs < 0 ? 0 : (rs > 56 ? 56 : rs);
  const int tok0 = b * SEQ + r * 64;
  const u16* kc = PN + (size_t)(NLAT + b * LC) * PNLD + 2208 + head * 64;
  const u16* kl = PN + (size_t)(b * SEQ) * PNLD + 2208 + head * 64;
  const u16* vc = VTc + (size_t)(b * VTR + 640 + head * 64) * LC;
  const u16* vl = VT + (size_t)(b * VTR + 640 + head * 64) * SEQ;
  float* rpb = (float*)(lds + (threadIdx.x >> 6) * 2048);
  {
    const float* src = p.rpb + (size_t)(l * 8 + head) * 15 * 31;
    const int lane_ = threadIdx.x & 63;
    for (int i = lane_; i < 465; i += 64) rpb[i] = src[i] * LOG2E;
  }
  const u16* qb = PN + (size_t)tok0 * PNLD + 1696 + head * 64;
  u16* ob = (u16*)(p.ws + OFF_Y) + (size_t)2 * NTOK * 512 + (size_t)tok0 * 512 + head * 64;
  auto tilefn = [&](int t, const u16*& kp, const u16*& vp, int& vld, int& aux) {
    if (t < 8) { kp = kc + (size_t)(t * 32) * PNLD; vp = vc + t * 32; vld = LC; aux = -1; }
    else { int a = t - 8; int tk = (rs + (a >> 1)) * 64 + (a & 1) * 32; kp = kl + (size_t)tk * PNLD; vp = vl + tk; vld = SEQ; aux = a; }
  };
  auto scorefn = [&](int gi, int aux, int kidx, int n, float dot) -> float {
    float s = dot * QSC;
    if (aux >= 0) {
      int kcol = (aux & 1) * 32 + kidx, qcol = gi * 16 + n;
      int wsx = qcol - 8; wsx = wsx < 0 ? 0 : (wsx > 48 ? 48 : wsx);
      int drow = rs + (aux >> 1) - r + 7;
      int dc = kcol - qcol; dc = dc < -15 ? -15 : (dc > 15 ? 15 : dc);
      float bias = rpb[drow * 31 + dc + 15];
      s = (kcol >= wsx && kcol < wsx + 16) ? s + bias : -INFINITY;
    }
    return s;
  };
  attn_core4([&](int gi) { return qb + (size_t)gi * 16 * PNLD; }, [&](int gi) { return ob + (size_t)gi * 16 * 512; },
             [&](int gi) { return -INFINITY; }, 0.0f, 24, tilefn, scorefn,
             [&](int gi, int aux) { return aux >= 0 && ((gi == 0 && (aux & 1)) || (gi == 3 && !(aux & 1))); });
}

DI void attn_ctx(const Params& p, int l, int wt, int which) {
  wt = __builtin_amdgcn_readfirstlane(wt);
  const u16* PN = (const u16*)(p.ws + OFF_PN);
  const u16* VTc = (const u16*)(p.ws + OFF_VTC);
  if (which == 0) {
    const int kvh = wt & 1, qt = (wt >> 1) & 15, b = wt >> 5;
    const int row0 = NLAT + b * LC + qt * 16;
    const u16* kc = PN + (size_t)(NLAT + b * LC) * PNLD + 512 + kvh * 64;
    const u16* vc = VTc + (size_t)(b * VTR + kvh * 64) * LC;
    const u16* qb = PN + (size_t)row0 * PNLD + kvh * 256;
    u16* ob = (u16*)(p.ws + OFF_Y) + (size_t)row0 * 512 + kvh * 256;
    const float* sk = p.sink + l * 8 + kvh * 4;
    attn_core4([&](int gi) { return qb + gi * 64; }, [&](int gi) { return ob + gi * 64; }, [&](int gi) { return sk[gi] * LOG2E; }, 1.0f, 8,
               [&](int t, const u16*& kp, const u16*& vp, int& vld, int& aux) { kp = kc + (size_t)(t * 32) * PNLD; vp = vc + t * 32; vld = LC; aux = -1; },
               [&](int gi, int aux, int kidx, int n, float dot) -> float { return dot * QSC; }, [&](int gi, int aux) { return false; });
  } else {
    const int head = wt & 7, q4 = (wt >> 3) & 3, b = wt >> 5;
    const int row0 = NLAT + b * LC + q4 * 64;
    const u16* kc = PN + (size_t)(NLAT + b * LC) * PNLD + 2208 + head * 64;
    const u16* vc = VTc + (size_t)(b * VTR + 640 + head * 64) * LC;
    const u16* qb = PN + (size_t)row0 * PNLD + 1696 + head * 64;
    u16* ob = (u16*)(p.ws + OFF_Y) + (size_t)2 * NTOK * 512 + (size_t)row0 * 512 + head * 64;
    attn_core4([&](int gi) { return qb + (size_t)gi * 16 * PNLD; }, [&](int gi) { return ob + (size_t)gi * 16 * 512; },
               [&](int gi) { return -INFINITY; }, 0.0f, 8,
               [&](int t, const u16*& kp, const u16*& vp, int& vld, int& aux) { kp = kc + (size_t)(t * 32) * PNLD; vp = vc + t * 32; vld = LC; aux = -1; },
               [&](int gi, int aux, int kidx, int n, float dot) -> float { return dot * QSC; }, [&](int gi, int aux) { return false; });
  }
}

constexpr int G_QS = 0, G_KS = 9216, G_KT = 18432, G_VT = 27648, G_ZL = 36864, G_TOT = 40960, G_DEC = 41984, G_END = 42240;
constexpr int NE = 4;
constexpr size_t OFF_SL = OFF_Y + (size_t)2 * NTOK * 512 * 2;
constexpr size_t OFF_DS = OFF_PAD + (524288u);

template <int PASS>
DI void task_gla(const Params& p, int l, int id, char* lds) {
  int seg, rest;
  if (PASS == 1) { seg = id & 15; rest = id >> 4; } else { seg = 16 - (id % 17); rest = id / 17; }
  const int sl = rest & 1, dir = (rest >> 1) & 1, h = (rest >> 2) & 3, b = rest >> 4, combo = rest >> 1;
  const int tid = threadIdx.x, lane = tid & 63, wave = tid >> 6, g = lane >> 4, n = lane & 15;
  const u16* PN = (const u16*)(p.ws + OFF_PN);
  u16* odst = dir ? (u16*)(p.ws + OFF_OB) : (u16*)(p.ws + OFF_Y) + (size_t)NTOK * 512;
  float* SL = (float*)(p.ws + OFF_SL);
  float* DS = (float*)(p.ws + OFF_DS);
  const float* gwp = (dir ? p.gw_b : p.gw_f) + (size_t)l * 16 * 256 + h * 64 + lane;
  const float* gbp = (dir ? p.gb_b : p.gb_f) + l * 256 + h * 64 + lane;
  f32x4 S[4][NE];
#pragma unroll
  for (int i = 0; i < 4; i++)
#pragma unroll
    for (int j = 0; j < NE; j++) S[i][j] = f32x4{0.f, 0.f, 0.f, 0.f};
  if (PASS == 2) {
    const float* sl_src = SL + ((size_t)(rest * 17 + seg)) * (1024 * NE) + lane * 4;
#pragma unroll
    for (int dt = 0; dt < 4; dt++)
#pragma unroll
      for (int et = 0; et < NE; et++) S[dt][et] = *(const f32x4*)(sl_src + (dt * NE + et) * 256);
  }
  float* ZL = (float*)(lds + G_ZL);
  float* TOT = (float*)(lds + G_TOT);
  float* DEC = (float*)(lds + G_DEC);
  float totsum = 0.f;

  int tb = 0, rowbase = 0;
  uint4 rq0, rq1, rk0, rk1, rz, rv, rv2;
  rq0 = rq1 = rz = uint4{0, 0, 0, 0};
  auto gload = [&](int ch) {
    int vld; const u16* vsrc;
    if (ch < 4) {
      tb = dir ? 192 - 64 * ch : 64 * ch; rowbase = NLAT + b * LC; vld = LC;
      vsrc = (const u16*)(p.ws + OFF_VTC) + (size_t)(b * VTR + 128 + h * 128 + sl * 64) * LC;
    } else {
      tb = dir ? SEQ - 64 * (ch - 3) : 64 * (ch - 4); rowbase = b * SEQ; vld = SEQ;
      vsrc = (const u16*)(p.ws + OFF_VT) + (size_t)(b * VTR + 128 + h * 128 + sl * 64) * SEQ;
    }
    {
      int row = tid >> 3, kc = tid & 7;
      int tok0 = dir ? tb + 63 - row : tb + row, tok1 = dir ? tb + 31 - row : tb + 32 + row;
      const u16* s0 = PN + (size_t)(rowbase + tok0) * PNLD + h * 64 + kc * 8;
      const u16* s1 = PN + (size_t)(rowbase + tok1) * PNLD + h * 64 + kc * 8;
      if (PASS == 2) { rq0 = *(const uint4*)(s0 + 640); rq1 = *(const uint4*)(s1 + 640); }
      rk0 = *(const uint4*)(s0 + 896); rk1 = *(const uint4*)(s1 + 896);
    }
    if (tid < 128) {
      int row = tid >> 1, hc = tid & 1;
      int tok = dir ? tb + 63 - row : tb + row;
      rz = *(const uint4*)(PN + (size_t)(rowbase + tok) * PNLD + 1664 + dir * 16 + hc * 8);
    }
    rv = *(const uint4*)(vsrc + (size_t)(tid >> 3) * vld + tb + (tid & 7) * 8);
    rv2 = *(const uint4*)(vsrc + (size_t)(32 + (tid >> 3)) * vld + tb + (tid & 7) * 8);
  };
  gload(seg * 4);

  for (int ci = 0; ci < 4; ci++) {
    const int ctb = tb, crowbase = rowbase;
    float gw[16];
#pragma unroll
    for (int r = 0; r < 16; r++) gw[r] = gwp[r * 256];
    const float gbias = gbp[0];
    __syncthreads();
    {
      int row = tid >> 3, kc = tid & 7;
      if (PASS == 2) {
        *(uint4*)(lds + G_QS + row * LROW + kc * 16) = rq0;
        *(uint4*)(lds + G_QS + (row + 32) * LROW + kc * 16) = rq1;
      }
      *(uint4*)(lds + G_KS + row * LROW + kc * 16) = rk0;
      *(uint4*)(lds + G_KS + (row + 32) * LROW + kc * 16) = rk1;
    }
    if (tid < 128) {
      int row = tid >> 1, hc = tid & 1;
      float* zd = ZL + row * 16 + hc * 8;
      zd[0] = __uint_as_float(rz.x << 16); zd[1] = __uint_as_float(rz.x & 0xffff0000u);
      zd[2] = __uint_as_float(rz.y << 16); zd[3] = __uint_as_float(rz.y & 0xffff0000u);
      zd[4] = __uint_as_float(rz.z << 16); zd[5] = __uint_as_float(rz.z & 0xffff0000u);
      zd[6] = __uint_as_float(rz.w << 16); zd[7] = __uint_as_float(rz.w & 0xffff0000u);
    }
    {
      int e = tid >> 3, kc = tid & 7;
      if (dir) {
        uint4 rr;
        rr.x = (rv.w >> 16) | (rv.w << 16); rr.y = (rv.z >> 16) | (rv.z << 16);
        rr.z = (rv.y >> 16) | (rv.y << 16); rr.w = (rv.x >> 16) | (rv.x << 16);
        *(uint4*)(lds + G_VT + e * LROW + (7 - kc) * 16) = rr;
        rr.x = (rv2.w >> 16) | (rv2.w << 16); rr.y = (rv2.z >> 16) | (rv2.z << 16);
        rr.z = (rv2.y >> 16) | (rv2.y << 16); rr.w = (rv2.x >> 16) | (rv2.x << 16);
        *(uint4*)(lds + G_VT + (32 + e) * LROW + (7 - kc) * 16) = rr;
      } else {
        *(uint4*)(lds + G_VT + e * LROW + kc * 16) = rv;
        *(uint4*)(lds + G_VT + (32 + e) * LROW + kc * 16) = rv2;
      }
    }
    __syncthreads();
    float bv[16];
    {
      float run = 0.f;
#pragma unroll
      for (int tt = 0; tt < 16; tt++) {
        const float4* zr = (const float4*)(ZL + (wave * 16 + tt) * 16);
        float z = gbias;
#pragma unroll
        for (int q = 0; q < 4; q++) {
          float4 zz = zr[q];
          z += zz.x * gw[q * 4 + 0] + zz.y * gw[q * 4 + 1] + zz.z * gw[q * 4 + 2] + zz.w * gw[q * 4 + 3];
        }
        float lsg = fminf(z, 0.f) - __logf(1.0f + __expf(-fabsf(z)));
        run += lsg * (1.0f / 16.0f);
        bv[tt] = run;
      }
      TOT[wave * 64 + lane] = run;
    }
    __syncthreads();
    {
      float off = 0.f, tot = 0.f;
#pragma unroll
      for (int s = 0; s < 4; s++) { float tv = TOT[s * 64 + lane]; if (s < wave) off += tv; tot += tv; }
      totsum += tot;
      const float dtot = __expf(tot);
      if (wave == 0) DEC[lane] = dtot;
      unsigned ktp[8];
#pragma unroll
      for (int tt = 0; tt < 16; tt++) {
        const int t = wave * 16 + tt;
        const float bq = bv[tt] + off;
        u16* ka = (u16*)(lds + G_KS + t * LROW) + lane;
        const float kv = bf2f(*ka);
        const float e1 = __expf(bq), e2 = __builtin_amdgcn_rcpf(e1);
        if (PASS == 2) {
          u16* qa = (u16*)(lds + G_QS + t * LROW) + lane;
          const float qv = bf2f(*qa);
          *qa = f2bf(qv * 0.125f * e1);
          *ka = f2bf(kv * e2);
        }
        const unsigned kt = f2bf(kv * (dtot * e2));
        if (tt & 1) ktp[tt >> 1] |= kt << 16; else ktp[tt >> 1] = kt;
      }
      uint4* kd = (uint4*)(lds + G_KT + lane * LROW + wave * 32);
      kd[0] = uint4{ktp[0], ktp[1], ktp[2], ktp[3]};
      kd[1] = uint4{ktp[4], ktp[5], ktp[6], ktp[7]};
    }
    __syncthreads();
    if (ci < 3) gload(seg * 4 + ci + 1);
    if (PASS == 2) {
      bf16x8 qf[2];
      qf[0] = *(const bf16x8*)(lds + G_QS + (wave * 16 + n) * LROW + g * 16);
      qf[1] = *(const bf16x8*)(lds + G_QS + (wave * 16 + n) * LROW + 64 + g * 16);
      f32x4 X[4];
#pragma unroll
      for (int jt = 0; jt < 4; jt++) {
        X[jt] = f32x4{0.f, 0.f, 0.f, 0.f};
#pragma unroll
        for (int s = 0; s < 2; s++) {
          bf16x8 kf = *(const bf16x8*)(lds + G_KS + (jt * 16 + n) * LROW + s * 64 + g * 16);
          X[jt] = MFMA16(kf, qf[s], X[jt]);
        }
#pragma unroll
        for (int r = 0; r < 4; r++) if (jt * 16 + 4 * g + r > wave * 16 + n) X[jt][r] = 0.f;
      }
      f32x4 o[NE];
#pragma unroll
      for (int et = 0; et < NE; et++) o[et] = f32x4{0.f, 0.f, 0.f, 0.f};
#pragma unroll
      for (int kk = 0; kk < 2; kk++) {
        union { bf16x8 v; unsigned u[4]; } pa;
        pa.u[0] = pack2(X[2 * kk][0], X[2 * kk][1]); pa.u[1] = pack2(X[2 * kk][2], X[2 * kk][3]);
        pa.u[2] = pack2(X[2 * kk + 1][0], X[2 * kk + 1][1]); pa.u[3] = pack2(X[2 * kk + 1][2], X[2 * kk + 1][3]);
        const char* qr = lds + G_QS + (wave * 16 + n) * LROW + kk * 64 + g * 8;
        s16x4 qa = *(const s16x4*)(qr), qb = *(const s16x4*)(qr + 32);
        bf16x8 qp = __builtin_shufflevector(qa, qb, 0, 1, 2, 3, 4, 5, 6, 7);
#pragma unroll
        for (int et = 0; et < NE; et++) {
          const char* vr = lds + G_VT + (et * 16 + n) * LROW + kk * 64 + g * 8;
          s16x4 va = *(const s16x4*)(vr), vb = *(const s16x4*)(vr + 32);
          bf16x8 vf = __builtin_shufflevector(va, vb, 0, 1, 2, 3, 4, 5, 6, 7);
          o[et] = MFMA16(pa.v, vf, o[et]);
          union { bf16x8 v; unsigned u[4]; } sb;
          sb.u[0] = pack2(S[2 * kk][et][0], S[2 * kk][et][1]); sb.u[1] = pack2(S[2 * kk][et][2], S[2 * kk][et][3]);
          sb.u[2] = pack2(S[2 * kk + 1][et][0], S[2 * kk + 1][et][1]); sb.u[3] = pack2(S[2 * kk + 1][et][2], S[2 * kk + 1][et][3]);
          o[et] = MFMA16(qp, sb.v, o[et]);
        }
      }
#pragma unroll
      for (int r = 0; r < 4; r++) {
        int i = wave * 16 + 4 * g + r;
        int tok = dir ? ctb + 63 - i : ctb + i;
        u16* orow = odst + (size_t)(crowbase + tok) * 512 + h * 128 + sl * 64 + n;
#pragma unroll
        for (int et = 0; et < NE; et++) orow[et * 16] = f2bf(o[et][r]);
      }
    }
    if (PASS == 1 || ci < 3) {
      bf16x8 vfr[NE][2];
#pragma unroll
      for (int et = 0; et < NE; et++)
#pragma unroll
        for (int s = 0; s < 2; s++) vfr[et][s] = *(const bf16x8*)(lds + G_VT + (et * 16 + n) * LROW + s * 64 + g * 16);
#pragma unroll
      for (int dt = 0; dt < 4; dt++) {
        bf16x8 kf0 = *(const bf16x8*)(lds + G_KT + (dt * 16 + n) * LROW + g * 16);
        bf16x8 kf1 = *(const bf16x8*)(lds + G_KT + (dt * 16 + n) * LROW + 64 + g * 16);
        const f32x4 dc = *(const f32x4*)(DEC + dt * 16 + 4 * g);
#pragma unroll
        for (int et = 0; et < NE; et++) {
          f32x4 u = {0.f, 0.f, 0.f, 0.f};
          u = MFMA16(kf0, vfr[et][0], u);
          u = MFMA16(kf1, vfr[et][1], u);
          S[dt][et] = S[dt][et] * dc + u;
        }
      }
    }
  }
  if (PASS == 1 && wave == 0) {
    float* dst = SL + ((size_t)(rest * 17 + seg)) * (1024 * NE) + lane * 4;
#pragma unroll
    for (int dt = 0; dt < 4; dt++)
#pragma unroll
      for (int et = 0; et < NE; et++) *(f32x4*)(dst + (dt * NE + et) * 256) = S[dt][et];
    if (sl == 0) DS[(size_t)(combo * 17 + seg) * 64 + lane] = totsum;
  }
}

DI void task_gla_prefix(const Params& p, int rest) {
  const int tid = threadIdx.x, combo = rest >> 1;
  constexpr int SSZ = 1024 * NE;
  float* SL = (float*)(p.ws + OFF_SL) + (size_t)rest * 17 * SSZ + tid * 16;
  const int tile = tid >> 4, g4 = (tid & 15) >> 2;
  const float* DS = (const float*)(p.ws + OFF_DS) + (size_t)combo * 17 * 64 + (tile / NE) * 16 + 4 * g4;
  f32x4 s0 = {0.f, 0.f, 0.f, 0.f}, s1 = s0, s2 = s0, s3 = s0;
#pragma unroll 2
  for (int seg = 0; seg < 16; seg++) {
    float* q = SL + (size_t)seg * SSZ;
    const f32x4 c0 = *(const f32x4*)(q), c1 = *(const f32x4*)(q + 4), c2 = *(const f32x4*)(q + 8), c3 = *(const f32x4*)(q + 12);
    const f32x4 dl = *(const f32x4*)(DS + seg * 64);
    *(f32x4*)(q) = s0; *(f32x4*)(q + 4) = s1; *(f32x4*)(q + 8) = s2; *(f32x4*)(q + 12) = s3;
    const f32x4 dc = {__expf(dl[0]), __expf(dl[1]), __expf(dl[2]), __expf(dl[3])};
    s0 = s0 * dc + c0; s1 = s1 * dc + c1; s2 = s2 * dc + c2; s3 = s3 * dc + c3;
  }
  float* q = SL + (size_t)16 * SSZ;
  *(f32x4*)(q) = s0; *(f32x4*)(q + 4) = s1; *(f32x4*)(q + 8) = s2; *(f32x4*)(q + 12) = s3;
}

DI void task_gla_out(const Params& p, int l, int task) {
  const int lane = threadIdx.x & 63, wave = threadIdx.x >> 6;
  const int row0 = task * 16 + wave * 4;
  u16* of = (u16*)(p.ws + OFF_Y) + (size_t)NTOK * 512 + (size_t)row0 * 512 + lane * 8;
  const u16* ob = (const u16*)(p.ws + OFF_OB) + (size_t)row0 * 512 + lane * 8;
  const u16* gr = (const u16*)(p.ws + OFF_PN) + (size_t)row0 * PNLD + 1152 + lane * 8;
  uint4 a[4], bb[4], rr[4];
#pragma unroll
  for (int q = 0; q < 4; q++) { a[q] = *(const uint4*)(of + q * 512); bb[q] = *(const uint4*)(ob + q * 512); rr[q] = *(const uint4*)(gr + (size_t)q * PNLD); }
  const float* gn = p.gla_norm + l * 128 + (lane & 15) * 8;
  float gnv[8];
#pragma unroll
  for (int i = 0; i < 8; i++) gnv[i] = gn[i];
#pragma unroll
  for (int q = 0; q < 4; q++) {
    const unsigned au[4] = {a[q].x, a[q].y, a[q].z, a[q].w}, bu[4] = {bb[q].x, bb[q].y, bb[q].z, bb[q].w}, ru[4] = {rr[q].x, rr[q].y, rr[q].z, rr[q].w};
    float v[8], rv[8], ss = 0.f;
#pragma unroll
    for (int i = 0; i < 4; i++) {
      v[2 * i] = __uint_as_float(au[i] << 16) + __uint_as_float(bu[i] << 16);
      v[2 * i + 1] = __uint_as_float(au[i] & 0xffff0000u) + __uint_as_float(bu[i] & 0xffff0000u);
      rv[2 * i] = __uint_as_float(ru[i] << 16);
      rv[2 * i + 1] = __uint_as_float(ru[i] & 0xffff0000u);
      ss += v[2 * i] * v[2 * i] + v[2 * i + 1] * v[2 * i + 1];
    }
    ss += __shfl_xor(ss, 1, 64); ss += __shfl_xor(ss, 2, 64); ss += __shfl_xor(ss, 4, 64); ss += __shfl_xor(ss, 8, 64);
    const float rstd = rsqrtf(ss * (1.0f / 128.0f) + 1e-6f);
    float o[8];
#pragma unroll
    for (int i = 0; i < 8; i++) o[i] = v[i] * rstd * gnv[i] * siluf_(rv[i]);
    uint4 w; w.x = pack2(o[0], o[1]); w.y = pack2(o[2], o[3]); w.z = pack2(o[4], o[5]); w.w = pack2(o[6], o[7]);
    *(uint4*)(of + q * 512) = w;
  }
}

constexpr size_t OFF_GQ = OFF_ACT;
static_assert(OFF_GQ + (size_t)3072 * NTOK <= OFF_Y, "gate alias");

DI void task_gates(const Params& p, int l, int tile, char* lds) {
  const int mt = tile / 12, nt = tile % 12;
  const int tid = threadIdx.x, lane = tid & 63, wave = tid >> 6;
  const int wm = wave >> 1, wn = wave & 1, g = lane >> 4, n = lane & 15;
  f32x4 acc[4][8];
#pragma unroll
  for (int i = 0; i < 4; i++)
#pragma unroll
    for (int j = 0; j < 8; j++) acc[i][j] = f32x4{0.f, 0.f, 0.f, 0.f};
  gemm_wide((const u16*)(p.ws + OFF_HB) + (size_t)mt * 128 * 32, NTOK, (const u16*)(p.ws + OFF_WMG) + (size_t)nt * 256 * 32, 3072, D, acc, lds);
  unsigned char* GQ = (unsigned char*)(p.ws + OFF_GQ);
  const float* bm = p.b_merge + l * 3072 + nt * 256 + wn * 128 + n;
#pragma unroll
  for (int ni = 0; ni < 8; ni++) {
    const float bias = bm[ni * 16];
    const size_t col = (size_t)(nt * 256 + wn * 128 + ni * 16 + n);
#pragma unroll
    for (int mi = 0; mi < 4; mi++) {
      const int row0 = mt * 128 + wm * 64 + mi * 16 + 4 * g;
      unsigned q0 = (unsigned)(sigmoidf_(acc[mi][ni][0] + bias) * 255.0f + 0.5f);
      unsigned q1 = (unsigned)(sigmoidf_(acc[mi][ni][1] + bias) * 255.0f + 0.5f);
      unsigned q2 = (unsigned)(sigmoidf_(acc[mi][ni][2] + bias) * 255.0f + 0.5f);
      unsigned q3 = (unsigned)(sigmoidf_(acc[mi][ni][3] + bias) * 255.0f + 0.5f);
      *(unsigned*)(GQ + ((col >> 4) * (size_t)(NTOK / 16) + (row0 >> 4)) * 256 + (col & 15) * 16 + (row0 & 15)) = q0 | (q1 << 8) | (q2 << 16) | (q3 << 24);
    }
  }
}

DI void task_mg(const Params& p, int l, int tile, char* lds) {
  const int mt = tile >> 3, nt = tile & 7;
  const int tid = threadIdx.x, lane = tid & 63, wave = tid >> 6;
  const int wm = wave >> 1, wn = wave & 1, g = lane >> 4, n = lane & 15;
  f32x4 mix[4][4];
  zero_acc<4>(mix);
  const unsigned char* GQ = (const unsigned char*)(p.ws + OFF_GQ);
#pragma unroll 1
  for (int br = 0; br < 3; br++) {
    f32x4 acc[4][4];
    zero_acc<4>(acc);
    gemm_tile<4, 0>((const u16*)(p.ws + OFF_Y) + (size_t)br * NTOK * 512 + (size_t)mt * 128 * 512, 512,
                 (const u16*)(p.ws + OFF_WBR) + (size_t)br * 1024 * 512 + (size_t)nt * 128 * 512, 512, 512, acc, lds);
#pragma unroll
    for (int ni = 0; ni < 4; ni++) {
      const size_t col = (size_t)(br * 1024 + nt * 128 + wn * 64 + ni * 16 + n);
#pragma unroll
      for (int mi = 0; mi < 4; mi++) {
        const int row0 = mt * 128 + wm * 64 + mi * 16 + 4 * g;
        const unsigned q = *(const unsigned*)(GQ + ((col >> 4) * (size_t)(NTOK / 16) + (row0 >> 4)) * 256 + (col & 15) * 16 + (row0 & 15));
        mix[mi][ni][0] += (float)(q & 255u) * (1.0f / 255.0f) * acc[mi][ni][0];
        mix[mi][ni][1] += (float)((q >> 8) & 255u) * (1.0f / 255.0f) * acc[mi][ni][1];
        mix[mi][ni][2] += (float)((q >> 16) & 255u) * (1.0f / 255.0f) * acc[mi][ni][2];
        mix[mi][ni][3] += (float)(q >> 24) * (1.0f / 255.0f) * acc[mi][ni][3];
      }
    }
  }
  u16* mx = (u16*)(p.ws + OFF_MIXED);
#pragma unroll
  for (int mi = 0; mi < 4; mi++)
#pragma unroll
    for (int ni = 0; ni < 4; ni++)
#pragma unroll
      for (int r = 0; r < 4; r++)
      {
        const int row = mt * 128 + wm * 64 + mi * 16 + 4 * g + r, col = nt * 128 + wn * 64 + ni * 16 + n;
        mx[((size_t)(col >> 5) * NTOK + row) * 32 + (col & 31)] = f2bf(mix[mi][ni][r]);
      }
}

DI void task_res_wide(const Params& p, int l, int tile, const u16* A, int lda, const u16* Wt, int K, int gate_idx, bool first, char* lds) {
  const int mt = tile >> 2, nt = tile & 3;
  const int tid = threadIdx.x, lane = tid & 63, wave = tid >> 6;
  const int wm = wave >> 1, wn = wave & 1, g = lane >> 4, n = lane & 15;
  f32x4 acc[4][8];
#pragma unroll
  for (int i = 0; i < 4; i++)
#pragma unroll
    for (int j = 0; j < 8; j++) acc[i][j] = f32x4{0.f, 0.f, 0.f, 0.f};
  gemm_wide(A + (size_t)mt * 128 * 32, NTOK, Wt + (size_t)nt * 256 * 32, D, K, acc, lds);
  const float* gt = modp(p, l, mt * 128) + gate_idx * D + nt * 256 + wn * 128 + n;
#pragma unroll
  for (int ni = 0; ni < 8; ni++) {
    const float gv = gt[ni * 16];
#pragma unroll
    for (int mi = 0; mi < 4; mi++)
#pragma unroll
      for (int r = 0; r < 4; r++) {
        int row = mt * 128 + wm * 64 + mi * 16 + 4 * g + r, col = nt * 256 + wn * 128 + ni * 16 + n;
        const float* xs = first ? xsrc(p, l, row) : (const float*)xdst(p, row);
        xdst(p, row)[col] = xs[col] + gv * acc[mi][ni][r];
      }
  }
}

DI void task_res_ctx(const Params& p, int l, int tile, const u16* A, int lda, const u16* Wt, int K, int gate_idx, bool first, char* lds) {
  const int mt = 128 + (tile >> 4), nt = tile & 15;
  const int tid = threadIdx.x, lane = tid & 63, wave = tid >> 6;
  const int wm = wave >> 1, wn = wave & 1, g = lane >> 4, n = lane & 15;
  f32x4 acc[4][2];
  zero_acc<2>(acc);
  gemm_tile<2, 1>(A + (size_t)mt * 128 * 32, NTOK, Wt + (size_t)nt * 64 * 32, D, K, acc, lds);
  const float* gt = modp(p, l, mt * 128) + gate_idx * D + nt * 64 + wn * 32 + n;
#pragma unroll
  for (int ni = 0; ni < 2; ni++) {
    const float gv = gt[ni * 16];
#pragma unroll
    for (int mi = 0; mi < 4; mi++)
#pragma unroll
      for (int r = 0; r < 4; r++) {
        int row = mt * 128 + wm * 64 + mi * 16 + 4 * g + r, col = nt * 64 + wn * 32 + ni * 16 + n;
        const float* xs = first ? xsrc(p, l, row) : (const float*)xdst(p, row);
        xdst(p, row)[col] = xs[col] + gv * acc[mi][ni][r];
      }
  }
}

DI void task_f1(const Params& p, int tile, char* lds) {
  const int mt = tile / 22, nt = tile % 22;
  const int tid = threadIdx.x, lane = tid & 63, wave = tid >> 6;
  const int wm = wave >> 1, wn = wave & 1, g = lane >> 4, n = lane & 15;
  f32x4 acc[4][8];
#pragma unroll
  for (int i = 0; i < 4; i++)
#pragma unroll
    for (int j = 0; j < 8; j++) acc[i][j] = f32x4{0.f, 0.f, 0.f, 0.f};
  gemm_wide((const u16*)(p.ws + OFF_HB) + (size_t)mt * 128 * 32, NTOK, (const u16*)(p.ws + OFF_WF1) + (size_t)nt * 256 * 32, 2 * FH, D, acc, lds);
  u16* act = (u16*)(p.ws + OFF_ACT);
#pragma unroll
  for (int mi = 0; mi < 4; mi++)
#pragma unroll
    for (int ni = 0; ni < 4; ni++)
#pragma unroll
      for (int r = 0; r < 4; r++) {
        int row = mt * 128 + wm * 64 + mi * 16 + 4 * g + r, col = nt * 128 + wn * 64 + ni * 16 + n;
        act[((size_t)(col >> 5) * NTOK + row) * 32 + (col & 31)] = f2bf(siluf_(acc[mi][ni][r]) * acc[mi][ni + 4][r]);
      }
}

#define XB_TMO      128
#define XB_XCNT(j)  (256  + 64 * (j))
#define XB_XSUB(j)  (1280 + 64 * (j))
#define XB_XGEN(j)  (2304 + 64 * (j))
#define XB_TOP      3328
#define XB_TOPGEN   3392
#define XCD_BAR_WORDS 3456
#define XB_SPIN_CAP (1u << 18)
#define LAS __attribute__((address_space(3)))

__device__ __forceinline__ unsigned xb_ld(unsigned* p)              { return __hip_atomic_load(p, __ATOMIC_RELAXED, __HIP_MEMORY_SCOPE_AGENT); }
__device__ __forceinline__ unsigned xb_add(unsigned* p, unsigned v) { return __hip_atomic_fetch_add(p, v, __ATOMIC_RELAXED, __HIP_MEMORY_SCOPE_AGENT); }
__device__ __forceinline__ unsigned xb_xcc_id() { return (unsigned)__builtin_amdgcn_s_getreg((3 << 11) | 20) & 0xFu; }
#define XB_SPIN(cond, bar) do { unsigned _sp = 0; while (cond) { __builtin_amdgcn_s_sleep(1); \
    if ((++_sp & 255u) == 0u) { if (xb_ld(&(bar)[XB_TMO])) break; if (_sp > XB_SPIN_CAP) { atomicAdd(&(bar)[XB_TMO], 1u); break; } } } } while (0)

struct XcdBarrier {
    unsigned* bar; unsigned x;
    volatile LAS unsigned* st;
};

__device__ __forceinline__ XcdBarrier xcd_barrier_post(unsigned* bar, volatile LAS unsigned* st) {
    XcdBarrier b; b.bar = bar; b.x = xb_xcc_id(); b.st = st;
    if (threadIdx.x == 0) (void)xb_add(&bar[XB_XCNT(b.x)], 1u);
    return b;
}
__device__ __forceinline__ void xcd_barrier_complete(unsigned* bar, unsigned x, unsigned& nloc, unsigned& nx) {
    const unsigned G = gridDim.x * gridDim.y * gridDim.z;
    unsigned sum, cnt, mine, sp = 0u;
    for (;;) {
        sum = 0u; cnt = 0u; mine = 0u;
#pragma unroll
        for (unsigned j = 0; j < 16; ++j) { const unsigned c = xb_ld(&bar[XB_XCNT(j)]); sum += c; cnt += (c > 0u) ? 1u : 0u; mine = (j == x) ? c : mine; }
        if (sum == G) break;
        __builtin_amdgcn_s_sleep(1);
        if ((++sp & 255u) == 0u) { if (xb_ld(&bar[XB_TMO])) break; if (sp > XB_SPIN_CAP) { atomicAdd(&bar[XB_TMO], 1u); break; } }
    }
    nloc = mine > 0u ? mine : 1u; nx = cnt > 0u ? cnt : 1u;
}

__device__ __forceinline__ void xcd_barrier(const XcdBarrier& b) {
    asm volatile("s_waitcnt vmcnt(0)" ::: "memory");
    __syncthreads();
    if (threadIdx.x == 0) {
        unsigned* bar = b.bar;
        __builtin_amdgcn_s_waitcnt(0);
        unsigned nloc = b.st[0], nx = b.st[1];
        if (nloc == 0u) { xcd_barrier_complete(bar, b.x, nloc, nx); b.st[0] = nloc; b.st[1] = nx; }
        const unsigned old = xb_add(&bar[XB_XSUB(b.x)], 1u);
        const unsigned gen = old / nloc;
        if (old + 1u == (gen + 1u) * nloc) {
            __builtin_amdgcn_fence(__ATOMIC_RELEASE, "agent");
            asm volatile("s_waitcnt vmcnt(0)" ::: "memory");
            const unsigned og = xb_add(&bar[XB_TOP], 1u);
            const unsigned tg = og / nx;
            if (og + 1u == (tg + 1u) * nx) xb_add(&bar[XB_TOPGEN], 1u);
            else XB_SPIN(xb_ld(&bar[XB_TOPGEN]) == tg, bar);
            __builtin_amdgcn_fence(__ATOMIC_ACQUIRE, "agent");
            xb_add(&bar[XB_XGEN(b.x)], 1u);
            asm volatile("s_waitcnt vmcnt(0)" ::: "memory");
        } else {
            XB_SPIN(xb_ld(&bar[XB_XGEN(b.x)]) == gen, bar);
            __builtin_amdgcn_fence(__ATOMIC_ACQUIRE, "agent");
            asm volatile("s_waitcnt vmcnt(0)" ::: "memory");
        }
    }
    __syncthreads();
}


DI int xcd_swizzle(int t, int nb, int ntiles) {
  const int r = t / nb;
  if ((nb & 7) || (r + 1) * nb > ntiles) return t;
  const int b = t - r * nb, per = nb >> 3;
  return r * nb + (b & 7) * per + (b >> 3);
}

constexpr int NPHASE = 26;
constexpr int SMEM_BYTES = 2 * GBUF;

DI void run_phase(const Params& p, int ph, char* lds) {
  const int bid = blockIdx.x, nb = gridDim.x, wave = threadIdx.x >> 6;
  if (ph == 0) {
    for (int t = bid; t < 192 + 512 + CONV1_TASKS; t += nb) {
      if (t < 192) task_mod(p, t, lds); else if (t < 704) task_rope(p, t - 192); else task_conv1(p, 0, t - 704, lds);
    }
    return;
  }
  if (ph == 25) { for (int t = bid; t < NLAT / 16; t += nb) task_final_norm(p, t); return; }
  const int l = (ph - 1) / 12; int sp = (ph - 1) % 12;
  const bool last = l == 1;
  const int mtiles = last ? 128 : 136;
  if (sp >= 7) sp = (sp == 7) ? 11 : sp - 1;
  switch (sp) {
    case 0: for (int t = bid; t < NTOK / 16; t += nb) task_norm(p, l, t, 0); break;
    case 1: {
      for (int t = bid; t < 136 * 15; t += nb) task_g1(p, l, xcd_swizzle(t, nb, 136 * 15), lds);
      for (int t = (bid + nb - ((136 * 15) % nb)) % nb; t < 136; t += nb) task_g1_tail(p, l, t, lds);
    } break;
    case 2: for (int t = bid; t < 1024; t += nb) task_gla<1>(p, l, xcd_swizzle(t, nb, 1024), lds); break;
    case 3: {
      for (int t = bid; t < 64; t += nb) task_gla_prefix(p, t);
      for (int t = bid; t < 512; t += nb) attn_a_latent(p, l, xcd_swizzle(t, nb, 512) * 4 + wave);
      if (!last) for (int t = bid; t < 32; t += nb) attn_ctx(p, l, (31 - t) * 4 + wave, 0);
    } break;
    case 4: for (int t = bid; t < 1088; t += nb) task_gla<2>(p, l, xcd_swizzle(t, nb, 1088), lds); break;
    case 5: {
      __syncthreads();
      for (int t = bid; t < 512; t += nb) attn_c_latent(p, l, xcd_swizzle(t, nb, 512) * 4 + wave, lds);
      if (!last) for (int t = bid; t < 32; t += nb) attn_ctx(p, l, t * 4 + wave, 1);
      for (int t = bid; t < (last ? NLAT : NTOK) / 16; t += nb) task_gla_out(p, l, t);
    } break;
    case 6: for (int t = bid; t < mtiles * 12; t += nb) task_gates(p, l, xcd_swizzle(t, nb, mtiles * 12), lds); break;
    case 11: for (int t = bid; t < mtiles * 8; t += nb) task_mg(p, l, xcd_swizzle(t, nb, mtiles * 8), lds); break;
    case 7: {
      for (int t = bid; t < 512; t += nb) task_res_wide(p, l, xcd_swizzle(t, nb, 512), (const u16*)(p.ws + OFF_MIXED), D, (const u16*)(p.ws + OFF_WOUT), D, 2, true, lds);
      if (!last) for (int t = bid; t < 128; t += nb) task_res_ctx(p, l, t, (const u16*)(p.ws + OFF_MIXED), D, (const u16*)(p.ws + OFF_WOUT), D, 2, true, lds);
      for (int t = (bid + nb - (last ? 0 : 128)) % nb; t < CONV2_TASKS; t += nb) task_conv2(p, l, t, lds);
    } break;
    case 8: for (int t = bid; t < (last ? NLAT : NTOK) / 16; t += nb) task_norm(p, l, t, 1); break;
    case 9: for (int t = bid; t < mtiles * 22; t += nb) task_f1(p, xcd_swizzle(t, nb, mtiles * 22), lds); break;
    case 10: {
      for (int t = bid; t < 512; t += nb) task_res_wide(p, l, xcd_swizzle(t, nb, 512), (const u16*)(p.ws + OFF_ACT), FH, (const u16*)(p.ws + OFF_WF2), FH, 5, false, lds);
      if (!last) {
        for (int t = bid; t < 128; t += nb) task_res_ctx(p, l, t, (const u16*)(p.ws + OFF_ACT), FH, (const u16*)(p.ws + OFF_WF2), FH, 5, false, lds);
        for (int t = (bid + nb - 128) % nb; t < CONV1_TASKS; t += nb) task_conv1(p, 1, t, lds);
      }
    } break;
  }
}

#if MULTI_LAUNCH
__global__ void __launch_bounds__(256, 2) k_phase(Params p, int ph) {
  __shared__ __attribute__((aligned(16))) char smem[SMEM_BYTES];
  run_phase(p, ph, smem);
}
#endif

#if !MULTI_LAUNCH
__global__ void __launch_bounds__(256, 2) k_mega(Params p) {
  extern __shared__ __attribute__((aligned(16))) char smem[];
  __shared__ uint4 xb_words;
  if (threadIdx.x == 0) xb_words = make_uint4(0u, 0u, 0u, 0u);
  __syncthreads();
  XcdBarrier xb = xcd_barrier_post((unsigned*)(p.ws + OFF_BAR), (volatile LAS unsigned*)&xb_words);
  if (p.ws == nullptr) cg::this_grid().sync();
#define PH(k) run_phase(p, k, smem); xcd_barrier(xb);
  PH(0) PH(1) PH(2) PH(3) PH(4) PH(5) PH(6) PH(7) PH(8) PH(9) PH(10) PH(11) PH(12) PH(13) PH(14) PH(15) PH(16) PH(17) PH(18) PH(19) PH(20) PH(21) PH(22) PH(23) PH(24)
  run_phase(p, 25, smem);
}
#endif

extern "C" void kernel_launch(void* const* d_in, const int* in_sizes, int n_in, void* d_out, int out_size, void* d_ws, size_t ws_size,
                              hipStream_t stream) {
  Params p{};
  const float** f = (const float**)&p;
  for (int i = 0; i < 25; i++) f[i] = (const float*)d_in[i];
  p.out = (float*)d_out;
  p.ws = (char*)d_ws;
#if MULTI_LAUNCH
  for (int ph = 0; ph < NPHASE; ph++) hipLaunchKernelGGL(k_phase, dim3(512), dim3(256), 0, stream, p, ph);
#else
  static int grid_blocks = 0;
  if (!grid_blocks) {
    int dev = 0, cus = 0, per_cu = 0;
    hipGetDevice(&dev);
    hipDeviceGetAttribute(&cus, hipDeviceAttributeMultiprocessorCount, dev);
    (void)hipFuncSetAttribute((const void*)k_mega, hipFuncAttributeMaxDynamicSharedMemorySize, SMEM_BYTES);
    (void)hipOccupancyMaxActiveBlocksPerMultiprocessor(&per_cu, k_mega, 256, SMEM_BYTES);
    if (per_cu > 2) per_cu = 2;
    if (per_cu < 1) per_cu = 1;
    grid_blocks = cus * per_cu;
  }
  hipMemsetAsync((char*)d_ws + OFF_BAR, 0, XCD_BAR_WORDS * 4, stream);
  void* args[] = {&p};
  hipError_t e = hipLaunchCooperativeKernel((void*)k_mega, dim3(grid_blocks), dim3(256), args, SMEM_BYTES, stream);
  if (e != hipSuccess) fprintf(stderr, "cooperative launch failed: %s (grid %d)\n", hipGetErrorString(e), grid_blocks);
#endif
}
```
